# Optimizing an MI355X kernel written in HIP

```python
import jax
import jax.numpy as jnp
from jax import lax
import numpy as np

D_MODEL = 1024
BATCH = 8
SEQ = 8192
DEPTH = 4

GRID_W = 64
CTX_LEN = 256
N_EVEN = (DEPTH + 1) // 2
N_ODD = DEPTH // 2

MLA_HEADS = 8
MLA_NOPE = 64
MLA_ROPE = 32
MLA_V = 64
Q_LORA = 256
KV_LORA = 128
Q_BLOCK = 128

POOL_WINDOWS = (2, 4, 8, 16)
POOL_GROUP = 128
POOL_WIDTH = POOL_GROUP * len(POOL_WINDOWS)

RET_HEADS = 8
RET_DK = 128
RET_DV = 256
RET_CHUNK = 128
RET_QK_W = RET_HEADS * RET_DK
RET_V_W = RET_HEADS * RET_DV

D_FF = 4 * D_MODEL
ROPE_BASE = 10000.0
EPS = 1e-6

EVEN_IN = Q_LORA + KV_LORA + MLA_ROPE + POOL_WIDTH
EVEN_MIX = MLA_HEADS * MLA_V + POOL_WIDTH
ODD_IN = 2 * RET_QK_W + 2 * RET_V_W
ODD_MIX = RET_V_W

kernel_name = 'hybrid_mla_pool_retention_dit'


def rms_norm(x, g):
    xf = x.astype(jnp.float32)
    y = xf * lax.rsqrt(jnp.mean(xf * xf, axis=-1, keepdims=True) + EPS)
    return (y * g.astype(jnp.float32)).astype(x.dtype)


def modulate(h, shift, scale):
    return h * (1.0 + scale) + shift


def grid_positions(n):
    rows = n // GRID_W
    row = jnp.repeat(jnp.arange(rows, dtype=jnp.float32), GRID_W)
    col = jnp.tile(jnp.arange(GRID_W, dtype=jnp.float32), rows)
    return row, col


def rope_axis(x, pos):
    d = x.shape[-1]
    freqs = ROPE_BASE ** (-jnp.arange(0, d, 2, dtype=jnp.float32) / d)
    ang = pos[:, None] * freqs[None, :]
    cos = jnp.cos(ang)[None, :, None, :].astype(x.dtype)
    sin = jnp.sin(ang)[None, :, None, :].astype(x.dtype)
    x1, x2 = jnp.split(x, 2, axis=-1)
    return jnp.concatenate([x1 * cos - x2 * sin, x1 * sin + x2 * cos], axis=-1)


def rope_2d(x, pos):
    xr, xc = jnp.split(x, 2, axis=-1)
    return jnp.concatenate([rope_axis(xr, pos[0]), rope_axis(xc, pos[1])], axis=-1)


def split_even(u):
    a = Q_LORA
    b = a + KV_LORA
    r = b + MLA_ROPE
    return u[..., :a], u[..., a:b], u[..., b:r], u[..., r:]


def mla_queries(u_q, g_q, w_uq, pos):
    B, L, _ = u_q.shape
    q = (rms_norm(u_q, g_q) @ w_uq).reshape(B, L, MLA_HEADS, MLA_NOPE + MLA_ROPE)
    q_nope, q_rope = q[..., :MLA_NOPE], q[..., MLA_NOPE:]
    if pos is not None:
        q_rope = rope_2d(q_rope, pos)
    return q_nope, q_rope


def mla_keys_values(u_kv, u_kr, g_kv, w_ukv, pos):
    B, L, _ = u_kv.shape
    kv = (rms_norm(u_kv, g_kv) @ w_ukv).reshape(B, L, MLA_HEADS, MLA_NOPE + MLA_V)
    k_nope, v = kv[..., :MLA_NOPE], kv[..., MLA_NOPE:]
    k_rope = u_kr
    if pos is not None:
        k_rope = rope_2d(u_kr[:, :, None, :], pos)[:, :, 0, :]
    return k_nope, k_rope, v


def block_attention(q_nope, q_rope, k_nope, k_rope, v):
    B, S, H, _ = q_nope.shape
    nb = S // Q_BLOCK
    scale = (MLA_NOPE + MLA_ROPE) ** -0.5

    def blocks(t):
        return t.reshape(B, nb, Q_BLOCK, H, t.shape[-1]).swapaxes(0, 1)

    def attend(qb):
        qn, qr = qb
        s = jnp.einsum('bqhd,bkhd->bhqk', qn, k_nope) + jnp.einsum('bqhr,bkr->bhqk', qr, k_rope)
        p = jax.nn.softmax(s.astype(jnp.float32) * scale, axis=-1).astype(v.dtype)
        return jnp.einsum('bhqk,bkhe->bqhe', p, v)

    o = lax.map(attend, (blocks(q_nope), blocks(q_rope)))
    return o.swapaxes(0, 1).reshape(B, S, H * MLA_V)


def multiscale_pool(p, w_pool, pool_scale):
    B, L, _ = p.shape
    cs = jnp.concatenate([jnp.zeros((B, 1, POOL_WIDTH), jnp.float32),
                          jnp.cumsum(p.astype(jnp.float32), axis=1)], axis=1)
    t = jnp.arange(L)
    outs = []
    for g, w in enumerate(POOL_WINDOWS):
        lo = jnp.clip(t - w // 2, 0, L)
        hi = jnp.clip(t + (w - w // 2), 0, L)
        sl = slice(g * POOL_GROUP, (g + 1) * POOL_GROUP)
        csg = cs[:, :, sl]
        mean = (csg[:, hi] - csg[:, lo]) / (hi - lo).astype(jnp.float32)[None, :, None]
        outs.append((mean.astype(p.dtype) - p[..., sl]) @ w_pool[g])
    return jnp.concatenate(outs, axis=-1) * pool_scale


def mla_pool_mixer(h_lat, h_ctx, w_in, g_q, g_kv, w_uq, w_ukv, w_pool, pool_scale, w_out,
                   pos, need_ctx):
    lq, lkv, lkr, lp = split_even(h_lat @ w_in)
    if need_ctx:
        cq, ckv, ckr, cp = split_even(h_ctx @ w_in)
    else:
        ukv = h_ctx @ w_in[:, Q_LORA:Q_LORA + KV_LORA + MLA_ROPE]
        ckv, ckr = ukv[..., :KV_LORA], ukv[..., KV_LORA:]
    ck_nope, ck_rope, cv = mla_keys_values(ckv, ckr, g_kv, w_ukv, None)
    lk_nope, lk_rope, lv = mla_keys_values(lkv, lkr, g_kv, w_ukv, pos)
    lq_nope, lq_rope = mla_queries(lq, g_q, w_uq, pos)
    k_nope = jnp.concatenate([ck_nope, lk_nope], axis=1)
    k_rope = jnp.concatenate([ck_rope, lk_rope], axis=1)
    v = jnp.concatenate([cv, lv], axis=1)
    o_lat = block_attention(lq_nope, lq_rope, k_nope, k_rope, v)
    y_lat = jnp.concatenate([o_lat, multiscale_pool(lp, w_pool, pool_scale)], axis=-1) @ w_out
    y_ctx = None
    if need_ctx:
        cq_nope, cq_rope = mla_queries(cq, g_q, w_uq, None)
        o_ctx = block_attention(cq_nope, cq_rope, ck_nope, ck_rope, cv)
        y_ctx = jnp.concatenate([o_ctx, multiscale_pool(cp, w_pool, pool_scale)], axis=-1) @ w_out
    return y_lat, y_ctx


def retention_log_decays():
    fwd = jnp.log1p(-jnp.exp2(-5.0 - jnp.arange(RET_HEADS, dtype=jnp.float32)))
    return fwd, fwd[::-1]


def retention_scan(q, k, v, log_g, state0, inclusive):
    B, L, H, _ = q.shape
    nc = L // RET_CHUNK
    idx = jnp.arange(RET_CHUNK, dtype=jnp.float32)
    diff = idx[:, None] - idx[None, :]
    mask = diff >= 0 if inclusive else diff > 0
    decay_in = jnp.where(mask, jnp.exp(jnp.where(mask, diff, 0.0)[None] * log_g[:, None, None]),
                         0.0).astype(q.dtype)
    decay_q = jnp.exp((idx[:, None] + 1.0) * log_g[None, :]).astype(q.dtype)
    decay_k = jnp.exp((RET_CHUNK - 1.0 - idx[:, None]) * log_g[None, :]).astype(q.dtype)
    decay_c = jnp.exp(RET_CHUNK * log_g)

    def chunks(t):
        return t.reshape(B, nc, RET_CHUNK, H, t.shape[-1]).swapaxes(0, 1)

    def step(state, qkv):
        qc, kc, vc = qkv
        s = jnp.einsum('bnhd,bmhd->bhnm', qc, kc) * decay_in
        inner = jnp.einsum('bhnm,bmhe->bnhe', s, vc)
        cross = jnp.einsum('bnhd,bhde->bnhe', qc * decay_q[None, :, :, None], state)
        new = state * decay_c[None, :, None, None] + jnp.einsum(
            'bmhd,bmhe->bhde', kc * decay_k[None, :, :, None], vc)
        return new, inner + cross

    final, out = lax.scan(step, state0, (chunks(q), chunks(k), chunks(v)))
    return out.swapaxes(0, 1).reshape(B, L, H, v.shape[-1]), final


def retention_final_state(k, v, log_g, reverse):
    L = k.shape[1]
    t = jnp.arange(L, dtype=jnp.float32)
    steps = t if reverse else (L - 1.0 - t)
    w = jnp.exp(steps[:, None] * log_g[None, :]).astype(k.dtype)
    return jnp.einsum('blhd,blhe->bhde', k * w[None, :, :, None], v).astype(jnp.float32)


def retention_bidir(q, k, v, state_f, state_b, log_f, log_b):
    o_f, s_f = retention_scan(q, k, v, log_f, state_f, True)
    flip = lambda t: jnp.flip(t, axis=1)
    o_b, s_b = retention_scan(flip(q), flip(k), flip(v), log_b, state_b, False)
    return o_f + flip(o_b), s_f, s_b


def head_group_norm(o):
    of = o.astype(jnp.float32)
    mu = jnp.mean(of, axis=-1, keepdims=True)
    var = jnp.mean(jnp.square(of - mu), axis=-1, keepdims=True)
    return (of - mu) * lax.rsqrt(var + EPS)


def to_heads(t, d):
    return t.reshape(t.shape[0], t.shape[1], RET_HEADS, d)


def retention_output(o, g, w_out):
    B, L = g.shape[0], g.shape[1]
    y = jax.nn.silu(g) * head_group_norm(o).astype(g.dtype).reshape(B, L, ODD_MIX)
    return y @ w_out


def retention_mixer(h_lat, h_ctx, w_in, w_out, pos, need_ctx):
    log_f, log_b = retention_log_decays()
    kscale = RET_DK ** -0.5
    a, b, c = RET_QK_W, 2 * RET_QK_W, 2 * RET_QK_W + RET_V_W
    u = h_lat @ w_in
    q = rope_2d(to_heads(u[..., :a], RET_DK), pos)
    k = rope_2d(to_heads(u[..., a:b], RET_DK), pos) * kscale
    v = to_heads(u[..., b:c], RET_DV)
    g = u[..., c:]
    y_ctx = None
    if need_ctx:
        uc = h_ctx @ w_in
        cq = to_heads(uc[..., :a], RET_DK)
        ck = to_heads(uc[..., a:b], RET_DK) * kscale
        cv = to_heads(uc[..., b:c], RET_DV)
        zero = jnp.zeros((h_ctx.shape[0], RET_HEADS, RET_DK, RET_DV), jnp.float32)
        o_ctx, s_f, s_b = retention_bidir(cq, ck, cv, zero, zero, log_f, log_b)
        y_ctx = retention_output(o_ctx, uc[..., c:], w_out)
    else:
        ukv = h_ctx @ w_in[:, a:c]
        ck = to_heads(ukv[..., :RET_QK_W], RET_DK) * kscale
        cv = to_heads(ukv[..., RET_QK_W:], RET_DV)
        s_f = retention_final_state(ck, cv, log_f, False)
        s_b = retention_final_state(ck, cv, log_b, True)
    o_lat, _, _ = retention_bidir(q, k, v, s_f, s_b, log_f, log_b)
    return retention_output(o_lat, g, w_out), y_ctx


def sq_relu_mlp(h, w1, w2):
    return jnp.square(jax.nn.relu(h @ w1)) @ w2


def setup_inputs(seed: int = 0) -> dict:
    key = jax.random.key(seed)
    keys = jax.random.split(key, 22)

    def nrm(i, shape, scale=1.0):
        return jax.random.normal(keys[i], shape, jnp.float32) * scale

    def gain(i, shape):
        return 1.0 + nrm(i, shape, 0.02)

    D = D_MODEL
    return {
        'x': nrm(0, (BATCH, SEQ, D)),
        'c': nrm(1, (BATCH, D)),
        'ctx': nrm(2, (BATCH, CTX_LEN, D)),
        'c_ctx': nrm(3, (D,)),
        'w_ada': nrm(4, (DEPTH, D, 6 * D), 0.5 * D ** -0.5),
        'b_ada': nrm(5, (DEPTH, 6 * D), 0.02),
        'g_mix_pre': gain(6, (DEPTH, D)),
        'g_mix_post': gain(7, (DEPTH, D)),
        'g_ffn_pre': gain(8, (DEPTH, D)),
        'g_ffn_post': gain(9, (DEPTH, D)),
        'w_ffn_in': nrm(10, (DEPTH, D, D_FF), D ** -0.5),
        'w_ffn_out': nrm(11, (DEPTH, D_FF, D), D_FF ** -0.5),
        'w_in_even': nrm(12, (N_EVEN, D, EVEN_IN), D ** -0.5),
        'g_q_lora': gain(13, (N_EVEN, Q_LORA)),
        'g_kv_lora': gain(14, (N_EVEN, KV_LORA)),
        'w_uq': nrm(15, (N_EVEN, Q_LORA, MLA_HEADS * (MLA_NOPE + MLA_ROPE)), Q_LORA ** -0.5),
        'w_ukv': nrm(16, (N_EVEN, KV_LORA, MLA_HEADS * (MLA_NOPE + MLA_V)), KV_LORA ** -0.5),
        'w_pool': nrm(17, (N_EVEN, len(POOL_WINDOWS), POOL_GROUP, POOL_GROUP), POOL_GROUP ** -0.5),
        'pool_scale': gain(18, (N_EVEN, POOL_WIDTH)),
        'w_out_even': nrm(19, (N_EVEN, EVEN_MIX, D), EVEN_MIX ** -0.5),
        'w_in_odd': nrm(20, (N_ODD, D, ODD_IN), D ** -0.5),
        'w_out_odd': nrm(21, (N_ODD, ODD_MIX, D), ODD_MIX ** -0.5),
    }


def reference(x, c, ctx, c_ctx, w_ada, b_ada, g_mix_pre, g_mix_post, g_ffn_pre, g_ffn_post,
              w_ffn_in, w_ffn_out, w_in_even, g_q_lora, g_kv_lora, w_uq, w_ukv, w_pool,
              pool_scale, w_out_even, w_in_odd, w_out_odd):
    pos = grid_positions(x.shape[1])
    cond_lat = jax.nn.silu(c)
    cond_ctx = jax.nn.silu(c_ctx)
    for layer in range(DEPTH):
        need_ctx = layer < DEPTH - 1
        mod_lat = (cond_lat @ w_ada[layer] + b_ada[layer])[:, None, :]
        mod_ctx = cond_ctx @ w_ada[layer] + b_ada[layer]
        sh1, sc1, gt1, sh2, sc2, gt2 = jnp.split(mod_lat, 6, axis=-1)
        csh1, csc1, cgt1, csh2, csc2, cgt2 = jnp.split(mod_ctx, 6, axis=-1)

        h_lat = modulate(rms_norm(x, g_mix_pre[layer]), sh1, sc1)
        h_ctx = modulate(rms_norm(ctx, g_mix_pre[layer]), csh1, csc1)
        if layer % 2 == 0:
            i = layer // 2
            y_lat, y_ctx = mla_pool_mixer(h_lat, h_ctx, w_in_even[i], g_q_lora[i], g_kv_lora[i],
                                          w_uq[i], w_ukv[i], w_pool[i], pool_scale[i],
                                          w_out_even[i], pos, need_ctx)
        else:
            i = layer // 2
            y_lat, y_ctx = retention_mixer(h_lat, h_ctx, w_in_odd[i], w_out_odd[i], pos, need_ctx)

        x = x + gt1 * rms_norm(y_lat, g_mix_post[layer])
        f_lat = sq_relu_mlp(modulate(rms_norm(x, g_ffn_pre[layer]), sh2, sc2),
                            w_ffn_in[layer], w_ffn_out[layer])
        x = x + gt2 * rms_norm(f_lat, g_ffn_post[layer])

        if need_ctx:
            ctx = ctx + cgt1 * rms_norm(y_ctx, g_mix_post[layer])
            f_ctx = sq_relu_mlp(modulate(rms_norm(ctx, g_ffn_pre[layer]), csh2, csc2),
                                w_ffn_in[layer], w_ffn_out[layer])
            ctx = ctx + cgt2 * rms_norm(f_ctx, g_ffn_post[layer])
    return x
```

```cpp
#include <hip/hip_runtime.h>
#include <hip/hip_cooperative_groups.h>
#include <cstdio>
#include <cstdint>
namespace cg = cooperative_groups;
namespace pg8 {
#define PG8_LAS __attribute__((address_space(3)))
typedef unsigned short bf16_t;
typedef short bf16x8 __attribute__((ext_vector_type(8)));
typedef float f32x4 __attribute__((ext_vector_type(4)));
typedef unsigned u32x4 __attribute__((ext_vector_type(4)));
constexpr int BM = 256, BK = 64, HALF = 128, HTB = HALF * BK * 2  , STAGE_BYTES = 8 * HTB, NXCD = 8, WGM = 8;

__host__ __device__ __forceinline__ int lds_byte(int r, int c) { const int st = (r >> 4) * 2 + (c >> 5), rr = r & 15, cc = c & 31, ob = rr * 64 + cc * 2; return st * 1024 + (ob ^ (((ob >> 9) & 1) << 5)); }
__host__ __device__ __forceinline__ void stage_rc(int b, int& R, int& C) { const int st = b / 1024, sb = b % 1024, swz = sb ^ (((sb >> 9) & 1) << 5); R = (st >> 1) * 16 + swz / 64; C = (st & 1) * 32 + (swz % 64) / 2; }
__host__ __device__ __forceinline__ int perm32(int rho) { const int n = rho >> 4, i = rho & 15; return 8 * (i >> 2) + 4 * n + (i & 3); }

struct Unit { int pm, pn, kp; };
struct Gemm { const bf16_t* A; const bf16_t* Bt; int M, N, K, lda; };

struct StaticOrder {
    int nM, nN, nwg, G, c, skip;
    __host__ __device__ void init(int M, int N, int G_, int c_, int skip_ = 0) { skip = skip_; nM = skip_ ? (M / BM / 33) * 32 : M / BM; nN = N / BM; nwg = nM * nN; G = G_; c = c_; }
    __host__ __device__ bool next(int i, Unit& u) const {
        const long L = (long)i * G + c; if (L >= nwg) return false;
        int wgid = (int)L; { const int q = nwg / NXCD, r = nwg % NXCD, xcd = wgid % NXCD, off = wgid / NXCD; wgid = (xcd < r ? xcd * (q + 1) : r * (q + 1) + (xcd - r) * q) + off; }
        const int nig = WGM * nN, gid = wgid / nig, fm = gid * WGM, gsz = (nM - fm) < WGM ? (nM - fm) : WGM;
        u.kp = 0; u.pm = fm + ((wgid % nig) % gsz); u.pn = (wgid % nig) / gsz; if (skip) u.pm = (u.pm >> 5) * 33 + 1 + (u.pm & 31); return true;
    }
    __device__ __forceinline__ void a_ready(const Unit&) const {}
    __device__ __forceinline__ void done(const Unit&) const {}
};

struct CtxSplitOrder {
    int nN, NP, G, c;
    __host__ __device__ void init(int N, int NP_, int G_, int c_) { nN = N / BM; NP = NP_; G = G_; c = c_; }
    __host__ __device__ bool next(int i, Unit& u) const {
        const int L = i * G + c; if (L >= 8 * nN * NP) return false;
        u.kp = L % NP; const int rest = L / NP; u.pn = rest % nN; u.pm = (rest / nN) * 33; return true;
    }
    __device__ __forceinline__ void a_ready(const Unit&) const {}
    __device__ __forceinline__ void done(const Unit&) const {}
};

template <class Epi, class Sched, bool ALIGN_EPI, bool SP2, int KC, int LDAC, int LDBC = KC>
__device__ __forceinline__ void gemm_phase(PG8_LAS unsigned char* lds, const Gemm g, const Sched& S, const Epi& E, const int tid) {
    const int wid = __builtin_amdgcn_readfirstlane(tid >> 6), lane = tid & 63, wr = wid >> 2, wc = wid & 3, fr = lane & 15, fq = lane >> 4;
    constexpr int K = KC, nt = K / BK;
    unsigned voffA[2], voffB[2];
#pragma unroll
    for (int i = 0; i < 2; ++i) { int R, C; stage_rc(tid * 16 + i * 8192, R, C); const int Rb = Epi::PERM ? ((R & ~31) + perm32(R & 31)) : R;
        voffA[i] = (unsigned)(R * LDAC + C) * 2u; voffB[i] = (unsigned)(Rb * LDBC + C) * 2u; }
    const size_t kstep = (size_t)(BK * 2);
    const size_t hstepA = (size_t)HALF * LDAC * 2, hstepB = (size_t)HALF * LDBC * 2;
    const size_t tstepA = 2 * hstepA, tstepB = 2 * hstepB;
    const unsigned ldsw = (unsigned)wid * 1024u;
    const int aoff = lds_byte(wr * 64 + fr, fq * 8), boff = lds_byte(wc * 32 + fr, fq * 8);
#define PG8_SA(b, h) (((b) * 2 + (h)) * HTB)
#define PG8_SB(b, h) ((4 + (b) * 2 + (h)) * HTB)
#define PG8_STAGE(bufoff, gbase, voff) do { _Pragma("unroll") for (int _i = 0; _i < 2; ++_i) \
        __builtin_amdgcn_global_load_lds((const unsigned*)((const char*)(gbase) + (voff)[_i]), (PG8_LAS unsigned*)(lds + (bufoff) + ldsw + _i * 8192), 16, 0, 0); } while (0)
#define PG8_LDA(dst, b, h) do { _Pragma("unroll") for (int m = 0; m < 4; ++m) _Pragma("unroll") for (int k = 0; k < 2; ++k) dst[m][k] = *(const PG8_LAS bf16x8*)(lds + PG8_SA(b, h) + aoff + m * 2048 + k * 1024); } while (0)
#define PG8_LDB(dst, b, h) do { _Pragma("unroll") for (int n = 0; n < 2; ++n) _Pragma("unroll") for (int k = 0; k < 2; ++k) dst[n][k] = *(const PG8_LAS bf16x8*)(lds + PG8_SB(b, h) + boff + n * 2048 + k * 1024); } while (0)
#define PG8_MMA(ai, bj, At, Bt) do { __builtin_amdgcn_s_setprio(1); _Pragma("unroll") for (int m = 0; m < 4; ++m) _Pragma("unroll") for (int n = 0; n < 2; ++n) _Pragma("unroll") for (int k = 0; k < 2; ++k) \
        acc[ai][bj][m][n] = __builtin_amdgcn_mfma_f32_16x16x32_bf16(Bt[n][k], At[m][k], acc[ai][bj][m][n], 0, 0, 0); __builtin_amdgcn_s_setprio(0); } while (0)
#define PG8_WAIT_V(n) asm volatile("s_waitcnt vmcnt(" #n ")" ::: "memory")
#define PG8_WAIT_L(n) asm volatile("s_waitcnt lgkmcnt(" #n ")" ::: "memory")
#define PG8_BAR __builtin_amdgcn_s_barrier()
#define PG8_SCHED __builtin_amdgcn_sched_barrier(0)
    Unit cur, nxt; int ui = 0;
    if (!S.next(0, cur)) return;
    f32x4 acc[2][2][4][2];
#pragma unroll
    for (int a = 0; a < 2; ++a)
#pragma unroll
        for (int b = 0; b < 2; ++b)
#pragma unroll
            for (int m = 0; m < 4; ++m)
#pragma unroll
                for (int n = 0; n < 2; ++n) acc[a][b][m][n] = (f32x4){0.f, 0.f, 0.f, 0.f};
    bf16x8 At[4][2], B0[2][2], B1[2][2];
    const char* cA = (const char*)g.A + (size_t)cur.pm * tstepA + (size_t)cur.kp * (K * 2); const char* cB = (const char*)g.Bt + (size_t)cur.pn * tstepB + (size_t)cur.kp * (K * 2);
    S.a_ready(cur);
    if constexpr (SP2) {
        PG8_STAGE(PG8_SB(0, 0), cB, voffB); PG8_STAGE(PG8_SB(0, 1), cB + hstepB, voffB); PG8_STAGE(PG8_SA(0, 0), cA, voffA); PG8_STAGE(PG8_SA(0, 1), cA + hstepA, voffA);
        if (wr == 1) PG8_BAR;
        PG8_WAIT_V(2); PG8_BAR;
        PG8_STAGE(PG8_SB(1, 0), cB + kstep, voffB); PG8_STAGE(PG8_SA(1, 0), cA + kstep, voffA); PG8_STAGE(PG8_SB(1, 1), cB + hstepB + kstep, voffB);
        PG8_WAIT_V(6); PG8_BAR;
    } else {
        PG8_STAGE(PG8_SB(0, 0), cB, voffB); PG8_STAGE(PG8_SA(0, 0), cA, voffA); PG8_STAGE(PG8_SB(0, 1), cB + hstepB, voffB); PG8_STAGE(PG8_SA(0, 1), cA + hstepA, voffA);
        if (wr == 1) PG8_BAR;
        PG8_WAIT_V(4); PG8_BAR;
        PG8_STAGE(PG8_SB(1, 0), cB + kstep, voffB); PG8_STAGE(PG8_SA(1, 0), cA + kstep, voffA); PG8_STAGE(PG8_SB(1, 1), cB + hstepB + kstep, voffB);
        PG8_WAIT_V(6); PG8_BAR;
    }
    for (;;) {
        const bool has_next = S.next(ui + 1, nxt);
        const char* nA = has_next ? (const char*)g.A + (size_t)nxt.pm * tstepA + (size_t)nxt.kp * (K * 2) : cA; const char* nB = has_next ? (const char*)g.Bt + (size_t)nxt.pn * tstepB + (size_t)nxt.kp * (K * 2) : cB;
#pragma nounroll
        for (int t = 0; t < nt; t += 2) {
            const bool last = (t == nt - 2);
            const char* a1 = cA + (size_t)(t + 1) * kstep;
            const char* a2 = last ? nA : cA + (size_t)(t + 2) * kstep; const char* b2 = last ? nB : cB + (size_t)(t + 2) * kstep;
            const char* a3 = a2 + kstep; const char* b3 = b2 + kstep;
            if (last && has_next) S.a_ready(nxt);
            if constexpr (SP2) {
            PG8_LDB(B0, 0, 0); PG8_LDB(B1, 0, 1); PG8_SCHED; PG8_LDA(At, 0, 0); PG8_STAGE(PG8_SA(1, 1), a1 + hstepA, voffA);
            PG8_WAIT_V(8); PG8_WAIT_L(0); PG8_BAR; PG8_MMA(0, 0, At, B0); PG8_MMA(0, 1, At, B1); PG8_BAR; PG8_SCHED;
            PG8_LDA(At, 0, 1); PG8_STAGE(PG8_SB(0, 0), b2, voffB); PG8_STAGE(PG8_SB(0, 1), b2 + hstepB, voffB); PG8_STAGE(PG8_SA(0, 0), a2, voffA);
            PG8_WAIT_V(8); PG8_WAIT_L(0); PG8_BAR; PG8_MMA(1, 0, At, B0); PG8_MMA(1, 1, At, B1); PG8_BAR; PG8_SCHED;
            PG8_LDB(B0, 1, 0); PG8_LDB(B1, 1, 1); PG8_SCHED; PG8_LDA(At, 1, 0); PG8_STAGE(PG8_SA(0, 1), a2 + hstepA, voffA);
            PG8_WAIT_V(8); PG8_WAIT_L(0); PG8_BAR; PG8_MMA(0, 0, At, B0); PG8_MMA(0, 1, At, B1); PG8_BAR; PG8_SCHED;
            PG8_LDA(At, 1, 1); PG8_STAGE(PG8_SB(1, 0), b3, voffB); PG8_STAGE(PG8_SB(1, 1), b3 + hstepB, voffB); PG8_STAGE(PG8_SA(1, 0), a3, voffA);
            PG8_WAIT_V(8); PG8_WAIT_L(0); PG8_BAR; PG8_MMA(1, 0, At, B0); PG8_MMA(1, 1, At, B1); PG8_BAR; PG8_SCHED;
            } else {
            PG8_LDB(B0, 0, 0); PG8_SCHED; PG8_LDA(At, 0, 0); PG8_STAGE(PG8_SA(1, 1), a1 + hstepA, voffA);
            PG8_WAIT_L(8); PG8_BAR; PG8_WAIT_L(0); PG8_MMA(0, 0, At, B0); PG8_BAR; PG8_SCHED;
            PG8_LDB(B1, 0, 1); PG8_STAGE(PG8_SB(0, 0), b2, voffB);
            PG8_BAR; PG8_WAIT_L(0); PG8_MMA(0, 1, At, B1); PG8_BAR;
            PG8_LDA(At, 0, 1); PG8_STAGE(PG8_SA(0, 0), a2, voffA);
            PG8_BAR; PG8_WAIT_L(0); PG8_MMA(1, 0, At, B0); PG8_BAR; PG8_SCHED;
            PG8_STAGE(PG8_SB(0, 1), b2 + hstepB, voffB);
            PG8_WAIT_V(6); PG8_BAR; PG8_MMA(1, 1, At, B1); PG8_BAR;
            PG8_LDB(B0, 1, 0); PG8_SCHED; PG8_LDA(At, 1, 0); PG8_STAGE(PG8_SA(0, 1), a2 + hstepA, voffA);
            PG8_WAIT_L(8); PG8_BAR; PG8_WAIT_L(0); PG8_MMA(0, 0, At, B0); PG8_BAR; PG8_SCHED;
            PG8_LDB(B1, 1, 1); PG8_STAGE(PG8_SB(1, 0), b3, voffB);
            PG8_BAR; PG8_WAIT_L(0); PG8_MMA(0, 1, At, B1); PG8_BAR;
            PG8_LDA(At, 1, 1); PG8_STAGE(PG8_SA(1, 0), a3, voffA);
            PG8_BAR; PG8_WAIT_L(0); PG8_MMA(1, 0, At, B0); PG8_BAR; PG8_SCHED;
            PG8_STAGE(PG8_SB(1, 1), b3 + hstepB, voffB);
            PG8_WAIT_V(6); PG8_BAR; PG8_MMA(1, 1, At, B1); PG8_BAR;
            }
        }
        if constexpr (ALIGN_EPI) { if (wr == 0) PG8_BAR; }
        if constexpr (!Epi::AFTER_DRAIN) { int te = tid; asm volatile("" : "+v"(te)); E(acc, cur, wr, wc, te & 15, (te & 63) >> 4); S.done(cur); }
        if (!has_next) break;
#pragma unroll
        for (int a = 0; a < 2; ++a)
#pragma unroll
            for (int b = 0; b < 2; ++b)
#pragma unroll
                for (int m = 0; m < 4; ++m)
#pragma unroll
                    for (int n = 0; n < 2; ++n) acc[a][b][m][n] = (f32x4){0.f, 0.f, 0.f, 0.f};
        cur = nxt; cA = nA; cB = nB; ++ui;
        if constexpr (ALIGN_EPI) { if (wr == 1) PG8_BAR; }
    }
    PG8_WAIT_V(0);
    if constexpr (!ALIGN_EPI) { if (wr == 0) PG8_BAR; }
    PG8_BAR;
    if constexpr (Epi::AFTER_DRAIN) { E.fused(acc, cur, wr, wc, fr, fq, lds, wid, lane); S.done(cur); }
#undef PG8_SA
#undef PG8_SB
#undef PG8_STAGE
#undef PG8_LDA
#undef PG8_LDB
#undef PG8_MMA
#undef PG8_WAIT_V
#undef PG8_WAIT_L
#undef PG8_BAR
#undef PG8_SCHED
}
}


#define LAS __attribute__((address_space(3)))
typedef unsigned short bf16_t;
typedef short bf16x8 __attribute__((ext_vector_type(8)));
typedef float f32x4 __attribute__((ext_vector_type(4)));
typedef unsigned u32x4 __attribute__((ext_vector_type(4)));
typedef unsigned u32x2 __attribute__((ext_vector_type(2)));
typedef float f32x2_t __attribute__((ext_vector_type(2)));
typedef __bf16 bf16x2_t __attribute__((ext_vector_type(2)));

constexpr int DM = 1024, NB = 8, SEQL = 8192, CTXL = 256, SEGL = SEQL + CTXL  , T = NB * SEGL  ;
constexpr int DFF = 4096, NTHR = 512, NWAVE = 8;
constexpr float EPS = 1e-6f;
constexpr size_t MiB = 1u << 20;
constexpr size_t WS_MOD = 0;
constexpr size_t WS_TAB = 1 * MiB;
constexpr size_t WS_XC = 2 * MiB;
constexpr size_t WS_WFF1 = 10 * MiB, WS_WFF2 = 18 * MiB, WS_WA = 26 * MiB, WS_WB = 38 * MiB;
constexpr size_t WS_WUQ = 28 * MiB, WS_WUKV = WS_WUQ + 512 * 1024, WS_WPOOL = 29 * MiB;
constexpr size_t WS_H = 46 * MiB;
constexpr size_t WS_B0 = 178 * MiB;
constexpr size_t WS_UQN = 310 * MiB, WS_UKVN = 343 * MiB, WS_KR = 360 * MiB, WS_PD = 365 * MiB, WS_Q = 431 * MiB, WS_KV = 530 * MiB;
constexpr size_t WS_Y = 706 * MiB;
constexpr size_t WS_YP = 838 * MiB;
constexpr size_t WS_END = 970 * MiB;
constexpr size_t WS_BAR = 900 * 1024;
constexpr int LDS_BAR_OFF = 141312;
constexpr int LDS_BYTES = 143360;

struct Params {
  const float *x, *c, *ctx, *c_ctx, *w_ada, *b_ada, *g_mix_pre, *g_mix_post, *g_ffn_pre, *g_ffn_post, *w_ffn_in, *w_ffn_out, *w_in_even, *g_q_lora, *g_kv_lora,
      *w_uq, *w_ukv, *w_pool, *pool_scale, *w_out_even, *w_in_odd, *w_out_odd;
  float* out; unsigned char* ws; int lo, hi;
};

__device__ __forceinline__ unsigned cvtpk(float lo, float hi) { f32x2_t v = {lo, hi}; bf16x2_t b = __builtin_convertvector(v, bf16x2_t); return __builtin_bit_cast(unsigned, b); }
__device__ __forceinline__ float bflo(unsigned u) { return __uint_as_float(u << 16); }
__device__ __forceinline__ float bfhi(unsigned u) { return __uint_as_float(u & 0xffff0000u); }
__device__ __forceinline__ bf16_t f2bf(float f) { return (bf16_t)(cvtpk(f, 0.f) & 0xffffu); }
__device__ __forceinline__ float wave_sum(float v) {
#pragma unroll
  for (int o = 1; o < 64; o <<= 1) v += __shfl_xor(v, o);
  return v;
}
__device__ __forceinline__ f32x4 mfma16(bf16x8 a, bf16x8 b, f32x4 c) { return __builtin_amdgcn_mfma_f32_16x16x32_bf16(a, b, c, 0, 0, 0); }

template <int mode, int ldc, int col_off> struct Epi {
  static constexpr bool PERM = true, AFTER_DRAIN = false;
  bf16_t* O; const float* cs; const float* tab; float scale;
  __device__ __forceinline__ void operator()(const f32x4 (&acc)[2][2][4][2], const pg8::Unit& u, int wr, int wc, int fr, int fq) const {
    const int seg = u.pm % 33; const bool islat = seg != 0;
    const int colt = u.pn * 256 + wc * 32 + 8 * fq;
#pragma unroll
    for (int ai = 0; ai < 2; ++ai)
#pragma unroll
      for (int m = 0; m < 4; ++m) {
        const int lrow = ai * 128 + wr * 64 + m * 16 + fr;
        const int row = u.pm * 256 + lrow;
        const int tok = (seg - 1) * 256 + lrow;
        bf16_t* rowp = O + (size_t)row * ldc + col_off;
#pragma unroll
        for (int bj = 0; bj < 2; ++bj) {
          const int c = colt + bj * 128;
          f32x4 v0 = acc[ai][bj][m][0], v1 = acc[ai][bj][m][1];
          if (mode == 5) {
            float* pp = (float*)O + ((size_t)(u.kp * 2048 + (u.pm / 33) * 256 + lrow) * 1024 + c);
            *(f32x4*)pp = v0; *(f32x4*)(pp + 4) = v1;
            continue;
          }
          if (mode == 1) {
#pragma unroll
            for (int i = 0; i < 4; ++i) { float a = fmaxf(v0[i], 0.f), b = fmaxf(v1[i], 0.f); v0[i] = a * a; v1[i] = b * b; }
          } else if (mode == 2) {
            const int hc = c % 96;
            if (islat && hc >= 64) {
              const int j = hc - 64, part = j >> 4, g = (j & 15) >> 3, pos = part ? (tok & 63) : (tok >> 6);
              const f32x4 cs4 = *(const f32x4*)(tab + pos * 8 + 4 * g), sn4 = *(const f32x4*)(tab + 1024 + pos * 8 + 4 * g);
              const f32x4 o0 = v0 * cs4 - v1 * sn4, o1 = v0 * sn4 + v1 * cs4; v0 = o0; v1 = o1;
            }
            v0 = v0 * scale; v1 = v1 * scale;
          } else if (mode == 3) {
            if (u.pn < 8) {
              if (islat) {
                const int hc = c & 127, part = hc >> 6, g = (hc & 63) >> 3, pos = part ? (tok & 63) : (tok >> 6);
                const f32x4 cs4 = *(const f32x4*)(tab + pos * 32 + 4 * g), sn4 = *(const f32x4*)(tab + 4096 + pos * 32 + 4 * g);
                const f32x4 o0 = v0 * cs4 - v1 * sn4, o1 = v0 * sn4 + v1 * cs4; v0 = o0; v1 = o1;
              }
              if (u.pn >= 4) { v0 = v0 * scale; v1 = v1 * scale; }
            }
          } else if (mode == 4) {
            const u32x4 old = *(const u32x4*)(rowp + c);
            const float ov[8] = {bflo(old.x), bfhi(old.x), bflo(old.y), bfhi(old.y), bflo(old.z), bfhi(old.z), bflo(old.w), bfhi(old.w)};
#pragma unroll
            for (int i = 0; i < 4; ++i) { const float a = v0[i], b = v1[i]; v0[i] = a / (1.f + __expf(-a)) * ov[i]; v1[i] = b / (1.f + __expf(-b)) * ov[4 + i]; }
          } else if (cs) {
            const f32x4 s0 = *(const f32x4*)(cs + c), s1 = *(const f32x4*)(cs + c + 4); v0 = v0 * s0; v1 = v1 * s1;
          }
          u32x4 w; w.x = cvtpk(v0[0], v0[1]); w.y = cvtpk(v0[2], v0[3]); w.z = cvtpk(v1[0], v1[1]); w.w = cvtpk(v1[2], v1[3]);
          *(u32x4*)(rowp + c) = w;
        }
      }
  }
};

__device__ __forceinline__ int src_col(int n, int mode) {
  if (mode == 1) { const int hc = n % 96; if (hc >= 64) { const int j = (hc - 64) & 15, g = j >> 3, i = j & 7; return n - j + ((i < 4) ? 4 * g + i : 8 + 4 * g + (i - 4)); } return n; }
  if (mode == 2) { if (n < 2048) { const int j = n & 63, g = j >> 3, i = j & 7; return n - j + ((i < 4) ? 4 * g + i : 32 + 4 * g + (i - 4)); } return n; }
  return n;
}
__device__ __forceinline__ void tr_item(const float* W, int K, int N, bf16_t* WT, int ldk, int mode, LAS float* scr, int item, int lane) {
  const int nblk = N / 32, kb = item / nblk, nb = item % nblk, k0 = 64 * kb, n0 = 32 * nb;
  const int sc = src_col(n0 + (lane & 31), mode);
#pragma unroll 8
  for (int i = 0; i < 32; ++i) { const int kk = 2 * i + (lane >> 5); scr[kk * 33 + (lane & 31)] = W[(size_t)(k0 + kk) * N + sc]; }
  asm volatile("s_waitcnt lgkmcnt(0)" ::: "memory");
  const int c = lane & 7;
#pragma unroll
  for (int j = 0; j < 4; ++j) { const int n = (lane >> 3) + 8 * j; const LAS float* s = scr + (8 * c) * 33 + n;
    u32x4 o; o.x = cvtpk(s[0 * 33], s[1 * 33]); o.y = cvtpk(s[2 * 33], s[3 * 33]); o.z = cvtpk(s[4 * 33], s[5 * 33]); o.w = cvtpk(s[6 * 33], s[7 * 33]);
    *(u32x4*)(WT + (size_t)(n0 + n) * ldk + k0 + 8 * c) = o; }
  asm volatile("s_waitcnt lgkmcnt(0)" ::: "memory");
}
__device__ __forceinline__ void conv_mat(const float* W, int K, int N, bf16_t* WT, int mode, LAS float* scr, int gw, int ngw, int lane, int ldk = 0) {
  const int items = (K / 64) * (N / 32);
  for (int it = gw; it < items; it += ngw) tr_item(W, K, N, WT, ldk ? ldk : K, mode, scr, it, lane);
}
__device__ __forceinline__ void conv_pool(const float* Wp, bf16_t* WT, LAS float* scr, int gw, int ngw, int lane) {
  for (int it = gw; it < 8 * 16; it += ngw) {
    const int kb = it / 16, nb = it % 16, k0 = 64 * kb, n0 = 32 * nb, gk = k0 >> 7, gn = n0 >> 7;
    if (gk == gn) {
      const float* W = Wp + (size_t)gk * 128 * 128;
#pragma unroll 8
      for (int i = 0; i < 32; ++i) { const int kk = 2 * i + (lane >> 5); scr[kk * 33 + (lane & 31)] = W[(size_t)(k0 - gk * 128 + kk) * 128 + (n0 - gn * 128) + (lane & 31)]; }
    } else {
#pragma unroll 8
      for (int i = 0; i < 32; ++i) { const int kk = 2 * i + (lane >> 5); scr[kk * 33 + (lane & 31)] = 0.f; }
    }
    asm volatile("s_waitcnt lgkmcnt(0)" ::: "memory");
    const int c = lane & 7;
#pragma unroll
    for (int j = 0; j < 4; ++j) { const int n = (lane >> 3) + 8 * j; const LAS float* s = scr + (8 * c) * 33 + n;
      u32x4 o; o.x = cvtpk(s[0 * 33], s[1 * 33]); o.y = cvtpk(s[2 * 33], s[3 * 33]); o.z = cvtpk(s[4 * 33], s[5 * 33]); o.w = cvtpk(s[6 * 33], s[7 * 33]);
      *(u32x4*)(WT + (size_t)(n0 + n) * 512 + k0 + 8 * c) = o; }
    asm volatile("s_waitcnt lgkmcnt(0)" ::: "memory");
  }
}
__device__ __forceinline__ void conv_layer(const Params& p, int L, LAS unsigned char* lds, int gw, int ngw, int wid, int lane) {
  LAS float* scr = (LAS float*)(lds + wid * 16384);
  unsigned char* ws = p.ws; const int i = L >> 1;
  conv_mat(p.w_ffn_in + (size_t)L * DM * DFF, DM, DFF, (bf16_t*)(ws + WS_WFF1), 0, scr, gw, ngw, lane);
  conv_mat(p.w_ffn_out + (size_t)L * DFF * DM, DFF, DM, (bf16_t*)(ws + WS_WFF2), 0, scr, gw, ngw, lane);
  if ((L & 1) == 0) {
    conv_mat(p.w_in_even + (size_t)i * DM * 928, DM, 928, (bf16_t*)(ws + WS_WA), 0, scr, gw, ngw, lane);
    conv_mat(p.w_uq + (size_t)i * 256 * 768, 256, 768, (bf16_t*)(ws + WS_WUQ), 1, scr, gw, ngw, lane);
    conv_mat(p.w_ukv + (size_t)i * 128 * 1024, 128, 1024, (bf16_t*)(ws + WS_WUKV), 0, scr, gw, ngw, lane, 256);
    for (int e = gw * 64 + lane; e < 1024 * 16; e += ngw * 64) { const int n = e >> 4, c = e & 15; *(u32x4*)((bf16_t*)(ws + WS_WUKV) + (size_t)n * 256 + 128 + c * 8) = (u32x4){0u, 0u, 0u, 0u}; }
    conv_pool(p.w_pool + (size_t)i * 4 * 128 * 128, (bf16_t*)(ws + WS_WPOOL), scr, gw, ngw, lane);
    conv_mat(p.w_out_even + (size_t)i * 1024 * 1024, 1024, 1024, (bf16_t*)(ws + WS_WB), 0, scr, gw, ngw, lane);
  } else {
    conv_mat(p.w_in_odd + (size_t)i * DM * 6144, DM, 6144, (bf16_t*)(ws + WS_WA), 2, scr, gw, ngw, lane);
    conv_mat(p.w_out_odd + (size_t)i * 2048 * 1024, 2048, 1024, (bf16_t*)(ws + WS_WB), 0, scr, gw, ngw, lane);
  }
}

__device__ __forceinline__ void p0_phase(const Params& p, LAS unsigned char* lds, const int tid, const int bid) {
  const int G = gridDim.x, lane = tid & 63, wid = tid >> 6;
  float* mod = (float*)(p.ws + WS_MOD);
  LAS float* sc = (LAS float*)lds;
  LAS float* part = (LAS float*)(lds + 9 * 1024 * 4);
  for (int e = tid; e < 9 * 1024; e += NTHR) { const int r = e >> 10, k = e & 1023; const float v = (r < 8) ? p.c[r * DM + k] : p.c_ctx[k]; sc[e] = v / (1.f + expf(-v)); }
  __syncthreads();
  for (int it = bid; it < 4 * 96; it += G) {
    const int L = it / 96, col0 = (it % 96) * 64;
    float a0 = 0, a1 = 0, a2 = 0, a3 = 0, a4 = 0, a5 = 0, a6 = 0, a7 = 0, a8 = 0;
    const float* wp = p.w_ada + ((size_t)L * DM + wid * 128) * 6144 + col0 + lane;
    const LAS float* s0 = sc + wid * 128;
#pragma unroll 16
    for (int k = 0; k < 128; ++k) { const float w = wp[(size_t)k * 6144];
      a0 += s0[k] * w; a1 += s0[1024 + k] * w; a2 += s0[2048 + k] * w; a3 += s0[3072 + k] * w; a4 += s0[4096 + k] * w; a5 += s0[5120 + k] * w; a6 += s0[6144 + k] * w; a7 += s0[7168 + k] * w; a8 += s0[8192 + k] * w; }
    LAS float* pp = part + wid * 9 * 64 + lane;
    pp[0] = a0; pp[64] = a1; pp[128] = a2; pp[192] = a3; pp[256] = a4; pp[320] = a5; pp[384] = a6; pp[448] = a7; pp[512] = a8;
    __syncthreads();
    for (int e = tid; e < 9 * 64; e += NTHR) { const int r = e >> 6, cl = e & 63; float v = p.b_ada[L * 6144 + col0 + cl];
#pragma unroll
      for (int w = 0; w < 8; ++w) v += part[w * 9 * 64 + e];
      mod[((size_t)L * 9 + r) * 6144 + col0 + cl] = v; }
    __syncthreads();
  }
  float* tab = (float*)(p.ws + WS_TAB);
  for (int e = bid * NTHR + tid; e < 1024 + 4096; e += G * NTHR) {
    if (e < 1024) { const int pos = e >> 3, i = e & 7; const float fr = powf(10000.f, -(float)(2 * i) / 16.f), a = (float)pos * fr; tab[e] = cosf(a); tab[1024 + e] = sinf(a); }
    else { const int q = e - 1024, pos = q >> 5, i = q & 31; const float fr = powf(10000.f, -(float)(2 * i) / 64.f), a = (float)pos * fr; tab[2048 + q] = cosf(a); tab[2048 + 4096 + q] = sinf(a); }
  }
}

__device__ __forceinline__ const float* xrow_ptr(const float* xl, const float* xc, int r) {
  const int b = r / SEGL, w = r % SEGL;
  return (w < CTXL) ? xc + (size_t)(b * CTXL + w) * DM : xl + (size_t)(b * SEQL + (w - CTXL)) * DM;
}
__device__ __forceinline__ void norm_phase(const Params& p, bool first, bool has_res, bool final_, const float* gpost, const float* gate_mod  ,
                                            const float* gpre, const float* shsc_mod  , int gw, int ngw, int lane, bool dry = false, const float* ysplit = nullptr) {
  const bf16_t* Y = (const bf16_t*)(p.ws + WS_Y); bf16_t* H = (bf16_t*)(p.ws + WS_H); float* XC = (float*)(p.ws + WS_XC);
  const float* xl = first ? p.x : p.out; const float* xc = first ? p.ctx : XC;
  const int rbeg = gw, rend = T, rstep = ngw;
  if (rbeg >= rend) return;
  int cur_m = -1;
  f32x4 cres[4], ca[4], csh[4];
#pragma unroll
  for (int j = 0; j < 4; ++j) { cres[j] = (f32x4){0.f, 0.f, 0.f, 0.f}; ca[j] = cres[j]; csh[j] = cres[j]; }
  f32x4 nx[4]; u32x2 ny[4];
  { const float* xs = xrow_ptr(xl, xc, rbeg);
#pragma unroll
    for (int j = 0; j < 4; ++j) { nx[j] = __builtin_nontemporal_load(((const f32x4*)xs) + lane + 64 * j); ny[j] = has_res ? __builtin_nontemporal_load(((const u32x2*)(Y + (size_t)rbeg * DM)) + lane + 64 * j) : (u32x2){0u, 0u}; } }
  for (int r = rbeg; r < rend; r += rstep) {
    const int b = r / SEGL, w = r % SEGL; const bool isctx = w < CTXL;
    float* xd = (isctx ? XC + (size_t)(b * CTXL + w) * DM : p.out + (size_t)(b * SEQL + (w - CTXL)) * DM);
    const int mrow = isctx ? 8 : b;
    f32x4 v[4]; u32x2 yq[4];
#pragma unroll
    for (int j = 0; j < 4; ++j) { v[j] = nx[j]; yq[j] = ny[j]; }
    if (r + rstep < rend) { const float* xs = xrow_ptr(xl, xc, r + rstep);
#pragma unroll
      for (int j = 0; j < 4; ++j) { nx[j] = __builtin_nontemporal_load(((const f32x4*)xs) + lane + 64 * j); if (has_res) ny[j] = __builtin_nontemporal_load(((const u32x2*)(Y + (size_t)(r + rstep) * DM)) + lane + 64 * j); } }
    if (final_ && isctx) continue;
    if (mrow != cur_m) { cur_m = mrow;
#pragma unroll
      for (int j = 0; j < 4; ++j) {
        if (has_res) cres[j] = ((const f32x4*)gpost)[lane + 64 * j] * ((const f32x4*)(gate_mod + (size_t)mrow * 6144))[lane + 64 * j];
        if (!final_) { ca[j] = ((const f32x4*)gpre)[lane + 64 * j] * (((const f32x4*)(shsc_mod + (size_t)mrow * 6144 + 1024))[lane + 64 * j] + 1.f); csh[j] = ((const f32x4*)(shsc_mod + (size_t)mrow * 6144))[lane + 64 * j]; } } }
    if (has_res) {
      f32x4 y[4]; float ss = 0.f;
#pragma unroll
      for (int j = 0; j < 4; ++j) y[j] = (f32x4){bflo(yq[j].x), bfhi(yq[j].x), bflo(yq[j].y), bfhi(yq[j].y)};
      if (ysplit && isctx) {
        const float* yp = ysplit + (size_t)(b * CTXL + w) * DM;
#pragma unroll
        for (int j = 0; j < 4; ++j) y[j] = ((const f32x4*)yp)[lane + 64 * j];
#pragma unroll 1
        for (int k = 1; k < 8; ++k) {
#pragma unroll
          for (int j = 0; j < 4; ++j) y[j] = y[j] + ((const f32x4*)(yp + (size_t)k * 2048 * DM))[lane + 64 * j]; }
      }
#pragma unroll
      for (int j = 0; j < 4; ++j) ss += (y[j].x * y[j].x + y[j].y * y[j].y) + (y[j].z * y[j].z + y[j].w * y[j].w);
      const float rs = rsqrtf(wave_sum(ss) * (1.f / DM) + EPS);
#pragma unroll
      for (int j = 0; j < 4; ++j) v[j] = v[j] + cres[j] * (y[j] * rs);
    }
    if ((has_res || first) && !dry) {
#pragma unroll
      for (int j = 0; j < 4; ++j) __builtin_nontemporal_store(v[j], ((f32x4*)xd) + lane + 64 * j);
    }
    if (!final_) {
      float ss = 0.f;
#pragma unroll
      for (int j = 0; j < 4; ++j) ss += (v[j].x * v[j].x + v[j].y * v[j].y) + (v[j].z * v[j].z + v[j].w * v[j].w);
      const float rs = rsqrtf(wave_sum(ss) * (1.f / DM) + EPS);
#pragma unroll
      for (int j = 0; j < 4; ++j) { const f32x4 h = (v[j] * rs) * ca[j] + csh[j];
        u32x2 o; o.x = cvtpk(h.x, h.y); o.y = cvtpk(h.z, h.w); __builtin_nontemporal_store(o, ((u32x2*)(H + (size_t)r * DM)) + lane + 64 * j); }
    }
  }
}

__device__ __forceinline__ void mid_phase(const Params& p, int i, int gw, int ngw, int lane) {
  const bf16_t* U = (const bf16_t*)(p.ws + WS_B0); bf16_t* UQN = (bf16_t*)(p.ws + WS_UQN); bf16_t* UKVN = (bf16_t*)(p.ws + WS_UKVN); bf16_t* KR = (bf16_t*)(p.ws + WS_KR); bf16_t* PD = (bf16_t*)(p.ws + WS_PD);
  const float* tab = (const float*)(p.ws + WS_TAB);
  const float* gq = p.g_q_lora + i * 256; const float* gkv = p.g_kv_lora + i * 128;
  for (int r = gw; r < T; r += ngw) {
    const int w = r % SEGL; const bool isctx = w < CTXL; const int t = isctx ? w : w - CTXL, Lseg = isctx ? CTXL : SEQL;
    const bf16_t* ur = U + (size_t)r * 1024;
    {
      const u32x2 q = ((const u32x2*)ur)[lane]; const float a0 = bflo(q.x), a1 = bfhi(q.x), a2 = bflo(q.y), a3 = bfhi(q.y);
      const float rs = rsqrtf(wave_sum(a0 * a0 + a1 * a1 + a2 * a2 + a3 * a3) * (1.f / 256.f) + EPS);
      const f32x4 g = ((const f32x4*)gq)[lane]; u32x2 o; o.x = cvtpk(a0 * rs * g.x, a1 * rs * g.y); o.y = cvtpk(a2 * rs * g.z, a3 * rs * g.w);
      ((u32x2*)(UQN + (size_t)r * 256))[lane] = o; }
    {
      const unsigned q = ((const unsigned*)(ur + 256))[lane]; const float a0 = bflo(q), a1 = bfhi(q);
      const float rs = rsqrtf(wave_sum(a0 * a0 + a1 * a1) * (1.f / 128.f) + EPS);
      ((unsigned*)(UKVN + (size_t)r * 128))[lane] = cvtpk(a0 * rs * gkv[2 * lane], a1 * rs * gkv[2 * lane + 1]); }
    {
      const int j = lane & 31; const float val = bflo((unsigned)ur[384 + j]); const float pv = __shfl_xor(val, 8);
      const int part = j >> 4, jj = j & 15, isx2 = jj >> 3, fi = jj & 7;
      float o = val;
      if (!isctx) { const int pos = part ? (t & 63) : (t >> 6); const float cs = tab[pos * 8 + fi], sn = tab[1024 + pos * 8 + fi]; o = isx2 ? (pv * sn + val * cs) : (val * cs - pv * sn); }
      const int dst = part * 16 + 8 * (fi >> 2) + (fi & 3) + 4 * isx2;
      if (lane < 32) KR[(size_t)r * 32 + dst] = f2bf(o); }
    {
      const int g = lane >> 4, wn = 2 << g; const int lo = max(t - (wn >> 1), 0), hi = min(t + wn - (wn >> 1), Lseg);
      float s[8] = {0, 0, 0, 0, 0, 0, 0, 0};
      const bf16_t* base = ur + 416 + lane * 8;
#pragma unroll
      for (int k = 0; k < 16; ++k) { const int q = t - 8 + k;
        if (q >= lo && q < hi) { const u32x4 d = *(const u32x4*)(base + (ptrdiff_t)(q - t) * 1024);
          s[0] += bflo(d.x); s[1] += bfhi(d.x); s[2] += bflo(d.y); s[3] += bfhi(d.y); s[4] += bflo(d.z); s[5] += bfhi(d.z); s[6] += bflo(d.w); s[7] += bfhi(d.w); } }
      const u32x4 own = *(const u32x4*)base; const float inv = 1.f / (float)(hi - lo);
      u32x4 o; o.x = cvtpk(s[0] * inv - bflo(own.x), s[1] * inv - bfhi(own.x)); o.y = cvtpk(s[2] * inv - bflo(own.y), s[3] * inv - bfhi(own.y));
      o.z = cvtpk(s[4] * inv - bflo(own.z), s[5] * inv - bfhi(own.z)); o.w = cvtpk(s[6] * inv - bflo(own.w), s[7] * inv - bfhi(own.w));
      *(u32x4*)(PD + (size_t)r * 512 + lane * 8) = o; }
  }
}

__device__ __forceinline__ void gn_phase(const Params& p, int gw, int ngw, int lane) {
  bf16_t* U = (bf16_t*)(p.ws + WS_B0);
  for (int r = gw; r < T; r += ngw) {
#pragma unroll
    for (int i = 0; i < 4; ++i) {
      bf16_t* ptr = U + (size_t)r * 4096 + 2048 + (i * 64 + lane) * 8;
      const u32x4 d = *(const u32x4*)ptr;
      float v[8] = {bflo(d.x), bfhi(d.x), bflo(d.y), bfhi(d.y), bflo(d.z), bfhi(d.z), bflo(d.w), bfhi(d.w)};
      float s = ((v[0] + v[1]) + (v[2] + v[3])) + ((v[4] + v[5]) + (v[6] + v[7]));
#pragma unroll
      for (int o = 1; o < 32; o <<= 1) s += __shfl_xor(s, o);
      const float mu = s * (1.f / 256.f); float q = 0.f;
#pragma unroll
      for (int e = 0; e < 8; ++e) { v[e] -= mu; q += v[e] * v[e]; }
#pragma unroll
      for (int o = 1; o < 32; o <<= 1) q += __shfl_xor(q, o);
      const float rs = rsqrtf(q * (1.f / 256.f) + EPS);
      u32x4 w; w.x = cvtpk(v[0] * rs, v[1] * rs); w.y = cvtpk(v[2] * rs, v[3] * rs); w.z = cvtpk(v[4] * rs, v[5] * rs); w.w = cvtpk(v[6] * rs, v[7] * rs);
      *(u32x4*)ptr = w;
    }
  }
}

#define XB_TMO      128
#define XB_XCNT(j)  (256  + 64 * (j))
#define XB_XSUB(j)  (1280 + 64 * (j))
#define XB_XGEN(j)  (2304 + 64 * (j))
#define XB_TOP      3328
#define XB_TOPGEN   3392
#define XCD_BAR_WORDS 3456
#define XB_SPIN_CAP (1u << 18)

__device__ __forceinline__ unsigned xb_ld(unsigned* p)              { return __hip_atomic_load(p, __ATOMIC_RELAXED, __HIP_MEMORY_SCOPE_AGENT); }
__device__ __forceinline__ unsigned xb_add(unsigned* p, unsigned v) { return __hip_atomic_fetch_add(p, v, __ATOMIC_RELAXED, __HIP_MEMORY_SCOPE_AGENT); }
__device__ __forceinline__ unsigned xb_xcc_id() { return (unsigned)__builtin_amdgcn_s_getreg((3 << 11) | 20) & 0xFu; }
#define XB_SPIN(cond, bar) do { unsigned _sp = 0; while (cond) { __builtin_amdgcn_s_sleep(1); \
    if ((++_sp & 255u) == 0u) { if (xb_ld(&(bar)[XB_TMO])) break; if (_sp > XB_SPIN_CAP) { atomicAdd(&(bar)[XB_TMO], 1u); break; } } } } while (0)

struct XcdBarrier {
    unsigned* bar; unsigned x;
    volatile LAS unsigned* st;
};

__device__ __forceinline__ XcdBarrier xcd_barrier_post(unsigned* bar, volatile LAS unsigned* st) {
    XcdBarrier b; b.bar = bar; b.x = xb_xcc_id(); b.st = st;
    if (threadIdx.x == 0) (void)xb_add(&bar[XB_XCNT(b.x)], 1u);
    return b;
}
__device__ __forceinline__ void xcd_barrier_complete(unsigned* bar, unsigned x, unsigned& nloc, unsigned& nx) {
    const unsigned G = gridDim.x * gridDim.y * gridDim.z;
    unsigned sum, cnt, mine, sp = 0u;
    for (;;) {
        sum = 0u; cnt = 0u; mine = 0u;
#pragma unroll
        for (unsigned j = 0; j < 16; ++j) { const unsigned c = xb_ld(&bar[XB_XCNT(j)]); sum += c; cnt += (c > 0u) ? 1u : 0u; mine = (j == x) ? c : mine; }
        if (sum == G) break;
        __builtin_amdgcn_s_sleep(1);
        if ((++sp & 255u) == 0u) { if (xb_ld(&bar[XB_TMO])) break; if (sp > XB_SPIN_CAP) { atomicAdd(&bar[XB_TMO], 1u); break; } }
    }
    nloc = mine > 0u ? mine : 1u; nx = cnt > 0u ? cnt : 1u;
}

__device__ __forceinline__ void xcd_barrier(const XcdBarrier& b) {
    asm volatile("s_waitcnt vmcnt(0)" ::: "memory");
    __syncthreads();
    if (threadIdx.x == 0) {
        unsigned* bar = b.bar;
        __builtin_amdgcn_s_waitcnt(0);
        unsigned nloc = b.st[0], nx = b.st[1];
        if (nloc == 0u) { xcd_barrier_complete(bar, b.x, nloc, nx); b.st[0] = nloc; b.st[1] = nx; }
        const unsigned old = xb_add(&bar[XB_XSUB(b.x)], 1u);
        const unsigned gen = old / nloc;
        if (old + 1u == (gen + 1u) * nloc) {
            __builtin_amdgcn_fence(__ATOMIC_RELEASE, "agent");
            asm volatile("s_waitcnt vmcnt(0)" ::: "memory");
            const unsigned og = xb_add(&bar[XB_TOP], 1u);
            const unsigned tg = og / nx;
            if (og + 1u == (tg + 1u) * nx) xb_add(&bar[XB_TOPGEN], 1u);
            else XB_SPIN(xb_ld(&bar[XB_TOPGEN]) == tg, bar);
            __builtin_amdgcn_fence(__ATOMIC_ACQUIRE, "agent");
            xb_add(&bar[XB_XGEN(b.x)], 1u);
            asm volatile("s_waitcnt vmcnt(0)" ::: "memory");
        } else {
            XB_SPIN(xb_ld(&bar[XB_XGEN(b.x)]) == gen, bar);
            __builtin_amdgcn_fence(__ATOMIC_ACQUIRE, "agent");
            asm volatile("s_waitcnt vmcnt(0)" ::: "memory");
        }
    }
    __syncthreads();
}

typedef short v4i16_t __attribute__((ext_vector_type(4)));
__device__ __forceinline__ u32x2 tr_rd(const LAS bf16_t* p) { return __builtin_bit_cast(u32x2, __builtin_amdgcn_ds_read_tr16_b64_v4i16((LAS v4i16_t*)p)); }
constexpr int AT_KSTR = 104, AT_VSTR = 72, AT_BUF = 64 * AT_KSTR * 2 + 64 * AT_VSTR * 2;
__device__ __forceinline__ void attn_stage(LAS unsigned char* buf, int tid, u32x4 rk, u32x4 rv, u32x4 rr) {
  LAS bf16_t* Ks = (LAS bf16_t*)buf; LAS bf16_t* Vs = (LAS bf16_t*)(buf + 64 * AT_KSTR * 2);
  const int skey = tid >> 3, sch = tid & 7;
  *(LAS u32x4*)(Ks + skey * AT_KSTR + sch * 8) = rk;
  if (tid < 256) { const int rkey = tid >> 2, rch = tid & 3; *(LAS u32x4*)(Ks + rkey * AT_KSTR + 64 + rch * 8) = rr; }
  *(LAS u32x4*)(Vs + skey * AT_VSTR + sch * 8) = rv;
}
__device__ __forceinline__ void attn_unit(LAS unsigned char* lds, const bf16_t* Q, const bf16_t* KV, const bf16_t* KR, bf16_t* MIX, size_t qrow0, size_t krow0, int ntiles, int h, const int tid) {
  const int lane = tid & 63, wid = tid >> 6, c16 = lane & 15, quad = lane >> 4, tq = (lane & 15) >> 2, tp = lane & 3;
  const bf16_t* gk = KV + (krow0 + (tid >> 3)) * 1024 + h * 128 + (tid & 7) * 8;
  const bf16_t* gr = KR + (krow0 + ((tid & 255) >> 2)) * 32 + (tid & 3) * 8;
  bf16x8 qf[2][3];
#pragma unroll
  for (int qb = 0; qb < 2; ++qb)
#pragma unroll
    for (int ks = 0; ks < 3; ++ks) qf[qb][ks] = *(const bf16x8*)(Q + (qrow0 + wid * 32 + qb * 16 + c16) * 768 + h * 96 + ks * 32 + quad * 8);
  f32x4 o[2][4];
#pragma unroll
  for (int qb = 0; qb < 2; ++qb)
#pragma unroll
    for (int eb = 0; eb < 4; ++eb) o[qb][eb] = (f32x4){0.f, 0.f, 0.f, 0.f};
  float mref[2] = {0.f, 0.f}; f32x4 lacc[2] = {(f32x4){0.f, 0.f, 0.f, 0.f}, (f32x4){0.f, 0.f, 0.f, 0.f}};
  const bf16x8 ones = (bf16x8){0x3F80, 0x3F80, 0x3F80, 0x3F80, 0x3F80, 0x3F80, 0x3F80, 0x3F80};
  u32x4 rk = *(const u32x4*)gk, rv = *(const u32x4*)(gk + 64), rr = (u32x4){0, 0, 0, 0};
  if (tid < 256) rr = *(const u32x4*)gr;
  __syncthreads();
  attn_stage(lds, tid, rk, rv, rr);
  __syncthreads();
  for (int t = 0; t < ntiles; ++t) {
    LAS unsigned char* buf = lds + (t & 1) * AT_BUF;
    const bool more = (t + 1 < ntiles);
    if (more) { const bf16_t* g2 = gk + (size_t)(t + 1) * 64 * 1024; rk = *(const u32x4*)g2; rv = *(const u32x4*)(g2 + 64); if (tid < 256) rr = *(const u32x4*)(gr + (size_t)(t + 1) * 64 * 32); }
    const LAS bf16_t* Ks = (const LAS bf16_t*)buf; const LAS bf16_t* Vs = (const LAS bf16_t*)(buf + 64 * AT_KSTR * 2);
    f32x4 s[4][2];
#pragma unroll
    for (int kb = 0; kb < 4; ++kb) {
      bf16x8 kf[3];
#pragma unroll
      for (int ks = 0; ks < 3; ++ks) kf[ks] = *(const LAS bf16x8*)(Ks + (kb * 16 + c16) * AT_KSTR + ks * 32 + quad * 8);
      __builtin_amdgcn_s_setprio(1);
#pragma unroll
      for (int qb = 0; qb < 2; ++qb) { const float nm = -mref[qb]; f32x4 a = (f32x4){nm, nm, nm, nm};
#pragma unroll
        for (int ks = 0; ks < 3; ++ks) a = mfma16(kf[ks], qf[qb][ks], a);
        s[kb][qb] = a; }
      __builtin_amdgcn_s_setprio(0);
    }
#pragma unroll
    for (int qb = 0; qb < 2; ++qb) {
      float mx = -1e30f;
#pragma unroll
      for (int kb = 0; kb < 4; ++kb) mx = fmaxf(fmaxf(fmaxf(s[kb][qb][0], s[kb][qb][1]), fmaxf(s[kb][qb][2], s[kb][qb][3])), mx);
      mx = fmaxf(mx, __shfl_xor(mx, 16)); mx = fmaxf(mx, __shfl_xor(mx, 32));
      if (t == 0 || __any(mx > 8.f)) {
        const float delta = (t == 0) ? mx : fmaxf(mx, 0.f), alpha = (t == 0) ? 1.f : __builtin_amdgcn_exp2f(-delta);
        mref[qb] += delta; lacc[qb] = lacc[qb] * alpha;
#pragma unroll
        for (int kb = 0; kb < 4; ++kb) s[kb][qb] = s[kb][qb] - delta;
#pragma unroll
        for (int eb = 0; eb < 4; ++eb) o[qb][eb] = o[qb][eb] * alpha;
      }
#pragma unroll
      for (int kb = 0; kb < 4; ++kb)
#pragma unroll
        for (int r = 0; r < 4; ++r) s[kb][qb][r] = __builtin_amdgcn_exp2f(s[kb][qb][r]);
    }
#pragma unroll
    for (int s2 = 0; s2 < 2; ++s2) {
      bf16x8 pf[2];
#pragma unroll
      for (int qb = 0; qb < 2; ++qb) { u32x4 w; w.x = cvtpk(s[2 * s2][qb][0], s[2 * s2][qb][1]); w.y = cvtpk(s[2 * s2][qb][2], s[2 * s2][qb][3]);
        w.z = cvtpk(s[2 * s2 + 1][qb][0], s[2 * s2 + 1][qb][1]); w.w = cvtpk(s[2 * s2 + 1][qb][2], s[2 * s2 + 1][qb][3]); pf[qb] = __builtin_bit_cast(bf16x8, w);
        lacc[qb] = mfma16(ones, pf[qb], lacc[qb]); }
      const LAS bf16_t* vb = Vs + (32 * s2 + 4 * quad + tq) * AT_VSTR + 4 * tp;
#pragma unroll
      for (int eb = 0; eb < 4; ++eb) {
        const u32x2 lo = tr_rd(vb + 16 * eb), hi = tr_rd(vb + 16 * AT_VSTR + 16 * eb);
        const u32x4 vv = (u32x4){lo.x, lo.y, hi.x, hi.y}; const bf16x8 vf = __builtin_bit_cast(bf16x8, vv);
        __builtin_amdgcn_s_setprio(1);
#pragma unroll
        for (int qb = 0; qb < 2; ++qb) o[qb][eb] = mfma16(vf, pf[qb], o[qb][eb]);
        __builtin_amdgcn_s_setprio(0);
      }
    }
    if (more) attn_stage(lds + ((t + 1) & 1) * AT_BUF, tid, rk, rv, rr);
    __syncthreads();
  }
#pragma unroll
  for (int qb = 0; qb < 2; ++qb) {
    const float inv = 1.f / lacc[qb][0];
    bf16_t* op = MIX + (qrow0 + wid * 32 + qb * 16 + c16) * 1024 + h * 64 + quad * 4;
#pragma unroll
    for (int eb = 0; eb < 4; ++eb) { u32x2 w; w.x = cvtpk(o[qb][eb][0] * inv, o[qb][eb][1] * inv); w.y = cvtpk(o[qb][eb][2] * inv, o[qb][eb][3] * inv); *(u32x2*)(op + eb * 16) = w; }
  }
}
__device__ __forceinline__ void attn_phase(const Params& p, LAS unsigned char* lds, const int tid, const int bid) {
  const bf16_t* Q = (const bf16_t*)(p.ws + WS_Q); const bf16_t* KV = (const bf16_t*)(p.ws + WS_KV); const bf16_t* KR = (const bf16_t*)(p.ws + WS_KR); bf16_t* MIX = (bf16_t*)(p.ws + WS_B0);
  const int G = gridDim.x;
  for (int u = bid; u < 2048; u += G) {
    const int b = u & 7, rest = u >> 3, qb = rest & 31, h = rest >> 5;
    attn_unit(lds, Q, KV, KR, MIX, (size_t)b * SEGL + CTXL + (size_t)qb * 256, (size_t)b * SEGL, SEGL / 64, h, tid);
  }
  for (int u = bid; u < 64; u += G) {
    const int b = u & 7, h = u >> 3;
    attn_unit(lds, Q, KV, KR, MIX, (size_t)b * SEGL, (size_t)b * SEGL, CTXL / 64, h, tid);
  }
}

constexpr int RT_STR = 136, RT_VSTR = 72;
constexpr int RT_QS = 0, RT_KS = 128 * RT_STR * 2, RT_VS = 2 * RT_KS, RT_ST = RT_VS + 128 * RT_VSTR * 2;
__device__ __forceinline__ u32x4 scale8(u32x4 v, float f) {
  u32x4 o; o.x = cvtpk(bflo(v.x) * f, bfhi(v.x) * f); o.y = cvtpk(bflo(v.y) * f, bfhi(v.y) * f); o.z = cvtpk(bflo(v.z) * f, bfhi(v.z) * f); o.w = cvtpk(bflo(v.w) * f, bfhi(v.w) * f); return o;
}
__device__ __forceinline__ void ret_unit(LAS unsigned char* lds, bf16_t* U, bf16_t* OF, int b, int h, int sl, const int tid, const bool dry) {
  const int lane = tid & 63, wid = tid >> 6, c16 = lane & 15, quad = lane >> 4, tq = (lane & 15) >> 2, tp = lane & 3;
  LAS bf16_t* Qs = (LAS bf16_t*)(lds + RT_QS); LAS bf16_t* Ks = (LAS bf16_t*)(lds + RT_KS); LAS bf16_t* Vs = (LAS bf16_t*)(lds + RT_VS); LAS bf16_t* St = (LAS bf16_t*)(lds + RT_ST);
  const size_t rowb = (size_t)b * SEGL;
  const int n = 16 * wid + c16;
  for (int dir = 0; dir < 2; ++dir) {
    const int hh = dir ? (7 - h) : h;
    const float lg = log2f(1.0f - exp2f(-5.0f - (float)hh));
    const float gC = exp2f(lg * 128.f), g1 = exp2f(lg), g127 = exp2f(lg * 127.f);
    const float dq = dir ? exp2f(lg * (float)(128 - n)) : exp2f(lg * (float)(n + 1));
    const float cn = dir ? exp2f(-lg * (float)n) : exp2f(lg * (float)n);
    float kf4[4];
#pragma unroll
    for (int i = 0; i < 4; ++i) { const int row = (tid + 512 * i) >> 4; kf4[i] = dir ? exp2f(lg * (float)row) : exp2f(-lg * (float)row); }
    f32x4 st[4];
#pragma unroll
    for (int eb = 0; eb < 4; ++eb) st[eb] = (f32x4){0.f, 0.f, 0.f, 0.f};
    u32x4 rq[4], rk[4], rv[2];
    { const int c0 = dir ? 1 : 0; const size_t row0 = rowb + (size_t)c0 * 128;
#pragma unroll
      for (int i = 0; i < 4; ++i) { const int idx = tid + 512 * i, row = idx >> 4, ch = idx & 15; const bf16_t* src = U + (row0 + row) * 4096 + h * 128 + ch * 8; rq[i] = *(const u32x4*)src; rk[i] = *(const u32x4*)(src + 1024); }
#pragma unroll
      for (int i = 0; i < 2; ++i) { const int idx = tid + 512 * i, row = idx >> 3, ch = idx & 7; rv[i] = *(const u32x4*)(U + (row0 + row) * 4096 + 2048 + h * 256 + sl * 64 + ch * 8); } }
    for (int step = 0; step < 66; ++step) {
      const int c = dir ? ((step < 2) ? (1 - step) : (67 - step)) : step;
      const size_t grow = rowb + (size_t)c * 128 + n;
      __syncthreads();
#pragma unroll
      for (int i = 0; i < 4; ++i) { const int idx = tid + 512 * i, row = idx >> 4, ch = idx & 15;
        *(LAS u32x4*)(Qs + row * RT_STR + ch * 8) = rq[i]; *(LAS u32x4*)(Ks + row * RT_STR + ch * 8) = scale8(rk[i], kf4[i]); }
#pragma unroll
      for (int i = 0; i < 2; ++i) { const int idx = tid + 512 * i, row = idx >> 3, ch = idx & 7; *(LAS u32x4*)(Vs + row * RT_VSTR + ch * 8) = rv[i]; }
#pragma unroll
      for (int eb = 0; eb < 4; ++eb)
#pragma unroll
        for (int r = 0; r < 4; ++r) St[(16 * eb + 4 * quad + r) * RT_STR + 16 * wid + c16] = f2bf(st[eb][r]);
      __syncthreads();
      if (step + 1 < 66) { const int s1 = step + 1; const int c1 = dir ? ((s1 < 2) ? (1 - s1) : (67 - s1)) : s1; const size_t r1 = rowb + (size_t)c1 * 128;
#pragma unroll
        for (int i = 0; i < 4; ++i) { const int idx = tid + 512 * i, row = idx >> 4, ch = idx & 15; const bf16_t* src = U + (r1 + row) * 4096 + h * 128 + ch * 8; rq[i] = *(const u32x4*)src; rk[i] = *(const u32x4*)(src + 1024); }
#pragma unroll
        for (int i = 0; i < 2; ++i) { const int idx = tid + 512 * i, row = idx >> 3, ch = idx & 7; rv[i] = *(const u32x4*)(U + (r1 + row) * 4096 + 2048 + h * 256 + sl * 64 + ch * 8); } }
      u32x2 fo[4];
      if (dir) { const bf16_t* ip = OF + grow * 2048 + h * 256 + sl * 64 + quad * 4;
#pragma unroll
        for (int eb = 0; eb < 4; ++eb) fo[eb] = *(const u32x2*)(ip + eb * 16); }
      bf16x8 qf[4];
#pragma unroll
      for (int ks = 0; ks < 4; ++ks) qf[ks] = *(const LAS bf16x8*)(Qs + n * RT_STR + ks * 32 + quad * 8);
      f32x4 o[4];
#pragma unroll
      for (int eb = 0; eb < 4; ++eb) { f32x4 a = (f32x4){0.f, 0.f, 0.f, 0.f};
#pragma unroll
        for (int ks = 0; ks < 4; ++ks) { const bf16x8 af = *(const LAS bf16x8*)(St + (16 * eb + c16) * RT_STR + ks * 32 + quad * 8); a = mfma16(af, qf[ks], a); }
        o[eb] = a * dq; }
      const float pre = dir ? gC : g1, post = dir ? 1.f : g127;
#pragma unroll
      for (int eb = 0; eb < 4; ++eb) st[eb] = st[eb] * pre;
#pragma unroll 1
      for (int s2 = 0; s2 < 4; ++s2) {
        const LAS bf16_t* vb = Vs + (32 * s2 + 4 * quad + tq) * RT_VSTR + 4 * tp;
        bf16x8 vf[4];
#pragma unroll
        for (int eb = 0; eb < 4; ++eb) { const u32x2 lo = tr_rd(vb + 16 * eb), hi = tr_rd(vb + 16 * RT_VSTR + 16 * eb); const u32x4 vv = (u32x4){lo.x, lo.y, hi.x, hi.y}; vf[eb] = __builtin_bit_cast(bf16x8, vv); }
        const bool needed = dir ? (2 * s2 + 1 >= wid) : (2 * s2 <= wid);
        if (needed) {
          float pw[8];
#pragma unroll
          for (int hf = 0; hf < 2; ++hf) { const int mb = 2 * s2 + hf; f32x4 a = (f32x4){0.f, 0.f, 0.f, 0.f};
#pragma unroll
            for (int ks = 0; ks < 4; ++ks) { const bf16x8 kf = *(const LAS bf16x8*)(Ks + (16 * mb + c16) * RT_STR + ks * 32 + quad * 8); a = mfma16(kf, qf[ks], a); }
#pragma unroll
            for (int r = 0; r < 4; ++r) { const int m = 16 * mb + 4 * quad + r; const bool keep = dir ? (m > n) : (n >= m); pw[4 * hf + r] = keep ? a[r] * cn : 0.f; } }
          u32x4 w; w.x = cvtpk(pw[0], pw[1]); w.y = cvtpk(pw[2], pw[3]); w.z = cvtpk(pw[4], pw[5]); w.w = cvtpk(pw[6], pw[7]);
          const bf16x8 pf = __builtin_bit_cast(bf16x8, w);
#pragma unroll
          for (int eb = 0; eb < 4; ++eb) o[eb] = mfma16(vf[eb], pf, o[eb]);
        }
        const LAS bf16_t* kb = Ks + (32 * s2 + 4 * quad + tq) * RT_STR + 16 * wid + 4 * tp;
        const u32x2 klo = tr_rd(kb), khi = tr_rd(kb + 16 * RT_STR);
        const u32x4 kk = (u32x4){klo.x, klo.y, khi.x, khi.y}; const bf16x8 bk = __builtin_bit_cast(bf16x8, kk);
#pragma unroll
        for (int eb = 0; eb < 4; ++eb) st[eb] = mfma16(vf[eb], bk, st[eb]);
      }
#pragma unroll
      for (int eb = 0; eb < 4; ++eb) st[eb] = st[eb] * post;
      if (dir == 0) { bf16_t* op = OF + grow * 2048 + h * 256 + sl * 64 + quad * 4;
#pragma unroll
        for (int eb = 0; eb < 4; ++eb) { u32x2 w; w.x = cvtpk(o[eb][0], o[eb][1]); w.y = cvtpk(o[eb][2], o[eb][3]); *(u32x2*)(op + eb * 16) = w; } }
      else { bf16_t* op = U + grow * 4096 + 2048 + h * 256 + sl * 64 + quad * 4;
#pragma unroll
        for (int eb = 0; eb < 4; ++eb) { u32x2 w; w.x = cvtpk(o[eb][0] + bflo(fo[eb].x), o[eb][1] + bfhi(fo[eb].x)); w.y = cvtpk(o[eb][2] + bflo(fo[eb].y), o[eb][3] + bfhi(fo[eb].y)); *(u32x2*)(op + eb * 16) = w; } }
    }
  }
}
__device__ __forceinline__ void ret_phase(const Params& p, LAS unsigned char* lds, const int tid, const int bid, const bool dry) {
  bf16_t* U = (bf16_t*)(p.ws + WS_B0); bf16_t* OF = (bf16_t*)(p.ws + WS_Y);
  for (int u = bid; u < 256; u += gridDim.x) { const int b = u & 7, rest = u >> 3, sl = rest & 3, h = rest >> 2; ret_unit(lds, U, OF, b, h, sl, tid, dry); }
}

#ifndef PHASE_MAP
#define PHASE_MAP(it) (it)
#define N_ITERS 38
#endif
#define RUN_GEMM(MODE, APTR, LDA_, BTPTR, N_, K_, OPTR, LDC_, COFF_, CS_, TAB_, SCALE_) do { const int skipc_ = ((L == 3 && s >= 4) || s == 8) ? 1 : 0; \
    pg8::Gemm g; g.A = (APTR); g.Bt = (BTPTR); g.M = T; g.N = (N_); g.K = (K_); g.lda = (LDA_); \
    Epi<MODE, LDC_, COFF_> E; E.O = (OPTR); E.cs = (CS_); E.tab = (TAB_); E.scale = (SCALE_); \
    pg8::StaticOrder S; S.init(T, (N_), G, (bid + G - rot_) % G, skipc_); \
    int tg_ = tid; asm volatile("" : "+v"(tg_)); \
    pg8::gemm_phase<Epi<MODE, LDC_, COFF_>, pg8::StaticOrder, true, true, K_, LDA_>(lds, g, S, E, tg_); \
    __syncthreads(); } while (0)
#define RUN_SPLIT(APTR, LDA_, BTPTR, LDB_, N_, KP_, NP_, OPTR) do { \
    pg8::Gemm g; g.A = (APTR); g.Bt = (BTPTR); g.M = T; g.N = (N_); g.K = (KP_); g.lda = (LDA_); \
    Epi<5, 1024, 0> E; E.O = (bf16_t*)(OPTR); E.cs = nullptr; E.tab = nullptr; E.scale = 1.f; \
    pg8::CtxSplitOrder S; S.init((N_), (NP_), G, bid); \
    int tg_ = tid; asm volatile("" : "+v"(tg_)); \
    pg8::gemm_phase<Epi<5, 1024, 0>, pg8::CtxSplitOrder, true, true, KP_, LDA_, LDB_>(lds, g, S, E, tg_); \
    __syncthreads(); } while (0)
__global__ void __launch_bounds__(NTHR, 2) mega(Params p_unused) {
  extern __shared__ __attribute__((aligned(16))) unsigned char lds_raw[];
  LAS unsigned char* lds = (LAS unsigned char*)lds_raw;
  const Params& p = *(const Params*)__builtin_amdgcn_kernarg_segment_ptr();
  const int G = gridDim.x;
  volatile LAS unsigned* bst = (volatile LAS unsigned*)(lds + LDS_BAR_OFF);
  if (threadIdx.x < 2) bst[threadIdx.x] = 0u;
  __syncthreads();
  const XcdBarrier bar = xcd_barrier_post((unsigned*)(p.ws + WS_BAR), bst);
  for (int it = p.lo; it < p.hi; ++it) {
    const int phc = PHASE_MAP(it); const int ph = phc & 63; const bool dry = (phc >> 6) != 0;
    if (it > p.lo + 1) { xcd_barrier(bar); }
    else if (it > p.lo) {
      asm volatile("s_waitcnt vmcnt(0) lgkmcnt(0)" ::: "memory");
      __syncthreads();
      if (threadIdx.x < 64) { __builtin_amdgcn_fence(__ATOMIC_RELEASE, "agent"); asm volatile("s_waitcnt vmcnt(0)" ::: "memory"); }
      cg::this_grid().sync();
      if (threadIdx.x < 64) { __builtin_amdgcn_fence(__ATOMIC_ACQUIRE, "agent"); asm volatile("s_waitcnt vmcnt(0)" ::: "memory"); }
      __syncthreads();
    }
    int tid = threadIdx.x; asm volatile("" : "+v"(tid));
    int bid = blockIdx.x; asm volatile("" : "+s"(bid));
    const int lane = tid & 63, wid = __builtin_amdgcn_readfirstlane(tid >> 6);
    const int gw = bid * NWAVE + wid, ngw = G * NWAVE;
    unsigned char* ws = p.ws;
    const float* mod = (const float*)(ws + WS_MOD);
    const float* tab = (const float*)(ws + WS_TAB);
    bf16_t* H = (bf16_t*)(ws + WS_H); bf16_t* B0 = (bf16_t*)(ws + WS_B0); bf16_t* Y = (bf16_t*)(ws + WS_Y);
    if (ph == 0) { p0_phase(p, lds, tid, bid); continue; }
    if (ph == 37) { norm_phase(p, false, true, true, p.g_ffn_post + 3 * DM, mod + (size_t)3 * 9 * 6144 + 5 * 1024, nullptr, nullptr, gw, ngw, lane); continue; }
    const int L = (ph - 1) / 9, s = (ph - 1) % 9, odd = L & 1, li = L >> 1;
    const float* modL = mod + (size_t)L * 9 * 6144;
    int rot_ = 0;
    if (s == 0) {
      conv_layer(p, L, lds, gw, ngw, wid, lane);
      norm_phase(p, L == 0, L > 0, false, p.g_ffn_post + (L > 0 ? (L - 1) : 0) * DM, mod + (size_t)(L > 0 ? (L - 1) : 0) * 9 * 6144 + 5 * 1024, p.g_mix_pre + L * DM, modL, gw, ngw, lane, false, (L > 0) ? (const float*)(ws + WS_YP) : nullptr);
      __syncthreads();
    }
    else if (s == 6) { norm_phase(p, false, true, false, p.g_mix_post + L * DM, modL + 2 * 1024, p.g_ffn_pre + L * DM, modL + 3 * 1024, gw, ngw, lane, dry); }
    else if (s == 7) { RUN_GEMM(1, H, 1024, (const bf16_t*)(ws + WS_WFF1), 4096, 1024, B0, 4096, 0, nullptr, tab, 1.f); }
    else if (s == 8) {
      RUN_GEMM(0, B0, 4096, (const bf16_t*)(ws + WS_WFF2), 1024, 4096, Y, 1024, 0, nullptr, tab, 1.f);
      if (L < 3) RUN_SPLIT(B0, 4096, (const bf16_t*)(ws + WS_WFF2), 4096, 1024, 512, 8, ws + WS_YP);
    }
    else if (!odd) {
      if (s == 1) { RUN_GEMM(0, H, 1024, (const bf16_t*)(ws + WS_WA), 1024, 1024, B0, 1024, 0, nullptr, tab, 1.f); }
      else if (s == 2) { mid_phase(p, li, gw, ngw, lane); }
      else if (s == 3) {
        RUN_GEMM(2, (const bf16_t*)(ws + WS_UQN), 256, (const bf16_t*)(ws + WS_WUQ), 768, 256, (bf16_t*)(ws + WS_Q), 768, 0, nullptr, tab, 0.10206207261596577f * 1.4426950408889634f);
        rot_ = 24;
        RUN_GEMM(0, (const bf16_t*)(ws + WS_UKVN), 128, (const bf16_t*)(ws + WS_WUKV), 1024, 256, (bf16_t*)(ws + WS_KV), 1024, 0, nullptr, tab, 1.f);
        rot_ = 56;
        RUN_GEMM(0, (const bf16_t*)(ws + WS_PD), 512, (const bf16_t*)(ws + WS_WPOOL), 512, 512, B0, 1024, 512, p.pool_scale + li * 512, tab, 1.f);
      }
      else if (s == 4) { attn_phase(p, lds, tid, bid); }
      else { RUN_GEMM(0, B0, 1024, (const bf16_t*)(ws + WS_WB), 1024, 1024, Y, 1024, 0, nullptr, tab, 1.f); }
    } else {
      if (s == 1) { RUN_GEMM(3, H, 1024, (const bf16_t*)(ws + WS_WA), 4096, 1024, B0, 4096, 0, nullptr, tab + 2048, 0.08838834764831845f); }
      else if (s == 2) { ret_phase(p, lds, tid, bid, dry); }
      else if (s == 3) { gn_phase(p, gw, ngw, lane); }
      else if (s == 4) { RUN_GEMM(4, H, 1024, (const bf16_t*)(ws + WS_WA) + (size_t)4096 * 1024, 2048, 1024, B0, 4096, 2048, nullptr, tab, 1.f); }
      else { RUN_GEMM(0, B0 + 2048, 4096, (const bf16_t*)(ws + WS_WB), 1024, 2048, Y, 1024, 0, nullptr, tab, 1.f); }
    }
  }
}

extern "C" void kernel_launch(void* const* d_in, const int* in_sizes, int n_in, void* d_out, int out_size, void* d_ws, size_t ws_size, hipStream_t stream) {
  static int grid = 0;
  if (grid == 0) {
    if (n_in != 22 || ws_size < WS_END) { fprintf(stderr, "kernel_launch: unexpected n_in %d or workspace %zu < %zu\n", n_in, ws_size, (size_t)WS_END); grid = -1; return; }
    int dev = 0, cus = 0, per_cu = 0;
    hipGetDevice(&dev); hipDeviceGetAttribute(&cus, hipDeviceAttributeMultiprocessorCount, dev);
    if (hipFuncSetAttribute((const void*)mega, hipFuncAttributeMaxDynamicSharedMemorySize, LDS_BYTES) != hipSuccess) { fprintf(stderr, "kernel_launch: hipFuncSetAttribute failed\n"); }
    if (hipOccupancyMaxActiveBlocksPerMultiprocessor(&per_cu, (const void*)mega, NTHR, LDS_BYTES) != hipSuccess || per_cu < 1) { fprintf(stderr, "kernel_launch: occupancy query gave %d\n", per_cu); per_cu = 1; }
    (void)hipGetLastError();
    grid = cus * 1;
  }
  if (grid < 0) return;
  if (hipMemsetAsync((char*)d_ws + WS_BAR, 0, XCD_BAR_WORDS * 4, stream) != hipSuccess) fprintf(stderr, "kernel_launch: memset of the barrier words failed\n");
  Params p{};
  const float** pp = (const float**)&p;
  for (int i = 0; i < 22; ++i) pp[i] = (const float*)d_in[i];
  p.out = (float*)d_out; p.ws = (unsigned char*)d_ws;
#ifndef N_SPLIT
  p.lo = 0; p.hi = N_ITERS;
  void* args[] = {&p};
  hipError_t e = hipLaunchCooperativeKernel((const void*)mega, dim3(grid), dim3(NTHR), args, LDS_BYTES, stream);
  if (e != hipSuccess) fprintf(stderr, "cooperative launch failed: %s (grid %d)\n", hipGetErrorString(e), grid);
#else
  for (int ph = 0; ph < 38; ++ph) { p.lo = ph; p.hi = ph + 1; hipLaunchKernelGGL(mega, dim3(grid), dim3(NTHR), LDS_BYTES, stream, p); }
#endif
}
```

```cpp
#include <hip/hip_runtime.h>
#include <hip/hip_cooperative_groups.h>
#include <cstdio>
#include <cstdint>
namespace cg = cooperative_groups;
namespace pg8 {
#define PG8_LAS __attribute__((address_space(3)))
typedef unsigned short bf16_t;
typedef short bf16x8 __attribute__((ext_vector_type(8)));
typedef float f32x4 __attribute__((ext_vector_type(4)));
typedef unsigned u32x4 __attribute__((ext_vector_type(4)));
constexpr int BM = 256, BK = 64, HALF = 128, HTB = HALF * BK * 2  , STAGE_BYTES = 8 * HTB, NXCD = 8, WGM = 8;

__host__ __device__ __forceinline__ int lds_byte(int r, int c) { const int st = (r >> 4) * 2 + (c >> 5), rr = r & 15, cc = c & 31, ob = rr * 64 + cc * 2; return st * 1024 + (ob ^ (((ob >> 9) & 1) << 5)); }
__host__ __device__ __forceinline__ void stage_rc(int b, int& R, int& C) { const int st = b / 1024, sb = b % 1024, swz = sb ^ (((sb >> 9) & 1) << 5); R = (st >> 1) * 16 + swz / 64; C = (st & 1) * 32 + (swz % 64) / 2; }
__host__ __device__ __forceinline__ int perm32(int rho) { const int n = rho >> 4, i = rho & 15; return 8 * (i >> 2) + 4 * n + (i & 3); }

struct Unit { int pm, pn, kp; };
struct Gemm { const bf16_t* A; const bf16_t* Bt; int M, N, K, lda; };

struct StaticOrder {
    int nM, nN, nwg, G, c, skip;
    __host__ __device__ void init(int M, int N, int G_, int c_, int skip_ = 0) { skip = skip_; nM = skip_ ? (M / BM / 33) * 32 : M / BM; nN = N / BM; nwg = nM * nN; G = G_; c = c_; }
    __host__ __device__ bool next(int i, Unit& u) const {
        const long L = (long)i * G + c; if (L >= nwg) return false;
        int wgid = (int)L; { const int q = nwg / NXCD, r = nwg % NXCD, xcd = wgid % NXCD, off = wgid / NXCD; wgid = (xcd < r ? xcd * (q + 1) : r * (q + 1) + (xcd - r) * q) + off; }
        const int nig = WGM * nN, gid = wgid / nig, fm = gid * WGM, gsz = (nM - fm) < WGM ? (nM - fm) : WGM;
        u.kp = 0; u.pm = fm + ((wgid % nig) % gsz); u.pn = (wgid % nig) / gsz; if (skip) u.pm = (u.pm >> 5) * 33 + 1 + (u.pm & 31); return true;
    }
    __device__ __forceinline__ void a_ready(const Unit&) const {}
    __device__ __forceinline__ void done(const Unit&) const {}
};

struct CtxSplitOrder {
    int nN, NP, G, c;
    __host__ __device__ void init(int N, int NP_, int G_, int c_) { nN = N / BM; NP = NP_; G = G_; c = c_; }
    __host__ __device__ bool next(int i, Unit& u) const {
        const int L = i * G + c; if (L >= 8 * nN * NP) return false;
        u.kp = L % NP; const int rest = L / NP; u.pn = rest % nN; u.pm = (rest / nN) * 33; return true;
    }
    __device__ __forceinline__ void a_ready(const Unit&) const {}
    __device__ __forceinline__ void done(const Unit&) const {}
};

template <class Epi, class Sched, bool ALIGN_EPI, bool SP2, int KC, int LDAC, int LDBC = KC>
__device__ __forceinline__ void gemm_phase(PG8_LAS unsigned char* lds, const Gemm g, const Sched& S, const Epi& E, const int tid) {
    const int wid = __builtin_amdgcn_readfirstlane(tid >> 6), lane = tid & 63, wr = wid >> 2, wc = wid & 3, fr = lane & 15, fq = lane >> 4;
    constexpr int K = KC, nt = K / BK;
    unsigned voffA[2], voffB[2];
#pragma unroll
    for (int i = 0; i < 2; ++i) { int R, C; stage_rc(tid * 16 + i * 8192, R, C); const int Rb = Epi::PERM ? ((R & ~31) + perm32(R & 31)) : R;
        voffA[i] = (unsigned)(R * LDAC + C) * 2u; voffB[i] = (unsigned)(Rb * LDBC + C) * 2u; }
    const size_t kstep = (size_t)(BK * 2);
    const size_t hstepA = (size_t)HALF * LDAC * 2, hstepB = (size_t)HALF * LDBC * 2;
    const size_t tstepA = 2 * hstepA, tstepB = 2 * hstepB;
    const unsigned ldsw = (unsigned)wid * 1024u;
    const int aoff = lds_byte(wr * 64 + fr, fq * 8), boff = lds_byte(wc * 32 + fr, fq * 8);
#define PG8_SA(b, h) (((b) * 2 + (h)) * HTB)
#define PG8_SB(b, h) ((4 + (b) * 2 + (h)) * HTB)
#define PG8_STAGE(bufoff, gbase, voff) do { _Pragma("unroll") for (int _i = 0; _i < 2; ++_i) \
        __builtin_amdgcn_global_load_lds((const unsigned*)((const char*)(gbase) + (voff)[_i]), (PG8_LAS unsigned*)(lds + (bufoff) + ldsw + _i * 8192), 16, 0, 0); } while (0)
#define PG8_LDA(dst, b, h) do { _Pragma("unroll") for (int m = 0; m < 4; ++m) _Pragma("unroll") for (int k = 0; k < 2; ++k) dst[m][k] = *(const PG8_LAS bf16x8*)(lds + PG8_SA(b, h) + aoff + m * 2048 + k * 1024); } while (0)
#define PG8_LDB(dst, b, h) do { _Pragma("unroll") for (int n = 0; n < 2; ++n) _Pragma("unroll") for (int k = 0; k < 2; ++k) dst[n][k] = *(const PG8_LAS bf16x8*)(lds + PG8_SB(b, h) + boff + n * 2048 + k * 1024); } while (0)
#define PG8_MMA(ai, bj, At, Bt) do { __builtin_amdgcn_s_setprio(1); _Pragma("unroll") for (int m = 0; m < 4; ++m) _Pragma("unroll") for (int n = 0; n < 2; ++n) _Pragma("unroll") for (int k = 0; k < 2; ++k) \
        acc[ai][bj][m][n] = __builtin_amdgcn_mfma_f32_16x16x32_bf16(Bt[n][k], At[m][k], acc[ai][bj][m][n], 0, 0, 0); __builtin_amdgcn_s_setprio(0); } while (0)
#define PG8_WAIT_V(n) asm volatile("s_waitcnt vmcnt(" #n ")" ::: "memory")
#define PG8_WAIT_L(n) asm volatile("s_waitcnt lgkmcnt(" #n ")" ::: "memory")
#define PG8_BAR __builtin_amdgcn_s_barrier()
#define PG8_SCHED __builtin_amdgcn_sched_barrier(0)
    Unit cur, nxt; int ui = 0;
    if (!S.next(0, cur)) return;
    f32x4 acc[2][2][4][2];
#pragma unroll
    for (int a = 0; a < 2; ++a)
#pragma unroll
        for (int b = 0; b < 2; ++b)
#pragma unroll
            for (int m = 0; m < 4; ++m)
#pragma unroll
                for (int n = 0; n < 2; ++n) acc[a][b][m][n] = (f32x4){0.f, 0.f, 0.f, 0.f};
    bf16x8 At[4][2], B0[2][2], B1[2][2];
    const char* cA = (const char*)g.A + (size_t)cur.pm * tstepA + (size_t)cur.kp * (K * 2); const char* cB = (const char*)g.Bt + (size_t)cur.pn * tstepB + (size_t)cur.kp * (K * 2);
    S.a_ready(cur);
    if constexpr (SP2) {
        PG8_STAGE(PG8_SB(0, 0), cB, voffB); PG8_STAGE(PG8_SB(0, 1), cB + hstepB, voffB); PG8_STAGE(PG8_SA(0, 0), cA, voffA); PG8_STAGE(PG8_SA(0, 1), cA + hstepA, voffA);
        if (wr == 1) PG8_BAR;
        PG8_WAIT_V(2); PG8_BAR;
        PG8_STAGE(PG8_SB(1, 0), cB + kstep, voffB); PG8_STAGE(PG8_SA(1, 0), cA + kstep, voffA); PG8_STAGE(PG8_SB(1, 1), cB + hstepB + kstep, voffB);
        PG8_WAIT_V(6); PG8_BAR;
    } else {
        PG8_STAGE(PG8_SB(0, 0), cB, voffB); PG8_STAGE(PG8_SA(0, 0), cA, voffA); PG8_STAGE(PG8_SB(0, 1), cB + hstepB, voffB); PG8_STAGE(PG8_SA(0, 1), cA + hstepA, voffA);
        if (wr == 1) PG8_BAR;
        PG8_WAIT_V(4); PG8_BAR;
        PG8_STAGE(PG8_SB(1, 0), cB + kstep, voffB); PG8_STAGE(PG8_SA(1, 0), cA + kstep, voffA); PG8_STAGE(PG8_SB(1, 1), cB + hstepB + kstep, voffB);
        PG8_WAIT_V(6); PG8_BAR;
    }
    for (;;) {
        const bool has_next = S.next(ui + 1, nxt);
        const char* nA = has_next ? (const char*)g.A + (size_t)nxt.pm * tstepA + (size_t)nxt.kp * (K * 2) : cA; const char* nB = has_next ? (const char*)g.Bt + (size_t)nxt.pn * tstepB + (size_t)nxt.kp * (K * 2) : cB;
#pragma nounroll
        for (int t = 0; t < nt; t += 2) {
            const bool last = (t == nt - 2);
            const char* a1 = cA + (size_t)(t + 1) * kstep;
            const char* a2 = last ? nA : cA + (size_t)(t + 2) * kstep; const char* b2 = last ? nB : cB + (size_t)(t + 2) * kstep;
            const char* a3 = a2 + kstep; const char* b3 = b2 + kstep;
            if (last && has_next) S.a_ready(nxt);
            if constexpr (SP2) {
            PG8_LDB(B0, 0, 0); PG8_LDB(B1, 0, 1); PG8_SCHED; PG8_LDA(At, 0, 0); PG8_STAGE(PG8_SA(1, 1), a1 + hstepA, voffA);
            PG8_WAIT_V(8); PG8_WAIT_L(0); PG8_BAR; PG8_MMA(0, 0, At, B0); PG8_MMA(0, 1, At, B1); PG8_BAR; PG8_SCHED;
            PG8_LDA(At, 0, 1); PG8_STAGE(PG8_SB(0, 0), b2, voffB); PG8_STAGE(PG8_SB(0, 1), b2 + hstepB, voffB); PG8_STAGE(PG8_SA(0, 0), a2, voffA);
            PG8_WAIT_V(8); PG8_WAIT_L(0); PG8_BAR; PG8_MMA(1, 0, At, B0); PG8_MMA(1, 1, At, B1); PG8_BAR; PG8_SCHED;
            PG8_LDB(B0, 1, 0); PG8_LDB(B1, 1, 1); PG8_SCHED; PG8_LDA(At, 1, 0); PG8_STAGE(PG8_SA(0, 1), a2 + hstepA, voffA);
            PG8_WAIT_V(8); PG8_WAIT_L(0); PG8_BAR; PG8_MMA(0, 0, At, B0); PG8_MMA(0, 1, At, B1); PG8_BAR; PG8_SCHED;
            PG8_LDA(At, 1, 1); PG8_STAGE(PG8_SB(1, 0), b3, voffB); PG8_STAGE(PG8_SB(1, 1), b3 + hstepB, voffB); PG8_STAGE(PG8_SA(1, 0), a3, voffA);
            PG8_WAIT_V(8); PG8_WAIT_L(0); PG8_BAR; PG8_MMA(1, 0, At, B0); PG8_MMA(1, 1, At, B1); PG8_BAR; PG8_SCHED;
            } else {
            PG8_LDB(B0, 0, 0); PG8_SCHED; PG8_LDA(At, 0, 0); PG8_STAGE(PG8_SA(1, 1), a1 + hstepA, voffA);
            PG8_WAIT_L(8); PG8_BAR; PG8_WAIT_L(0); PG8_MMA(0, 0, At, B0); PG8_BAR; PG8_SCHED;
            PG8_LDB(B1, 0, 1); PG8_STAGE(PG8_SB(0, 0), b2, voffB);
            PG8_BAR; PG8_WAIT_L(0); PG8_MMA(0, 1, At, B1); PG8_BAR;
            PG8_LDA(At, 0, 1); PG8_STAGE(PG8_SA(0, 0), a2, voffA);
            PG8_BAR; PG8_WAIT_L(0); PG8_MMA(1, 0, At, B0); PG8_BAR; PG8_SCHED;
            PG8_STAGE(PG8_SB(0, 1), b2 + hstepB, voffB);
            PG8_WAIT_V(6); PG8_BAR; PG8_MMA(1, 1, At, B1); PG8_BAR;
            PG8_LDB(B0, 1, 0); PG8_SCHED; PG8_LDA(At, 1, 0); PG8_STAGE(PG8_SA(0, 1), a2 + hstepA, voffA);
            PG8_WAIT_L(8); PG8_BAR; PG8_WAIT_L(0); PG8_MMA(0, 0, At, B0); PG8_BAR; PG8_SCHED;
            PG8_LDB(B1, 1, 1); PG8_STAGE(PG8_SB(1, 0), b3, voffB);
            PG8_BAR; PG8_WAIT_L(0); PG8_MMA(0, 1, At, B1); PG8_BAR;
            PG8_LDA(At, 1, 1); PG8_STAGE(PG8_SA(1, 0), a3, voffA);
            PG8_BAR; PG8_WAIT_L(0); PG8_MMA(1, 0, At, B0); PG8_BAR; PG8_SCHED;
            PG8_STAGE(PG8_SB(1, 1), b3 + hstepB, voffB);
            PG8_WAIT_V(6); PG8_BAR; PG8_MMA(1, 1, At, B1); PG8_BAR;
            }
        }
        if constexpr (ALIGN_EPI) { if (wr == 0) PG8_BAR; }
        if constexpr (!Epi::AFTER_DRAIN) { int te = tid; asm volatile("" : "+v"(te)); E(acc, cur, wr, wc, te & 15, (te & 63) >> 4); S.done(cur); }
        if (!has_next) break;
#pragma unroll
        for (int a = 0; a < 2; ++a)
#pragma unroll
            for (int b = 0; b < 2; ++b)
#pragma unroll
                for (int m = 0; m < 4; ++m)
#pragma unroll
                    for (int n = 0; n < 2; ++n) acc[a][b][m][n] = (f32x4){0.f, 0.f, 0.f, 0.f};
        cur = nxt; cA = nA; cB = nB; ++ui;
        if constexpr (ALIGN_EPI) { if (wr == 1) PG8_BAR; }
    }
    PG8_WAIT_V(0);
    if constexpr (!ALIGN_EPI) { if (wr == 0) PG8_BAR; }
    PG8_BAR;
    if constexpr (Epi::AFTER_DRAIN) { E.fused(acc, cur, wr, wc, fr, fq, lds, wid, lane); S.done(cur); }
#undef PG8_SA
#undef PG8_SB
#undef PG8_STAGE
#undef PG8_LDA
#undef PG8_LDB
#undef PG8_MMA
#undef PG8_WAIT_V
#undef PG8_WAIT_L
#undef PG8_BAR
#undef PG8_SCHED
}
}


#define LAS __attribute__((address_space(3)))
typedef unsigned short bf16_t;
typedef short bf16x8 __attribute__((ext_vector_type(8)));
typedef float f32x4 __attribute__((ext_vector_type(4)));
typedef unsigned u32x4 __attribute__((ext_vector_type(4)));
typedef unsigned u32x2 __attribute__((ext_vector_type(2)));
typedef float f32x2_t __attribute__((ext_vector_type(2)));
typedef __bf16 bf16x2_t __attribute__((ext_vector_type(2)));

constexpr int DM = 1024, NB = 8, SEQL = 8192, CTXL = 256, SEGL = SEQL + CTXL  , T = NB * SEGL  ;
constexpr int DFF = 4096, NTHR = 512, NWAVE = 8;
constexpr float EPS = 1e-6f;
constexpr size_t MiB = 1u << 20;
constexpr size_t WS_MOD = 0;
constexpr size_t WS_TAB = 1 * MiB;
constexpr size_t WS_XC = 2 * MiB;
constexpr size_t WS_WFF1 = 10 * MiB, WS_WFF2 = 18 * MiB, WS_WA = 26 * MiB, WS_WB = 38 * MiB;
constexpr size_t WS_WUQ = 28 * MiB, WS_WUKV = WS_WUQ + 512 * 1024, WS_WPOOL = 29 * MiB;
constexpr size_t WS_H = 46 * MiB;
constexpr size_t WS_B0 = 178 * MiB;
constexpr size_t WS_UQN = 310 * MiB, WS_UKVN = 343 * MiB, WS_KR = 360 * MiB, WS_PD = 365 * MiB, WS_Q = 431 * MiB, WS_KV = 530 * MiB;
constexpr size_t WS_Y = 706 * MiB;
constexpr size_t WS_YP = 838 * MiB;
constexpr size_t WS_END = 970 * MiB;
constexpr size_t WS_BAR = 900 * 1024;
constexpr int LDS_BAR_OFF = 141312;
constexpr int LDS_BYTES = 143360;

struct Params {
  const float *x, *c, *ctx, *c_ctx, *w_ada, *b_ada, *g_mix_pre, *g_mix_post, *g_ffn_pre, *g_ffn_post, *w_ffn_in, *w_ffn_out, *w_in_even, *g_q_lora, *g_kv_lora,
      *w_uq, *w_ukv, *w_pool, *pool_scale, *w_out_even, *w_in_odd, *w_out_odd;
  float* out; unsigned char* ws; int lo, hi;
};

__device__ __forceinline__ unsigned cvtpk(float lo, float hi) { f32x2_t v = {lo, hi}; bf16x2_t b = __builtin_convertvector(v, bf16x2_t); return __builtin_bit_cast(unsigned, b); }
__device__ __forceinline__ float bflo(unsigned u) { return __uint_as_float(u << 16); }
__device__ __forceinline__ float bfhi(unsigned u) { return __uint_as_float(u & 0xffff0000u); }
__device__ __forceinline__ bf16_t f2bf(float f) { return (bf16_t)(cvtpk(f, 0.f) & 0xffffu); }
__device__ __forceinline__ float wave_sum(float v) {
#pragma unroll
  for (int o = 1; o < 64; o <<= 1) v += __shfl_xor(v, o);
  return v;
}
__device__ __forceinline__ f32x4 mfma16(bf16x8 a, bf16x8 b, f32x4 c) { return __builtin_amdgcn_mfma_f32_16x16x32_bf16(a, b, c, 0, 0, 0); }

template <int mode, int ldc, int col_off> struct Epi {
  static constexpr bool PERM = true, AFTER_DRAIN = false;
  bf16_t* O; const float* cs; const float* tab; float scale;
  __device__ __forceinline__ void operator()(const f32x4 (&acc)[2][2][4][2], const pg8::Unit& u, int wr, int wc, int fr, int fq) const {
    const int seg = u.pm % 33; const bool islat = seg != 0;
    const int colt = u.pn * 256 + wc * 32 + 8 * fq;
#pragma unroll
    for (int ai = 0; ai < 2; ++ai)
#pragma unroll
      for (int m = 0; m < 4; ++m) {
        const int lrow = ai * 128 + wr * 64 + m * 16 + fr;
        const int row = u.pm * 256 + lrow;
        const int tok = (seg - 1) * 256 + lrow;
        bf16_t* rowp = O + (size_t)row * ldc + col_off;
#pragma unroll
        for (int bj = 0; bj < 2; ++bj) {
          const int c = colt + bj * 128;
          f32x4 v0 = acc[ai][bj][m][0], v1 = acc[ai][bj][m][1];
          if (mode == 5) {
            float* pp = (float*)O + ((size_t)(u.kp * 2048 + (u.pm / 33) * 256 + lrow) * 1024 + c);
            *(f32x4*)pp = v0; *(f32x4*)(pp + 4) = v1;
            continue;
          }
          if (mode == 1) {
#pragma unroll
            for (int i = 0; i < 4; ++i) { float a = fmaxf(v0[i], 0.f), b = fmaxf(v1[i], 0.f); v0[i] = a * a; v1[i] = b * b; }
          } else if (mode == 2) {
            const int hc = c % 96;
            if (islat && hc >= 64) {
              const int j = hc - 64, part = j >> 4, g = (j & 15) >> 3, pos = part ? (tok & 63) : (tok >> 6);
              const f32x4 cs4 = *(const f32x4*)(tab + pos * 8 + 4 * g), sn4 = *(const f32x4*)(tab + 1024 + pos * 8 + 4 * g);
              const f32x4 o0 = v0 * cs4 - v1 * sn4, o1 = v0 * sn4 + v1 * cs4; v0 = o0; v1 = o1;
            }
            v0 = v0 * scale; v1 = v1 * scale;
          } else if (mode == 3) {
            if (u.pn < 8) {
              if (islat) {
                const int hc = c & 127, part = hc >> 6, g = (hc & 63) >> 3, pos = part ? (tok & 63) : (tok >> 6);
                const f32x4 cs4 = *(const f32x4*)(tab + pos * 32 + 4 * g), sn4 = *(const f32x4*)(tab + 4096 + pos * 32 + 4 * g);
                const f32x4 o0 = v0 * cs4 - v1 * sn4, o1 = v0 * sn4 + v1 * cs4; v0 = o0; v1 = o1;
              }
              if (u.pn >= 4) { v0 = v0 * scale; v1 = v1 * scale; }
            }
          } else if (mode == 4) {
            const u32x4 old = *(const u32x4*)(rowp + c);
            const float ov[8] = {bflo(old.x), bfhi(old.x), bflo(old.y), bfhi(old.y), bflo(old.z), bfhi(old.z), bflo(old.w), bfhi(old.w)};
#pragma unroll
            for (int i = 0; i < 4; ++i) { const float a = v0[i], b = v1[i]; v0[i] = a / (1.f + __expf(-a)) * ov[i]; v1[i] = b / (1.f + __expf(-b)) * ov[4 + i]; }
          } else if (cs) {
            const f32x4 s0 = *(const f32x4*)(cs + c), s1 = *(const f32x4*)(cs + c + 4); v0 = v0 * s0; v1 = v1 * s1;
          }
          u32x4 w; w.x = cvtpk(v0[0], v0[1]); w.y = cvtpk(v0[2], v0[3]); w.z = cvtpk(v1[0], v1[1]); w.w = cvtpk(v1[2], v1[3]);
          *(u32x4*)(rowp + c) = w;
        }
      }
  }
};

__device__ __forceinline__ int src_col(int n, int mode) {
  if (mode == 1) { const int hc = n % 96; if (hc >= 64) { const int j = (hc - 64) & 15, g = j >> 3, i = j & 7; return n - j + ((i < 4) ? 4 * g + i : 8 + 4 * g + (i - 4)); } return n; }
  if (mode == 2) { if (n < 2048) { const int j = n & 63, g = j >> 3, i = j & 7; return n - j + ((i < 4) ? 4 * g + i : 32 + 4 * g + (i - 4)); } return n; }
  return n;
}
__device__ __forceinline__ void tr_item(const float* W, int K, int N, bf16_t* WT, int ldk, int mode, LAS float* scr, int item, int lane) {
  const int nblk = N / 32, kb = item / nblk, nb = item % nblk, k0 = 64 * kb, n0 = 32 * nb;
  const int sc = src_col(n0 + (lane & 31), mode);
#pragma unroll 8
  for (int i = 0; i < 32; ++i) { const int kk = 2 * i + (lane >> 5); scr[kk * 33 + (lane & 31)] = W[(size_t)(k0 + kk) * N + sc]; }
  asm volatile("s_waitcnt lgkmcnt(0)" ::: "memory");
  const int c = lane & 7;
#pragma unroll
  for (int j = 0; j < 4; ++j) { const int n = (lane >> 3) + 8 * j; const LAS float* s = scr + (8 * c) * 33 + n;
    u32x4 o; o.x = cvtpk(s[0 * 33], s[1 * 33]); o.y = cvtpk(s[2 * 33], s[3 * 33]); o.z = cvtpk(s[4 * 33], s[5 * 33]); o.w = cvtpk(s[6 * 33], s[7 * 33]);
    *(u32x4*)(WT + (size_t)(n0 + n) * ldk + k0 + 8 * c) = o; }
  asm volatile("s_waitcnt lgkmcnt(0)" ::: "memory");
}
__device__ __forceinline__ void conv_mat(const float* W, int K, int N, bf16_t* WT, int mode, LAS float* scr, int gw, int ngw, int lane, int ldk = 0) {
  const int items = (K / 64) * (N / 32);
  for (int it = gw; it < items; it += ngw) tr_item(W, K, N, WT, ldk ? ldk : K, mode, scr, it, lane);
}
__device__ __forceinline__ void conv_pool(const float* Wp, bf16_t* WT, LAS float* scr, int gw, int ngw, int lane) {
  for (int it = gw; it < 8 * 16; it += ngw) {
    const int kb = it / 16, nb = it % 16, k0 = 64 * kb, n0 = 32 * nb, gk = k0 >> 7, gn = n0 >> 7;
    if (gk == gn) {
      const float* W = Wp + (size_t)gk * 128 * 128;
#pragma unroll 8
      for (int i = 0; i < 32; ++i) { const int kk = 2 * i + (lane >> 5); scr[kk * 33 + (lane & 31)] = W[(size_t)(k0 - gk * 128 + kk) * 128 + (n0 - gn * 128) + (lane & 31)]; }
    } else {
#pragma unroll 8
      for (int i = 0; i < 32; ++i) { const int kk = 2 * i + (lane >> 5); scr[kk * 33 + (lane & 31)] = 0.f; }
    }
    asm volatile("s_waitcnt lgkmcnt(0)" ::: "memory");
    const int c = lane & 7;
#pragma unroll
    for (int j = 0; j < 4; ++j) { const int n = (lane >> 3) + 8 * j; const LAS float* s = scr + (8 * c) * 33 + n;
      u32x4 o; o.x = cvtpk(s[0 * 33], s[1 * 33]); o.y = cvtpk(s[2 * 33], s[3 * 33]); o.z = cvtpk(s[4 * 33], s[5 * 33]); o.w = cvtpk(s[6 * 33], s[7 * 33]);
      *(u32x4*)(WT + (size_t)(n0 + n) * 512 + k0 + 8 * c) = o; }
    asm volatile("s_waitcnt lgkmcnt(0)" ::: "memory");
  }
}
__device__ __forceinline__ void conv_layer(const Params& p, int L, LAS unsigned char* lds, int gw, int ngw, int wid, int lane) {
  LAS float* scr = (LAS float*)(lds + wid * 16384);
  unsigned char* ws = p.ws; const int i = L >> 1;
  conv_mat(p.w_ffn_in + (size_t)L * DM * DFF, DM, DFF, (bf16_t*)(ws + WS_WFF1), 0, scr, gw, ngw, lane);
  conv_mat(p.w_ffn_out + (size_t)L * DFF * DM, DFF, DM, (bf16_t*)(ws + WS_WFF2), 0, scr, gw, ngw, lane);
  if ((L & 1) == 0) {
    conv_mat(p.w_in_even + (size_t)i * DM * 928, DM, 928, (bf16_t*)(ws + WS_WA), 0, scr, gw, ngw, lane);
    conv_mat(p.w_uq + (size_t)i * 256 * 768, 256, 768, (bf16_t*)(ws + WS_WUQ), 1, scr, gw, ngw, lane);
    conv_mat(p.w_ukv + (size_t)i * 128 * 1024, 128, 1024, (bf16_t*)(ws + WS_WUKV), 0, scr, gw, ngw, lane, 256);
    for (int e = gw * 64 + lane; e < 1024 * 16; e += ngw * 64) { const int n = e >> 4, c = e & 15; *(u32x4*)((bf16_t*)(ws + WS_WUKV) + (size_t)n * 256 + 128 + c * 8) = (u32x4){0u, 0u, 0u, 0u}; }
    conv_pool(p.w_pool + (size_t)i * 4 * 128 * 128, (bf16_t*)(ws + WS_WPOOL), scr, gw, ngw, lane);
    conv_mat(p.w_out_even + (size_t)i * 1024 * 1024, 1024, 1024, (bf16_t*)(ws + WS_WB), 0, scr, gw, ngw, lane);
  } else {
    conv_mat(p.w_in_odd + (size_t)i * DM * 6144, DM, 6144, (bf16_t*)(ws + WS_WA), 2, scr, gw, ngw, lane);
    conv_mat(p.w_out_odd + (size_t)i * 2048 * 1024, 2048, 1024, (bf16_t*)(ws + WS_WB), 0, scr, gw, ngw, lane);
  }
}

__device__ __forceinline__ void p0_phase(const Params& p, LAS unsigned char* lds, const int tid, const int bid) {
  const int G = gridDim.x, lane = tid & 63, wid = tid >> 6;
  float* mod = (float*)(p.ws + WS_MOD);
  LAS float* sc = (LAS float*)lds;
  LAS float* part = (LAS float*)(lds + 9 * 1024 * 4);
  for (int e = tid; e < 9 * 1024; e += NTHR) { const int r = e >> 10, k = e & 1023; const float v = (r < 8) ? p.c[r * DM + k] : p.c_ctx[k]; sc[e] = v / (1.f + expf(-v)); }
  __syncthreads();
  for (int it = bid; it < 4 * 96; it += G) {
    const int L = it / 96, col0 = (it % 96) * 64;
    float a0 = 0, a1 = 0, a2 = 0, a3 = 0, a4 = 0, a5 = 0, a6 = 0, a7 = 0, a8 = 0;
    const float* wp = p.w_ada + ((size_t)L * DM + wid * 128) * 6144 + col0 + lane;
    const LAS float* s0 = sc + wid * 128;
#pragma unroll 16
    for (int k = 0; k < 128; ++k) { const float w = wp[(size_t)k * 6144];
      a0 += s0[k] * w; a1 += s0[1024 + k] * w; a2 += s0[2048 + k] * w; a3 += s0[3072 + k] * w; a4 += s0[4096 + k] * w; a5 += s0[5120 + k] * w; a6 += s0[6144 + k] * w; a7 += s0[7168 + k] * w; a8 += s0[8192 + k] * w; }
    LAS float* pp = part + wid * 9 * 64 + lane;
    pp[0] = a0; pp[64] = a1; pp[128] = a2; pp[192] = a3; pp[256] = a4; pp[320] = a5; pp[384] = a6; pp[448] = a7; pp[512] = a8;
    __syncthreads();
    for (int e = tid; e < 9 * 64; e += NTHR) { const int r = e >> 6, cl = e & 63; float v = p.b_ada[L * 6144 + col0 + cl];
#pragma unroll
      for (int w = 0; w < 8; ++w) v += part[w * 9 * 64 + e];
      mod[((size_t)L * 9 + r) * 6144 + col0 + cl] = v; }
    __syncthreads();
  }
  float* tab = (float*)(p.ws + WS_TAB);
  for (int e = bid * NTHR + tid; e < 1024 + 4096; e += G * NTHR) {
    if (e < 1024) { const int pos = e >> 3, i = e & 7; const float fr = powf(10000.f, -(float)(2 * i) / 16.f), a = (float)pos * fr; tab[e] = cosf(a); tab[1024 + e] = sinf(a); }
    else { const int q = e - 1024, pos = q >> 5, i = q & 31; const float fr = powf(10000.f, -(float)(2 * i) / 64.f), a = (float)pos * fr; tab[2048 + q] = cosf(a); tab[2048 + 4096 + q] = sinf(a); }
  }
}

__device__ __forceinline__ const float* xrow_ptr(const float* xl, const float* xc, int r) {
  const int b = r / SEGL, w = r % SEGL;
  return (w < CTXL) ? xc + (size_t)(b * CTXL + w) * DM : xl + (size_t)(b * SEQL + (w - CTXL)) * DM;
}
__device__ __forceinline__ void norm_phase(const Params& p, bool first, bool has_res, bool final_, const float* gpost, const float* gate_mod  ,
                                            const float* gpre, const float* shsc_mod  , int gw, int ngw, int lane, bool dry = false, const float* ysplit = nullptr) {
  const bf16_t* Y = (const bf16_t*)(p.ws + WS_Y); bf16_t* H = (bf16_t*)(p.ws + WS_H); float* XC = (float*)(p.ws + WS_XC);
  const float* xl = first ? p.x : p.out; const float* xc = first ? p.ctx : XC;
  const int rbeg = gw, rend = T, rstep = ngw;
  if (rbeg >= rend) return;
  int cur_m = -1;
  f32x4 cres[4], ca[4], csh[4];
#pragma unroll
  for (int j = 0; j < 4; ++j) { cres[j] = (f32x4){0.f, 0.f, 0.f, 0.f}; ca[j] = cres[j]; csh[j] = cres[j]; }
  f32x4 nx[4]; u32x2 ny[4];
  { const float* xs = xrow_ptr(xl, xc, rbeg);
#pragma unroll
    for (int j = 0; j < 4; ++j) { nx[j] = __builtin_nontemporal_load(((const f32x4*)xs) + lane + 64 * j); ny[j] = has_res ? __builtin_nontemporal_load(((const u32x2*)(Y + (size_t)rbeg * DM)) + lane + 64 * j) : (u32x2){0u, 0u}; } }
  for (int r = rbeg; r < rend; r += rstep) {
    const int b = r / SEGL, w = r % SEGL; const bool isctx = w < CTXL;
    float* xd = (isctx ? XC + (size_t)(b * CTXL + w) * DM : p.out + (size_t)(b * SEQL + (w - CTXL)) * DM);
    const int mrow = isctx ? 8 : b;
    f32x4 v[4]; u32x2 yq[4];
#pragma unroll
    for (int j = 0; j < 4; ++j) { v[j] = nx[j]; yq[j] = ny[j]; }
    if (r + rstep < rend) { const float* xs = xrow_ptr(xl, xc, r + rstep);
#pragma unroll
      for (int j = 0; j < 4; ++j) { nx[j] = __builtin_nontemporal_load(((const f32x4*)xs) + lane + 64 * j); if (has_res) ny[j] = __builtin_nontemporal_load(((const u32x2*)(Y + (size_t)(r + rstep) * DM)) + lane + 64 * j); } }
    if (final_ && isctx) continue;
    if (mrow != cur_m) { cur_m = mrow;
#pragma unroll
      for (int j = 0; j < 4; ++j) {
        if (has_res) cres[j] = ((const f32x4*)gpost)[lane + 64 * j] * ((const f32x4*)(gate_mod + (size_t)mrow * 6144))[lane + 64 * j];
        if (!final_) { ca[j] = ((const f32x4*)gpre)[lane + 64 * j] * (((const f32x4*)(shsc_mod + (size_t)mrow * 6144 + 1024))[lane + 64 * j] + 1.f); csh[j] = ((const f32x4*)(shsc_mod + (size_t)mrow * 6144))[lane + 64 * j]; } } }
    if (has_res) {
      f32x4 y[4]; float ss = 0.f;
#pragma unroll
      for (int j = 0; j < 4; ++j) y[j] = (f32x4){bflo(yq[j].x), bfhi(yq[j].x), bflo(yq[j].y), bfhi(yq[j].y)};
      if (ysplit && isctx) {
        const float* yp = ysplit + (size_t)(b * CTXL + w) * DM;
#pragma unroll
        for (int j = 0; j < 4; ++j) y[j] = ((const f32x4*)yp)[lane + 64 * j];
#pragma unroll 1
        for (int k = 1; k < 8; ++k) {
#pragma unroll
          for (int j = 0; j < 4; ++j) y[j] = y[j] + ((const f32x4*)(yp + (size_t)k * 2048 * DM))[lane + 64 * j]; }
      }
#pragma unroll
      for (int j = 0; j < 4; ++j) ss += (y[j].x * y[j].x + y[j].y * y[j].y) + (y[j].z * y[j].z + y[j].w * y[j].w);
      const float rs = rsqrtf(wave_sum(ss) * (1.f / DM) + EPS);
#pragma unroll
      for (int j = 0; j < 4; ++j) v[j] = v[j] + cres[j] * (y[j] * rs);
    }
    if ((has_res || first) && !dry) {
#pragma unroll
      for (int j = 0; j < 4; ++j) __builtin_nontemporal_store(v[j], ((f32x4*)xd) + lane + 64 * j);
    }
    if (!final_) {
      float ss = 0.f;
#pragma unroll
      for (int j = 0; j < 4; ++j) ss += (v[j].x * v[j].x + v[j].y * v[j].y) + (v[j].z * v[j].z + v[j].w * v[j].w);
      const float rs = rsqrtf(wave_sum(ss) * (1.f / DM) + EPS);
#pragma unroll
      for (int j = 0; j < 4; ++j) { const f32x4 h = (v[j] * rs) * ca[j] + csh[j];
        u32x2 o; o.x = cvtpk(h.x, h.y); o.y = cvtpk(h.z, h.w); __builtin_nontemporal_store(o, ((u32x2*)(H + (size_t)r * DM)) + lane + 64 * j); }
    }
  }
}

__device__ __forceinline__ void mid_phase(const Params& p, int i, int gw, int ngw, int lane) {
  const bf16_t* U = (const bf16_t*)(p.ws + WS_B0); bf16_t* UQN = (bf16_t*)(p.ws + WS_UQN); bf16_t* UKVN = (bf16_t*)(p.ws + WS_UKVN); bf16_t* KR = (bf16_t*)(p.ws + WS_KR); bf16_t* PD = (bf16_t*)(p.ws + WS_PD);
  const float* tab = (const float*)(p.ws + WS_TAB);
  const float* gq = p.g_q_lora + i * 256; const float* gkv = p.g_kv_lora + i * 128;
  for (int r = gw; r < T; r += ngw) {
    const int w = r % SEGL; const bool isctx = w < CTXL; const int t = isctx ? w : w - CTXL, Lseg = isctx ? CTXL : SEQL;
    const bf16_t* ur = U + (size_t)r * 1024;
    {
      const u32x2 q = ((const u32x2*)ur)[lane]; const float a0 = bflo(q.x), a1 = bfhi(q.x), a2 = bflo(q.y), a3 = bfhi(q.y);
      const float rs = rsqrtf(wave_sum(a0 * a0 + a1 * a1 + a2 * a2 + a3 * a3) * (1.f / 256.f) + EPS);
      const f32x4 g = ((const f32x4*)gq)[lane]; u32x2 o; o.x = cvtpk(a0 * rs * g.x, a1 * rs * g.y); o.y = cvtpk(a2 * rs * g.z, a3 * rs * g.w);
      ((u32x2*)(UQN + (size_t)r * 256))[lane] = o; }
    {
      const unsigned q = ((const unsigned*)(ur + 256))[lane]; const float a0 = bflo(q), a1 = bfhi(q);
      const float rs = rsqrtf(wave_sum(a0 * a0 + a1 * a1) * (1.f / 128.f) + EPS);
      ((unsigned*)(UKVN + (size_t)r * 128))[lane] = cvtpk(a0 * rs * gkv[2 * lane], a1 * rs * gkv[2 * lane + 1]); }
    {
      const int j = lane & 31; const float val = bflo((unsigned)ur[384 + j]); const float pv = __shfl_xor(val, 8);
      const int part = j >> 4, jj = j & 15, isx2 = jj >> 3, fi = jj & 7;
      float o = val;
      if (!isctx) { const int pos = part ? (t & 63) : (t >> 6); const float cs = tab[pos * 8 + fi], sn = tab[1024 + pos * 8 + fi]; o = isx2 ? (pv * sn + val * cs) : (val * cs - pv * sn); }
      const int dst = part * 16 + 8 * (fi >> 2) + (fi & 3) + 4 * isx2;
      if (lane < 32) KR[(size_t)r * 32 + dst] = f2bf(o); }
    {
      const int g = lane >> 4, wn = 2 << g; const int lo = max(t - (wn >> 1), 0), hi = min(t + wn - (wn >> 1), Lseg);
      float s[8] = {0, 0, 0, 0, 0, 0, 0, 0};
      const bf16_t* base = ur + 416 + lane * 8;
#pragma unroll
      for (int k = 0; k < 16; ++k) { const int q = t - 8 + k;
        if (q >= lo && q < hi) { const u32x4 d = *(const u32x4*)(base + (ptrdiff_t)(q - t) * 1024);
          s[0] += bflo(d.x); s[1] += bfhi(d.x); s[2] += bflo(d.y); s[3] += bfhi(d.y); s[4] += bflo(d.z); s[5] += bfhi(d.z); s[6] += bflo(d.w); s[7] += bfhi(d.w); } }
      const u32x4 own = *(const u32x4*)base; const float inv = 1.f / (float)(hi - lo);
      u32x4 o; o.x = cvtpk(s[0] * inv - bflo(own.x), s[1] * inv - bfhi(own.x)); o.y = cvtpk(s[2] * inv - bflo(own.y), s[3] * inv - bfhi(own.y));
      o.z = cvtpk(s[4] * inv - bflo(own.z), s[5] * inv - bfhi(own.z)); o.w = cvtpk(s[6] * inv - bflo(own.w), s[7] * inv - bfhi(own.w));
      *(u32x4*)(PD + (size_t)r * 512 + lane * 8) = o; }
  }
}

__device__ __forceinline__ void gn_phase(const Params& p, int gw, int ngw, int lane) {
  bf16_t* U = (bf16_t*)(p.ws + WS_B0);
  for (int r = gw; r < T; r += ngw) {
#pragma unroll
    for (int i = 0; i < 4; ++i) {
      bf16_t* ptr = U + (size_t)r * 4096 + 2048 + (i * 64 + lane) * 8;
      const u32x4 d = *(const u32x4*)ptr;
      float v[8] = {bflo(d.x), bfhi(d.x), bflo(d.y), bfhi(d.y), bflo(d.z), bfhi(d.z), bflo(d.w), bfhi(d.w)};
      float s = ((v[0] + v[1]) + (v[2] + v[3])) + ((v[4] + v[5]) + (v[6] + v[7]));
#pragma unroll
      for (int o = 1; o < 32; o <<= 1) s += __shfl_xor(s, o);
      const float mu = s * (1.f / 256.f); float q = 0.f;
#pragma unroll
      for (int e = 0; e < 8; ++e) { v[e] -= mu; q += v[e] * v[e]; }
#pragma unroll
      for (int o = 1; o < 32; o <<= 1) q += __shfl_xor(q, o);
      const float rs = rsqrtf(q * (1.f / 256.f) + EPS);
      u32x4 w; w.x = cvtpk(v[0] * rs, v[1] * rs); w.y = cvtpk(v[2] * rs, v[3] * rs); w.z = cvtpk(v[4] * rs, v[5] * rs); w.w = cvtpk(v[6] * rs, v[7] * rs);
      *(u32x4*)ptr = w;
    }
  }
}

#define XB_TMO      128
#define XB_XCNT(j)  (256  + 64 * (j))
#define XB_XSUB(j)  (1280 + 64 * (j))
#define XB_XGEN(j)  (2304 + 64 * (j))
#define XB_TOP      3328
#define XB_TOPGEN   3392
#define XCD_BAR_WORDS 3456
#define XB_SPIN_CAP (1u << 18)

__device__ __forceinline__ unsigned xb_ld(unsigned* p)              { return __hip_atomic_load(p, __ATOMIC_RELAXED, __HIP_MEMORY_SCOPE_AGENT); }
__device__ __forceinline__ unsigned xb_add(unsigned* p, unsigned v) { return __hip_atomic_fetch_add(p, v, __ATOMIC_RELAXED, __HIP_MEMORY_SCOPE_AGENT); }
__device__ __forceinline__ unsigned xb_xcc_id() { return (unsigned)__builtin_amdgcn_s_getreg((3 << 11) | 20) & 0xFu; }
#define XB_SPIN(cond, bar) do { unsigned _sp = 0; while (cond) { __builtin_amdgcn_s_sleep(1); \
    if ((++_sp & 255u) == 0u) { if (xb_ld(&(bar)[XB_TMO])) break; if (_sp > XB_SPIN_CAP) { atomicAdd(&(bar)[XB_TMO], 1u); break; } } } } while (0)

struct XcdBarrier {
    unsigned* bar; unsigned x;
    volatile LAS unsigned* st;
};

__device__ __forceinline__ XcdBarrier xcd_barrier_post(unsigned* bar, volatile LAS unsigned* st) {
    XcdBarrier b; b.bar = bar; b.x = xb_xcc_id(); b.st = st;
    if (threadIdx.x == 0) (void)xb_add(&bar[XB_XCNT(b.x)], 1u);
    return b;
}
__device__ __forceinline__ void xcd_barrier_complete(unsigned* bar, unsigned x, unsigned& nloc, unsigned& nx) {
    const unsigned G = gridDim.x * gridDim.y * gridDim.z;
    unsigned sum, cnt, mine, sp = 0u;
    for (;;) {
        sum = 0u; cnt = 0u; mine = 0u;
#pragma unroll
        for (unsigned j = 0; j < 16; ++j) { const unsigned c = xb_ld(&bar[XB_XCNT(j)]); sum += c; cnt += (c > 0u) ? 1u : 0u; mine = (j == x) ? c : mine; }
        if (sum == G) break;
        __builtin_amdgcn_s_sleep(1);
        if ((++sp & 255u) == 0u) { if (xb_ld(&bar[XB_TMO])) break; if (sp > XB_SPIN_CAP) { atomicAdd(&bar[XB_TMO], 1u); break; } }
    }
    nloc = mine > 0u ? mine : 1u; nx = cnt > 0u ? cnt : 1u;
}

__device__ __forceinline__ void xcd_barrier(const XcdBarrier& b) {
    asm volatile("s_waitcnt vmcnt(0)" ::: "memory");
    __syncthreads();
    if (threadIdx.x == 0) {
        unsigned* bar = b.bar;
        __builtin_amdgcn_s_waitcnt(0);
        unsigned nloc = b.st[0], nx = b.st[1];
        if (nloc == 0u) { xcd_barrier_complete(bar, b.x, nloc, nx); b.st[0] = nloc; b.st[1] = nx; }
        const unsigned old = xb_add(&bar[XB_XSUB(b.x)], 1u);
        const unsigned gen = old / nloc;
        if (old + 1u == (gen + 1u) * nloc) {
            __builtin_amdgcn_fence(__ATOMIC_RELEASE, "agent");
            asm volatile("s_waitcnt vmcnt(0)" ::: "memory");
            const unsigned og = xb_add(&bar[XB_TOP], 1u);
            const unsigned tg = og / nx;
            if (og + 1u == (tg + 1u) * nx) xb_add(&bar[XB_TOPGEN], 1u);
            else XB_SPIN(xb_ld(&bar[XB_TOPGEN]) == tg, bar);
            __builtin_amdgcn_fence(__ATOMIC_ACQUIRE, "agent");
            xb_add(&bar[XB_XGEN(b.x)], 1u);
            asm volatile("s_waitcnt vmcnt(0)" ::: "memory");
        } else {
            XB_SPIN(xb_ld(&bar[XB_XGEN(b.x)]) == gen, bar);
            __builtin_amdgcn_fence(__ATOMIC_ACQUIRE, "agent");
            asm volatile("s_waitcnt vmcnt(0)" ::: "memory");
        }
    }
    __syncthreads();
}

typedef short v4i16_t __attribute__((ext_vector_type(4)));
__device__ __forceinline__ u32x2 tr_rd(const LAS bf16_t* p) { return __builtin_bit_cast(u32x2, __builtin_amdgcn_ds_read_tr16_b64_v4i16((LAS v4i16_t*)p)); }
constexpr int AT_KSTR = 104, AT_VSTR = 72, AT_BUF = 64 * AT_KSTR * 2 + 64 * AT_VSTR * 2;
__device__ __forceinline__ void attn_stage(LAS unsigned char* buf, int tid, u32x4 rk, u32x4 rv, u32x4 rr) {
  LAS bf16_t* Ks = (LAS bf16_t*)buf; LAS bf16_t* Vs = (LAS bf16_t*)(buf + 64 * AT_KSTR * 2);
  const int skey = tid >> 3, sch = tid & 7;
  *(LAS u32x4*)(Ks + skey * AT_KSTR + sch * 8) = rk;
  if (tid < 256) { const int rkey = tid >> 2, rch = tid & 3; *(LAS u32x4*)(Ks + rkey * AT_KSTR + 64 + rch * 8) = rr; }
  *(LAS u32x4*)(Vs + skey * AT_VSTR + sch * 8) = rv;
}
__device__ __forceinline__ void attn_unit(LAS unsigned char* lds, const bf16_t* Q, const bf16_t* KV, const bf16_t* KR, bf16_t* MIX, size_t qrow0, size_t krow0, int ntiles, int h, const int tid) {
  const int lane = tid & 63, wid = tid >> 6, c16 = lane & 15, quad = lane >> 4, tq = (lane & 15) >> 2, tp = lane & 3;
  const bf16_t* gk = KV + (krow0 + (tid >> 3)) * 1024 + h * 128 + (tid & 7) * 8;
  const bf16_t* gr = KR + (krow0 + ((tid & 255) >> 2)) * 32 + (tid & 3) * 8;
  bf16x8 qf[2][3];
#pragma unroll
  for (int qb = 0; qb < 2; ++qb)
#pragma unroll
    for (int ks = 0; ks < 3; ++ks) qf[qb][ks] = *(const bf16x8*)(Q + (qrow0 + wid * 32 + qb * 16 + c16) * 768 + h * 96 + ks * 32 + quad * 8);
  f32x4 o[2][4];
#pragma unroll
  for (int qb = 0; qb < 2; ++qb)
#pragma unroll
    for (int eb = 0; eb < 4; ++eb) o[qb][eb] = (f32x4){0.f, 0.f, 0.f, 0.f};
  float mref[2] = {0.f, 0.f}; f32x4 lacc[2] = {(f32x4){0.f, 0.f, 0.f, 0.f}, (f32x4){0.f, 0.f, 0.f, 0.f}};
  const bf16x8 ones = (bf16x8){0x3F80, 0x3F80, 0x3F80, 0x3F80, 0x3F80, 0x3F80, 0x3F80, 0x3F80};
  u32x4 rk = *(const u32x4*)gk, rv = *(const u32x4*)(gk + 64), rr = (u32x4){0, 0, 0, 0};
  if (tid < 256) rr = *(const u32x4*)gr;
  __syncthreads();
  attn_stage(lds, tid, rk, rv, rr);
  __syncthreads();
  for (int t = 0; t < ntiles; ++t) {
    LAS unsigned char* buf = lds + (t & 1) * AT_BUF;
    const bool more = (t + 1 < ntiles);
    if (more) { const bf16_t* g2 = gk + (size_t)(t + 1) * 64 * 1024; rk = *(const u32x4*)g2; rv = *(const u32x4*)(g2 + 64); if (tid < 256) rr = *(const u32x4*)(gr + (size_t)(t + 1) * 64 * 32); }
    const LAS bf16_t* Ks = (const LAS bf16_t*)buf; const LAS bf16_t* Vs = (const LAS bf16_t*)(buf + 64 * AT_KSTR * 2);
    f32x4 s[4][2];
#pragma unroll
    for (int kb = 0; kb < 4; ++kb) {
      bf16x8 kf[3];
#pragma unroll
      for (int ks = 0; ks < 3; ++ks) kf[ks] = *(const LAS bf16x8*)(Ks + (kb * 16 + c16) * AT_KSTR + ks * 32 + quad * 8);
#pragma unroll
      for (int qb = 0; qb < 2; ++qb) { const float nm = -mref[qb]; f32x4 a = (f32x4){nm, nm, nm, nm};
#pragma unroll
        for (int ks = 0; ks < 3; ++ks) a = mfma16(kf[ks], qf[qb][ks], a);
        s[kb][qb] = a; }
    }
#pragma unroll
    for (int qb = 0; qb < 2; ++qb) {
      float mx = -1e30f;
#pragma unroll
      for (int kb = 0; kb < 4; ++kb) mx = fmaxf(fmaxf(fmaxf(s[kb][qb][0], s[kb][qb][1]), fmaxf(s[kb][qb][2], s[kb][qb][3])), mx);
      mx = fmaxf(mx, __shfl_xor(mx, 16)); mx = fmaxf(mx, __shfl_xor(mx, 32));
      if (t == 0 || __any(mx > 8.f)) {
        const float delta = (t == 0) ? mx : fmaxf(mx, 0.f), alpha = (t == 0) ? 1.f : __builtin_amdgcn_exp2f(-delta);
        mref[qb] += delta; lacc[qb] = lacc[qb] * alpha;
#pragma unroll
        for (int kb = 0; kb < 4; ++kb) s[kb][qb] = s[kb][qb] - delta;
#pragma unroll
        for (int eb = 0; eb < 4; ++eb) o[qb][eb] = o[qb][eb] * alpha;
      }
#pragma unroll
      for (int kb = 0; kb < 4; ++kb)
#pragma unroll
        for (int r = 0; r < 4; ++r) s[kb][qb][r] = __builtin_amdgcn_exp2f(s[kb][qb][r]);
    }
#pragma unroll
    for (int s2 = 0; s2 < 2; ++s2) {
      bf16x8 pf[2];
#pragma unroll
      for (int qb = 0; qb < 2; ++qb) { u32x4 w; w.x = cvtpk(s[2 * s2][qb][0], s[2 * s2][qb][1]); w.y = cvtpk(s[2 * s2][qb][2], s[2 * s2][qb][3]);
        w.z = cvtpk(s[2 * s2 + 1][qb][0], s[2 * s2 + 1][qb][1]); w.w = cvtpk(s[2 * s2 + 1][qb][2], s[2 * s2 + 1][qb][3]); pf[qb] = __builtin_bit_cast(bf16x8, w);
        lacc[qb] = mfma16(ones, pf[qb], lacc[qb]); }
      const LAS bf16_t* vb = Vs + (32 * s2 + 4 * quad + tq) * AT_VSTR + 4 * tp;
#pragma unroll
      for (int eb = 0; eb < 4; ++eb) {
        const u32x2 lo = tr_rd(vb + 16 * eb), hi = tr_rd(vb + 16 * AT_VSTR + 16 * eb);
        const u32x4 vv = (u32x4){lo.x, lo.y, hi.x, hi.y}; const bf16x8 vf = __builtin_bit_cast(bf16x8, vv);
#pragma unroll
        for (int qb = 0; qb < 2; ++qb) o[qb][eb] = mfma16(vf, pf[qb], o[qb][eb]);
      }
    }
    if (more) attn_stage(lds + ((t + 1) & 1) * AT_BUF, tid, rk, rv, rr);
    __syncthreads();
  }
#pragma unroll
  for (int qb = 0; qb < 2; ++qb) {
    const float inv = 1.f / lacc[qb][0];
    bf16_t* op = MIX + (qrow0 + wid * 32 + qb * 16 + c16) * 1024 + h * 64 + quad * 4;
#pragma unroll
    for (int eb = 0; eb < 4; ++eb) { u32x2 w; w.x = cvtpk(o[qb][eb][0] * inv, o[qb][eb][1] * inv); w.y = cvtpk(o[qb][eb][2] * inv, o[qb][eb][3] * inv); *(u32x2*)(op + eb * 16) = w; }
  }
}
__device__ __forceinline__ void attn_phase(const Params& p, LAS unsigned char* lds, const int tid, const int bid) {
  const bf16_t* Q = (const bf16_t*)(p.ws + WS_Q); const bf16_t* KV = (const bf16_t*)(p.ws + WS_KV); const bf16_t* KR = (const bf16_t*)(p.ws + WS_KR); bf16_t* MIX = (bf16_t*)(p.ws + WS_B0);
  const int G = gridDim.x;
  for (int u = bid; u < 2048; u += G) {
    const int b = u & 7, rest = u >> 3, qb = rest & 31, h = rest >> 5;
    attn_unit(lds, Q, KV, KR, MIX, (size_t)b * SEGL + CTXL + (size_t)qb * 256, (size_t)b * SEGL, SEGL / 64, h, tid);
  }
  for (int u = bid; u < 64; u += G) {
    const int b = u & 7, h = u >> 3;
    attn_unit(lds, Q, KV, KR, MIX, (size_t)b * SEGL, (size_t)b * SEGL, CTXL / 64, h, tid);
  }
}

constexpr int RT_STR = 136, RT_VSTR = 72;
constexpr int RT_QS = 0, RT_KS = 128 * RT_STR * 2, RT_VS = 2 * RT_KS, RT_ST = RT_VS + 128 * RT_VSTR * 2;
__device__ __forceinline__ u32x4 scale8(u32x4 v, float f) {
  u32x4 o; o.x = cvtpk(bflo(v.x) * f, bfhi(v.x) * f); o.y = cvtpk(bflo(v.y) * f, bfhi(v.y) * f); o.z = cvtpk(bflo(v.z) * f, bfhi(v.z) * f); o.w = cvtpk(bflo(v.w) * f, bfhi(v.w) * f); return o;
}
__device__ __forceinline__ void ret_unit(LAS unsigned char* lds, bf16_t* U, bf16_t* OF, int b, int h, int sl, const int tid, const bool dry) {
  const int lane = tid & 63, wid = tid >> 6, c16 = lane & 15, quad = lane >> 4, tq = (lane & 15) >> 2, tp = lane & 3;
  LAS bf16_t* Qs = (LAS bf16_t*)(lds + RT_QS); LAS bf16_t* Ks = (LAS bf16_t*)(lds + RT_KS); LAS bf16_t* Vs = (LAS bf16_t*)(lds + RT_VS); LAS bf16_t* St = (LAS bf16_t*)(lds + RT_ST);
  const size_t rowb = (size_t)b * SEGL;
  const int n = 16 * wid + c16;
  for (int dir = 0; dir < 2; ++dir) {
    const int hh = dir ? (7 - h) : h;
    const float lg = log2f(1.0f - exp2f(-5.0f - (float)hh));
    const float gC = exp2f(lg * 128.f), g1 = exp2f(lg), g127 = exp2f(lg * 127.f);
    const float dq = dir ? exp2f(lg * (float)(128 - n)) : exp2f(lg * (float)(n + 1));
    const float cn = dir ? exp2f(-lg * (float)n) : exp2f(lg * (float)n);
    float kf4[4];
#pragma unroll
    for (int i = 0; i < 4; ++i) { const int row = (tid + 512 * i) >> 4; kf4[i] = dir ? exp2f(lg * (float)row) : exp2f(-lg * (float)row); }
    f32x4 st[4];
#pragma unroll
    for (int eb = 0; eb < 4; ++eb) st[eb] = (f32x4){0.f, 0.f, 0.f, 0.f};
    u32x4 rq[4], rk[4], rv[2];
    { const int c0 = dir ? 1 : 0; const size_t row0 = rowb + (size_t)c0 * 128;
#pragma unroll
      for (int i = 0; i < 4; ++i) { const int idx = tid + 512 * i, row = idx >> 4, ch = idx & 15; const bf16_t* src = U + (row0 + row) * 4096 + h * 128 + ch * 8; rq[i] = *(const u32x4*)src; rk[i] = *(const u32x4*)(src + 1024); }
#pragma unroll
      for (int i = 0; i < 2; ++i) { const int idx = tid + 512 * i, row = idx >> 3, ch = idx & 7; rv[i] = *(const u32x4*)(U + (row0 + row) * 4096 + 2048 + h * 256 + sl * 64 + ch * 8); } }
    for (int step = 0; step < 66; ++step) {
      const int c = dir ? ((step < 2) ? (1 - step) : (67 - step)) : step;
      const size_t grow = rowb + (size_t)c * 128 + n;
      __syncthreads();
#pragma unroll
      for (int i = 0; i < 4; ++i) { const int idx = tid + 512 * i, row = idx >> 4, ch = idx & 15;
        *(LAS u32x4*)(Qs + row * RT_STR + ch * 8) = rq[i]; *(LAS u32x4*)(Ks + row * RT_STR + ch * 8) = scale8(rk[i], kf4[i]); }
#pragma unroll
      for (int i = 0; i < 2; ++i) { const int idx = tid + 512 * i, row = idx >> 3, ch = idx & 7; *(LAS u32x4*)(Vs + row * RT_VSTR + ch * 8) = rv[i]; }
#pragma unroll
      for (int eb = 0; eb < 4; ++eb)
#pragma unroll
        for (int r = 0; r < 4; ++r) St[(16 * eb + 4 * quad + r) * RT_STR + 16 * wid + c16] = f2bf(st[eb][r]);
      __syncthreads();
      if (step + 1 < 66) { const int s1 = step + 1; const int c1 = dir ? ((s1 < 2) ? (1 - s1) : (67 - s1)) : s1; const size_t r1 = rowb + (size_t)c1 * 128;
#pragma unroll
        for (int i = 0; i < 4; ++i) { const int idx = tid + 512 * i, row = idx >> 4, ch = idx & 15; const bf16_t* src = U + (r1 + row) * 4096 + h * 128 + ch * 8; rq[i] = *(const u32x4*)src; rk[i] = *(const u32x4*)(src + 1024); }
#pragma unroll
        for (int i = 0; i < 2; ++i) { const int idx = tid + 512 * i, row = idx >> 3, ch = idx & 7; rv[i] = *(const u32x4*)(U + (r1 + row) * 4096 + 2048 + h * 256 + sl * 64 + ch * 8); } }
      u32x2 fo[4];
      if (dir) { const bf16_t* ip = OF + grow * 2048 + h * 256 + sl * 64 + quad * 4;
#pragma unroll
        for (int eb = 0; eb < 4; ++eb) fo[eb] = *(const u32x2*)(ip + eb * 16); }
      bf16x8 qf[4];
#pragma unroll
      for (int ks = 0; ks < 4; ++ks) qf[ks] = *(const LAS bf16x8*)(Qs + n * RT_STR + ks * 32 + quad * 8);
      f32x4 o[4];
#pragma unroll
      for (int eb = 0; eb < 4; ++eb) { f32x4 a = (f32x4){0.f, 0.f, 0.f, 0.f};
#pragma unroll
        for (int ks = 0; ks < 4; ++ks) { const bf16x8 af = *(const LAS bf16x8*)(St + (16 * eb + c16) * RT_STR + ks * 32 + quad * 8); a = mfma16(af, qf[ks], a); }
        o[eb] = a * dq; }
      const float pre = dir ? gC : g1, post = dir ? 1.f : g127;
#pragma unroll
      for (int eb = 0; eb < 4; ++eb) st[eb] = st[eb] * pre;
#pragma unroll 2
      for (int s2 = 0; s2 < 4; ++s2) {
        const LAS bf16_t* vb = Vs + (32 * s2 + 4 * quad + tq) * RT_VSTR + 4 * tp;
        bf16x8 vf[4];
#pragma unroll
        for (int eb = 0; eb < 4; ++eb) { const u32x2 lo = tr_rd(vb + 16 * eb), hi = tr_rd(vb + 16 * RT_VSTR + 16 * eb); const u32x4 vv = (u32x4){lo.x, lo.y, hi.x, hi.y}; vf[eb] = __builtin_bit_cast(bf16x8, vv); }
        const bool needed = dir ? (2 * s2 + 1 >= wid) : (2 * s2 <= wid);
        if (needed) {
          float pw[8];
#pragma unroll
          for (int hf = 0; hf < 2; ++hf) { const int mb = 2 * s2 + hf; f32x4 a = (f32x4){0.f, 0.f, 0.f, 0.f};
#pragma unroll
            for (int ks = 0; ks < 4; ++ks) { const bf16x8 kf = *(const LAS bf16x8*)(Ks + (16 * mb + c16) * RT_STR + ks * 32 + quad * 8); a = mfma16(kf, qf[ks], a); }
#pragma unroll
            for (int r = 0; r < 4; ++r) { const int m = 16 * mb + 4 * quad + r; const bool keep = dir ? (m > n) : (n >= m); pw[4 * hf + r] = keep ? a[r] * cn : 0.f; } }
          u32x4 w; w.x = cvtpk(pw[0], pw[1]); w.y = cvtpk(pw[2], pw[3]); w.z = cvtpk(pw[4], pw[5]); w.w = cvtpk(pw[6], pw[7]);
          const bf16x8 pf = __builtin_bit_cast(bf16x8, w);
#pragma unroll
          for (int eb = 0; eb < 4; ++eb) o[eb] = mfma16(vf[eb], pf, o[eb]);
        }
        const LAS bf16_t* kb = Ks + (32 * s2 + 4 * quad + tq) * RT_STR + 16 * wid + 4 * tp;
        const u32x2 klo = tr_rd(kb), khi = tr_rd(kb + 16 * RT_STR);
        const u32x4 kk = (u32x4){klo.x, klo.y, khi.x, khi.y}; const bf16x8 bk = __builtin_bit_cast(bf16x8, kk);
#pragma unroll
        for (int eb = 0; eb < 4; ++eb) st[eb] = mfma16(vf[eb], bk, st[eb]);
      }
#pragma unroll
      for (int eb = 0; eb < 4; ++eb) st[eb] = st[eb] * post;
      if (dir == 0) { bf16_t* op = OF + grow * 2048 + h * 256 + sl * 64 + quad * 4;
#pragma unroll
        for (int eb = 0; eb < 4; ++eb) { u32x2 w; w.x = cvtpk(o[eb][0], o[eb][1]); w.y = cvtpk(o[eb][2], o[eb][3]); *(u32x2*)(op + eb * 16) = w; } }
      else { bf16_t* op = U + grow * 4096 + 2048 + h * 256 + sl * 64 + quad * 4;
#pragma unroll
        for (int eb = 0; eb < 4; ++eb) { u32x2 w; w.x = cvtpk(o[eb][0] + bflo(fo[eb].x), o[eb][1] + bfhi(fo[eb].x)); w.y = cvtpk(o[eb][2] + bflo(fo[eb].y), o[eb][3] + bfhi(fo[eb].y)); *(u32x2*)(op + eb * 16) = w; } }
    }
  }
}
__device__ __forceinline__ void ret_phase(const Params& p, LAS unsigned char* lds, const int tid, const int bid, const bool dry) {
  bf16_t* U = (bf16_t*)(p.ws + WS_B0); bf16_t* OF = (bf16_t*)(p.ws + WS_Y);
  for (int u = bid; u < 256; u += gridDim.x) { const int b = u & 7, rest = u >> 3, sl = rest & 3, h = rest >> 2; ret_unit(lds, U, OF, b, h, sl, tid, dry); }
}

#ifndef PHASE_MAP
#define PHASE_MAP(it) (it)
#define N_ITERS 38
#endif
#define RUN_GEMM(MODE, APTR, LDA_, BTPTR, N_, K_, OPTR, LDC_, COFF_, CS_, TAB_, SCALE_) do { const int skipc_ = ((L == 3 && s >= 4) || s == 8) ? 1 : 0; \
    pg8::Gemm g; g.A = (APTR); g.Bt = (BTPTR); g.M = T; g.N = (N_); g.K = (K_); g.lda = (LDA_); \
    Epi<MODE, LDC_, COFF_> E; E.O = (OPTR); E.cs = (CS_); E.tab = (TAB_); E.scale = (SCALE_); \
    pg8::StaticOrder S; S.init(T, (N_), G, (bid + G - rot_) % G, skipc_); \
    int tg_ = tid; asm volatile("" : "+v"(tg_)); \
    pg8::gemm_phase<Epi<MODE, LDC_, COFF_>, pg8::StaticOrder, true, true, K_, LDA_>(lds, g, S, E, tg_); \
    __syncthreads(); } while (0)
#define RUN_SPLIT(APTR, LDA_, BTPTR, LDB_, N_, KP_, NP_, OPTR) do { \
    pg8::Gemm g; g.A = (APTR); g.Bt = (BTPTR); g.M = T; g.N = (N_); g.K = (KP_); g.lda = (LDA_); \
    Epi<5, 1024, 0> E; E.O = (bf16_t*)(OPTR); E.cs = nullptr; E.tab = nullptr; E.scale = 1.f; \
    pg8::CtxSplitOrder S; S.init((N_), (NP_), G, bid); \
    int tg_ = tid; asm volatile("" : "+v"(tg_)); \
    pg8::gemm_phase<Epi<5, 1024, 0>, pg8::CtxSplitOrder, true, true, KP_, LDA_, LDB_>(lds, g, S, E, tg_); \
    __syncthreads(); } while (0)
__global__ void __launch_bounds__(NTHR, 2) mega(Params p_unused) {
  extern __shared__ __attribute__((aligned(16))) unsigned char lds_raw[];
  LAS unsigned char* lds = (LAS unsigned char*)lds_raw;
  const Params& p = *(const Params*)__builtin_amdgcn_kernarg_segment_ptr();
  const int G = gridDim.x;
  volatile LAS unsigned* bst = (volatile LAS unsigned*)(lds + LDS_BAR_OFF);
  if (threadIdx.x < 2) bst[threadIdx.x] = 0u;
  __syncthreads();
  const XcdBarrier bar = xcd_barrier_post((unsigned*)(p.ws + WS_BAR), bst);
  for (int it = p.lo; it < p.hi; ++it) {
    const int phc = PHASE_MAP(it); const int ph = phc & 63; const bool dry = (phc >> 6) != 0;
    if (it > p.lo + 1) { xcd_barrier(bar); }
    else if (it > p.lo) {
      asm volatile("s_waitcnt vmcnt(0) lgkmcnt(0)" ::: "memory");
      __syncthreads();
      if (threadIdx.x < 64) { __builtin_amdgcn_fence(__ATOMIC_RELEASE, "agent"); asm volatile("s_waitcnt vmcnt(0)" ::: "memory"); }
      cg::this_grid().sync();
      if (threadIdx.x < 64) { __builtin_amdgcn_fence(__ATOMIC_ACQUIRE, "agent"); asm volatile("s_waitcnt vmcnt(0)" ::: "memory"); }
      __syncthreads();
    }
    int tid = threadIdx.x; asm volatile("" : "+v"(tid));
    int bid = blockIdx.x; asm volatile("" : "+s"(bid));
    const int lane = tid & 63, wid = __builtin_amdgcn_readfirstlane(tid >> 6);
    const int gw = bid * NWAVE + wid, ngw = G * NWAVE;
    unsigned char* ws = p.ws;
    const float* mod = (const float*)(ws + WS_MOD);
    const float* tab = (const float*)(ws + WS_TAB);
    bf16_t* H = (bf16_t*)(ws + WS_H); bf16_t* B0 = (bf16_t*)(ws + WS_B0); bf16_t* Y = (bf16_t*)(ws + WS_Y);
    if (ph == 0) { p0_phase(p, lds, tid, bid); continue; }
    if (ph == 37) { norm_phase(p, false, true, true, p.g_ffn_post + 3 * DM, mod + (size_t)3 * 9 * 6144 + 5 * 1024, nullptr, nullptr, gw, ngw, lane); continue; }
    const int L = (ph - 1) / 9, s = (ph - 1) % 9, odd = L & 1, li = L >> 1;
    const float* modL = mod + (size_t)L * 9 * 6144;
    int rot_ = 0;
    if (s == 0) {
      conv_layer(p, L, lds, gw, ngw, wid, lane);
      norm_phase(p, L == 0, L > 0, false, p.g_ffn_post + (L > 0 ? (L - 1) : 0) * DM, mod + (size_t)(L > 0 ? (L - 1) : 0) * 9 * 6144 + 5 * 1024, p.g_mix_pre + L * DM, modL, gw, ngw, lane, false, (L > 0) ? (const float*)(ws + WS_YP) : nullptr);
      __syncthreads();
    }
    else if (s == 6) { norm_phase(p, false, true, false, p.g_mix_post + L * DM, modL + 2 * 1024, p.g_ffn_pre + L * DM, modL + 3 * 1024, gw, ngw, lane, dry); }
    else if (s == 7) { RUN_GEMM(1, H, 1024, (const bf16_t*)(ws + WS_WFF1), 4096, 1024, B0, 4096, 0, nullptr, tab, 1.f); }
    else if (s == 8) {
      RUN_GEMM(0, B0, 4096, (const bf16_t*)(ws + WS_WFF2), 1024, 4096, Y, 1024, 0, nullptr, tab, 1.f);
      if (L < 3) RUN_SPLIT(B0, 4096, (const bf16_t*)(ws + WS_WFF2), 4096, 1024, 512, 8, ws + WS_YP);
    }
    else if (!odd) {
      if (s == 1) { RUN_GEMM(0, H, 1024, (const bf16_t*)(ws + WS_WA), 1024, 1024, B0, 1024, 0, nullptr, tab, 1.f); }
      else if (s == 2) { mid_phase(p, li, gw, ngw, lane); }
      else if (s == 3) {
        RUN_GEMM(2, (const bf16_t*)(ws + WS_UQN), 256, (const bf16_t*)(ws + WS_WUQ), 768, 256, (bf16_t*)(ws + WS_Q), 768, 0, nullptr, tab, 0.10206207261596577f * 1.4426950408889634f);
        rot_ = 24;
        RUN_GEMM(0, (const bf16_t*)(ws + WS_UKVN), 128, (const bf16_t*)(ws + WS_WUKV), 1024, 256, (bf16_t*)(ws + WS_KV), 1024, 0, nullptr, tab, 1.f);
        rot_ = 56;
        RUN_GEMM(0, (const bf16_t*)(ws + WS_PD), 512, (const bf16_t*)(ws + WS_WPOOL), 512, 512, B0, 1024, 512, p.pool_scale + li * 512, tab, 1.f);
      }
      else if (s == 4) { attn_phase(p, lds, tid, bid); }
      else { RUN_GEMM(0, B0, 1024, (const bf16_t*)(ws + WS_WB), 1024, 1024, Y, 1024, 0, nullptr, tab, 1.f); }
    } else {
      if (s == 1) { RUN_GEMM(3, H, 1024, (const bf16_t*)(ws + WS_WA), 4096, 1024, B0, 4096, 0, nullptr, tab + 2048, 0.08838834764831845f); }
      else if (s == 2) { ret_phase(p, lds, tid, bid, dry); }
      else if (s == 3) { gn_phase(p, gw, ngw, lane); }
      else if (s == 4) { RUN_GEMM(4, H, 1024, (const bf16_t*)(ws + WS_WA) + (size_t)4096 * 1024, 2048, 1024, B0, 4096, 2048, nullptr, tab, 1.f); }
      else { RUN_GEMM(0, B0 + 2048, 4096, (const bf16_t*)(ws + WS_WB), 1024, 2048, Y, 1024, 0, nullptr, tab, 1.f); }
    }
  }
}

extern "C" void kernel_launch(void* const* d_in, const int* in_sizes, int n_in, void* d_out, int out_size, void* d_ws, size_t ws_size, hipStream_t stream) {
  static int grid = 0;
  if (grid == 0) {
    if (n_in != 22 || ws_size < WS_END) { fprintf(stderr, "kernel_launch: unexpected n_in %d or workspace %zu < %zu\n", n_in, ws_size, (size_t)WS_END); grid = -1; return; }
    int dev = 0, cus = 0, per_cu = 0;
    hipGetDevice(&dev); hipDeviceGetAttribute(&cus, hipDeviceAttributeMultiprocessorCount, dev);
    if (hipFuncSetAttribute((const void*)mega, hipFuncAttributeMaxDynamicSharedMemorySize, LDS_BYTES) != hipSuccess) { fprintf(stderr, "kernel_launch: hipFuncSetAttribute failed\n"); }
    if (hipOccupancyMaxActiveBlocksPerMultiprocessor(&per_cu, (const void*)mega, NTHR, LDS_BYTES) != hipSuccess || per_cu < 1) { fprintf(stderr, "kernel_launch: occupancy query gave %d\n", per_cu); per_cu = 1; }
    (void)hipGetLastError();
    grid = cus * 1;
  }
  if (grid < 0) return;
  if (hipMemsetAsync((char*)d_ws + WS_BAR, 0, XCD_BAR_WORDS * 4, stream) != hipSuccess) fprintf(stderr, "kernel_launch: memset of the barrier words failed\n");
  Params p{};
  const float** pp = (const float**)&p;
  for (int i = 0; i < 22; ++i) pp[i] = (const float*)d_in[i];
  p.out = (float*)d_out; p.ws = (unsigned char*)d_ws;
#ifndef N_SPLIT
  p.lo = 0; p.hi = N_ITERS;
  void* args[] = {&p};
  hipError_t e = hipLaunchCooperativeKernel((const void*)mega, dim3(grid), dim3(NTHR), args, LDS_BYTES, stream);
  if (e != hipSuccess) fprintf(stderr, "cooperative launch failed: %s (grid %d)\n", hipGetErrorString(e), grid);
#else
  for (int ph = 0; ph < 38; ++ph) { p.lo = ph; p.hi = ph + 1; hipLaunchKernelGGL(mega, dim3(grid), dim3(NTHR), LDS_BYTES, stream, p); }
#endif
}
```

```cpp
#include <hip/hip_runtime.h>
#include <hip/hip_cooperative_groups.h>
#include <cstdio>
#include <cstdint>
namespace cg = cooperative_groups;
namespace pg8 {
#define PG8_LAS __attribute__((address_space(3)))
typedef unsigned short bf16_t;
typedef short bf16x8 __attribute__((ext_vector_type(8)));
typedef float f32x4 __attribute__((ext_vector_type(4)));
typedef unsigned u32x4 __attribute__((ext_vector_type(4)));
constexpr int BM = 256, BK = 64, HALF = 128, HTB = HALF * BK * 2  , STAGE_BYTES = 8 * HTB, NXCD = 8, WGM = 8;

__host__ __device__ __forceinline__ int lds_byte(int r, int c) { const int st = (r >> 4) * 2 + (c >> 5), rr = r & 15, cc = c & 31, ob = rr * 64 + cc * 2; return st * 1024 + (ob ^ (((ob >> 9) & 1) << 5)); }
__host__ __device__ __forceinline__ void stage_rc(int b, int& R, int& C) { const int st = b / 1024, sb = b % 1024, swz = sb ^ (((sb >> 9) & 1) << 5); R = (st >> 1) * 16 + swz / 64; C = (st & 1) * 32 + (swz % 64) / 2; }
__host__ __device__ __forceinline__ int perm32(int rho) { const int n = rho >> 4, i = rho & 15; return 8 * (i >> 2) + 4 * n + (i & 3); }

struct Unit { int pm, pn, kp; };
struct Gemm { const bf16_t* A; const bf16_t* Bt; int M, N, K, lda; };

struct StaticOrder {
    int nM, nN, nwg, G, c, skip;
    __host__ __device__ void init(int M, int N, int G_, int c_, int skip_ = 0) { skip = skip_; nM = skip_ ? (M / BM / 33) * 32 : M / BM; nN = N / BM; nwg = nM * nN; G = G_; c = c_; }
    __host__ __device__ bool next(int i, Unit& u) const {
        const long L = (long)i * G + c; if (L >= nwg) return false;
        int wgid = (int)L; { const int q = nwg / NXCD, r = nwg % NXCD, xcd = wgid % NXCD, off = wgid / NXCD; wgid = (xcd < r ? xcd * (q + 1) : r * (q + 1) + (xcd - r) * q) + off; }
        const int nig = WGM * nN, gid = wgid / nig, fm = gid * WGM, gsz = (nM - fm) < WGM ? (nM - fm) : WGM;
        u.kp = 0; u.pm = fm + ((wgid % nig) % gsz); u.pn = (wgid % nig) / gsz; if (skip) u.pm = (u.pm >> 5) * 33 + 1 + (u.pm & 31); return true;
    }
    __device__ __forceinline__ void a_ready(const Unit&) const {}
    __device__ __forceinline__ void done(const Unit&) const {}
};

struct CtxSplitOrder {
    int nN, NP, G, c;
    __host__ __device__ void init(int N, int NP_, int G_, int c_) { nN = N / BM; NP = NP_; G = G_; c = c_; }
    __host__ __device__ bool next(int i, Unit& u) const {
        const int L = i * G + c; if (L >= 8 * nN * NP) return false;
        u.kp = L % NP; const int rest = L / NP; u.pn = rest % nN; u.pm = (rest / nN) * 33; return true;
    }
    __device__ __forceinline__ void a_ready(const Unit&) const {}
    __device__ __forceinline__ void done(const Unit&) const {}
};

template <class Epi, class Sched, bool ALIGN_EPI, bool SP2, int KC, int LDAC, int LDBC = KC>
__device__ __forceinline__ void gemm_phase(PG8_LAS unsigned char* lds, const Gemm g, const Sched& S, const Epi& E, const int tid) {
    const int wid = __builtin_amdgcn_readfirstlane(tid >> 6), lane = tid & 63, wr = wid >> 2, wc = wid & 3, fr = lane & 15, fq = lane >> 4;
    constexpr int K = KC, nt = K / BK;
    unsigned voffA[2], voffB[2];
#pragma unroll
    for (int i = 0; i < 2; ++i) { int R, C; stage_rc(tid * 16 + i * 8192, R, C); const int Rb = Epi::PERM ? ((R & ~31) + perm32(R & 31)) : R;
        voffA[i] = (unsigned)(R * LDAC + C) * 2u; voffB[i] = (unsigned)(Rb * LDBC + C) * 2u; }
    const size_t kstep = (size_t)(BK * 2);
    const size_t hstepA = (size_t)HALF * LDAC * 2, hstepB = (size_t)HALF * LDBC * 2;
    const size_t tstepA = 2 * hstepA, tstepB = 2 * hstepB;
    const unsigned ldsw = (unsigned)wid * 1024u;
    const int aoff = lds_byte(wr * 64 + fr, fq * 8), boff = lds_byte(wc * 32 + fr, fq * 8);
#define PG8_SA(b, h) (((b) * 2 + (h)) * HTB)
#define PG8_SB(b, h) ((4 + (b) * 2 + (h)) * HTB)
#define PG8_STAGE(bufoff, gbase, voff) do { _Pragma("unroll") for (int _i = 0; _i < 2; ++_i) \
        __builtin_amdgcn_global_load_lds((const unsigned*)((const char*)(gbase) + (voff)[_i]), (PG8_LAS unsigned*)(lds + (bufoff) + ldsw + _i * 8192), 16, 0, 0); } while (0)
#define PG8_LDA(dst, b, h) do { _Pragma("unroll") for (int m = 0; m < 4; ++m) _Pragma("unroll") for (int k = 0; k < 2; ++k) dst[m][k] = *(const PG8_LAS bf16x8*)(lds + PG8_SA(b, h) + aoff + m * 2048 + k * 1024); } while (0)
#define PG8_LDB(dst, b, h) do { _Pragma("unroll") for (int n = 0; n < 2; ++n) _Pragma("unroll") for (int k = 0; k < 2; ++k) dst[n][k] = *(const PG8_LAS bf16x8*)(lds + PG8_SB(b, h) + boff + n * 2048 + k * 1024); } while (0)
#define PG8_MMA(ai, bj, At, Bt) do { __builtin_amdgcn_s_setprio(1); _Pragma("unroll") for (int m = 0; m < 4; ++m) _Pragma("unroll") for (int n = 0; n < 2; ++n) _Pragma("unroll") for (int k = 0; k < 2; ++k) \
        acc[ai][bj][m][n] = __builtin_amdgcn_mfma_f32_16x16x32_bf16(Bt[n][k], At[m][k], acc[ai][bj][m][n], 0, 0, 0); __builtin_amdgcn_s_setprio(0); } while (0)
#define PG8_WAIT_V(n) asm volatile("s_waitcnt vmcnt(" #n ")" ::: "memory")
#define PG8_WAIT_L(n) asm volatile("s_waitcnt lgkmcnt(" #n ")" ::: "memory")
#define PG8_BAR __builtin_amdgcn_s_barrier()
#define PG8_SCHED __builtin_amdgcn_sched_barrier(0)
    Unit cur, nxt; int ui = 0;
    if (!S.next(0, cur)) return;
    f32x4 acc[2][2][4][2];
#pragma unroll
    for (int a = 0; a < 2; ++a)
#pragma unroll
        for (int b = 0; b < 2; ++b)
#pragma unroll
            for (int m = 0; m < 4; ++m)
#pragma unroll
                for (int n = 0; n < 2; ++n) acc[a][b][m][n] = (f32x4){0.f, 0.f, 0.f, 0.f};
    bf16x8 At[4][2], B0[2][2], B1[2][2];
    const char* cA = (const char*)g.A + (size_t)cur.pm * tstepA + (size_t)cur.kp * (K * 2); const char* cB = (const char*)g.Bt + (size_t)cur.pn * tstepB + (size_t)cur.kp * (K * 2);
    S.a_ready(cur);
    if constexpr (SP2) {
        PG8_STAGE(PG8_SB(0, 0), cB, voffB); PG8_STAGE(PG8_SB(0, 1), cB + hstepB, voffB); PG8_STAGE(PG8_SA(0, 0), cA, voffA); PG8_STAGE(PG8_SA(0, 1), cA + hstepA, voffA);
        if (wr == 1) PG8_BAR;
        PG8_WAIT_V(2); PG8_BAR;
        PG8_STAGE(PG8_SB(1, 0), cB + kstep, voffB); PG8_STAGE(PG8_SA(1, 0), cA + kstep, voffA); PG8_STAGE(PG8_SB(1, 1), cB + hstepB + kstep, voffB);
        PG8_WAIT_V(6); PG8_BAR;
    } else {
        PG8_STAGE(PG8_SB(0, 0), cB, voffB); PG8_STAGE(PG8_SA(0, 0), cA, voffA); PG8_STAGE(PG8_SB(0, 1), cB + hstepB, voffB); PG8_STAGE(PG8_SA(0, 1), cA + hstepA, voffA);
        if (wr == 1) PG8_BAR;
        PG8_WAIT_V(4); PG8_BAR;
        PG8_STAGE(PG8_SB(1, 0), cB + kstep, voffB); PG8_STAGE(PG8_SA(1, 0), cA + kstep, voffA); PG8_STAGE(PG8_SB(1, 1), cB + hstepB + kstep, voffB);
        PG8_WAIT_V(6); PG8_BAR;
    }
    for (;;) {
        const bool has_next = S.next(ui + 1, nxt);
        const char* nA = has_next ? (const char*)g.A + (size_t)nxt.pm * tstepA + (size_t)nxt.kp * (K * 2) : cA; const char* nB = has_next ? (const char*)g.Bt + (size_t)nxt.pn * tstepB + (size_t)nxt.kp * (K * 2) : cB;
#pragma nounroll
        for (int t = 0; t < nt; t += 2) {
            const bool last = (t == nt - 2);
            const char* a1 = cA + (size_t)(t + 1) * kstep;
            const char* a2 = last ? nA : cA + (size_t)(t + 2) * kstep; const char* b2 = last ? nB : cB + (size_t)(t + 2) * kstep;
            const char* a3 = a2 + kstep; const char* b3 = b2 + kstep;
            if (last && has_next) S.a_ready(nxt);
            if constexpr (SP2) {
            PG8_LDB(B0, 0, 0); PG8_LDB(B1, 0, 1); PG8_SCHED; PG8_LDA(At, 0, 0); PG8_STAGE(PG8_SA(1, 1), a1 + hstepA, voffA);
            PG8_WAIT_V(8); PG8_WAIT_L(0); PG8_BAR; PG8_MMA(0, 0, At, B0); PG8_MMA(0, 1, At, B1); PG8_BAR; PG8_SCHED;
            PG8_LDA(At, 0, 1); PG8_STAGE(PG8_SB(0, 0), b2, voffB); PG8_STAGE(PG8_SB(0, 1), b2 + hstepB, voffB); PG8_STAGE(PG8_SA(0, 0), a2, voffA);
            PG8_WAIT_V(8); PG8_WAIT_L(0); PG8_BAR; PG8_MMA(1, 0, At, B0); PG8_MMA(1, 1, At, B1); PG8_BAR; PG8_SCHED;
            PG8_LDB(B0, 1, 0); PG8_LDB(B1, 1, 1); PG8_SCHED; PG8_LDA(At, 1, 0); PG8_STAGE(PG8_SA(0, 1), a2 + hstepA, voffA);
            PG8_WAIT_V(8); PG8_WAIT_L(0); PG8_BAR; PG8_MMA(0, 0, At, B0); PG8_MMA(0, 1, At, B1); PG8_BAR; PG8_SCHED;
            PG8_LDA(At, 1, 1); PG8_STAGE(PG8_SB(1, 0), b3, voffB); PG8_STAGE(PG8_SB(1, 1), b3 + hstepB, voffB); PG8_STAGE(PG8_SA(1, 0), a3, voffA);
            PG8_WAIT_V(8); PG8_WAIT_L(0); PG8_BAR; PG8_MMA(1, 0, At, B0); PG8_MMA(1, 1, At, B1); PG8_BAR; PG8_SCHED;
            } else {
            PG8_LDB(B0, 0, 0); PG8_SCHED; PG8_LDA(At, 0, 0); PG8_STAGE(PG8_SA(1, 1), a1 + hstepA, voffA);
            PG8_WAIT_L(8); PG8_BAR; PG8_WAIT_L(0); PG8_MMA(0, 0, At, B0); PG8_BAR; PG8_SCHED;
            PG8_LDB(B1, 0, 1); PG8_STAGE(PG8_SB(0, 0), b2, voffB);
            PG8_BAR; PG8_WAIT_L(0); PG8_MMA(0, 1, At, B1); PG8_BAR;
            PG8_LDA(At, 0, 1); PG8_STAGE(PG8_SA(0, 0), a2, voffA);
            PG8_BAR; PG8_WAIT_L(0); PG8_MMA(1, 0, At, B0); PG8_BAR; PG8_SCHED;
            PG8_STAGE(PG8_SB(0, 1), b2 + hstepB, voffB);
            PG8_WAIT_V(6); PG8_BAR; PG8_MMA(1, 1, At, B1); PG8_BAR;
            PG8_LDB(B0, 1, 0); PG8_SCHED; PG8_LDA(At, 1, 0); PG8_STAGE(PG8_SA(0, 1), a2 + hstepA, voffA);
            PG8_WAIT_L(8); PG8_BAR; PG8_WAIT_L(0); PG8_MMA(0, 0, At, B0); PG8_BAR; PG8_SCHED;
            PG8_LDB(B1, 1, 1); PG8_STAGE(PG8_SB(1, 0), b3, voffB);
            PG8_BAR; PG8_WAIT_L(0); PG8_MMA(0, 1, At, B1); PG8_BAR;
            PG8_LDA(At, 1, 1); PG8_STAGE(PG8_SA(1, 0), a3, voffA);
            PG8_BAR; PG8_WAIT_L(0); PG8_MMA(1, 0, At, B0); PG8_BAR; PG8_SCHED;
            PG8_STAGE(PG8_SB(1, 1), b3 + hstepB, voffB);
            PG8_WAIT_V(6); PG8_BAR; PG8_MMA(1, 1, At, B1); PG8_BAR;
            }
        }
        if constexpr (ALIGN_EPI) { if (wr == 0) PG8_BAR; }
        if constexpr (!Epi::AFTER_DRAIN) { int te = tid; asm volatile("" : "+v"(te)); E(acc, cur, wr, wc, te & 15, (te & 63) >> 4); S.done(cur); }
        if (!has_next) break;
#pragma unroll
        for (int a = 0; a < 2; ++a)
#pragma unroll
            for (int b = 0; b < 2; ++b)
#pragma unroll
                for (int m = 0; m < 4; ++m)
#pragma unroll
                    for (int n = 0; n < 2; ++n) acc[a][b][m][n] = (f32x4){0.f, 0.f, 0.f, 0.f};
        cur = nxt; cA = nA; cB = nB; ++ui;
        if constexpr (ALIGN_EPI) { if (wr == 1) PG8_BAR; }
    }
    PG8_WAIT_V(0);
    if constexpr (!ALIGN_EPI) { if (wr == 0) PG8_BAR; }
    PG8_BAR;
    if constexpr (Epi::AFTER_DRAIN) { E.fused(acc, cur, wr, wc, fr, fq, lds, wid, lane); S.done(cur); }
#undef PG8_SA
#undef PG8_SB
#undef PG8_STAGE
#undef PG8_LDA
#undef PG8_LDB
#undef PG8_MMA
#undef PG8_WAIT_V
#undef PG8_WAIT_L
#undef PG8_BAR
#undef PG8_SCHED
}
}


#define LAS __attribute__((address_space(3)))
typedef unsigned short bf16_t;
typedef short bf16x8 __attribute__((ext_vector_type(8)));
typedef float f32x4 __attribute__((ext_vector_type(4)));
typedef unsigned u32x4 __attribute__((ext_vector_type(4)));
typedef unsigned u32x2 __attribute__((ext_vector_type(2)));
typedef float f32x2_t __attribute__((ext_vector_type(2)));
typedef __bf16 bf16x2_t __attribute__((ext_vector_type(2)));

constexpr int DM = 1024, NB = 8, SEQL = 8192, CTXL = 256, SEGL = SEQL + CTXL  , T = NB * SEGL  ;
constexpr int DFF = 4096, NTHR = 512, NWAVE = 8;
constexpr float EPS = 1e-6f;
constexpr size_t MiB = 1u << 20;
constexpr size_t WS_MOD = 0;
constexpr size_t WS_TAB = 1 * MiB;
constexpr size_t WS_XC = 2 * MiB;
constexpr size_t WS_WFF1 = 10 * MiB, WS_WFF2 = 18 * MiB, WS_WA = 26 * MiB, WS_WB = 38 * MiB;
constexpr size_t WS_WUQ = 28 * MiB, WS_WUKV = WS_WUQ + 512 * 1024, WS_WPOOL = 29 * MiB;
constexpr size_t WS_H = 46 * MiB;
constexpr size_t WS_B0 = 178 * MiB;
constexpr size_t WS_UQN = 310 * MiB, WS_UKVN = 343 * MiB, WS_KR = 360 * MiB, WS_PD = 365 * MiB, WS_Q = 431 * MiB, WS_KV = 530 * MiB;
constexpr size_t WS_Y = 706 * MiB;
constexpr size_t WS_YP = 838 * MiB;
constexpr size_t WS_END = 970 * MiB;
constexpr size_t WS_BAR = 900 * 1024;
constexpr int LDS_BAR_OFF = 141312;
constexpr int LDS_BYTES = 143360;

struct Params {
  const float *x, *c, *ctx, *c_ctx, *w_ada, *b_ada, *g_mix_pre, *g_mix_post, *g_ffn_pre, *g_ffn_post, *w_ffn_in, *w_ffn_out, *w_in_even, *g_q_lora, *g_kv_lora,
      *w_uq, *w_ukv, *w_pool, *pool_scale, *w_out_even, *w_in_odd, *w_out_odd;
  float* out; unsigned char* ws; int lo, hi;
};

__device__ __forceinline__ unsigned cvtpk(float lo, float hi) { f32x2_t v = {lo, hi}; bf16x2_t b = __builtin_convertvector(v, bf16x2_t); return __builtin_bit_cast(unsigned, b); }
__device__ __forceinline__ float bflo(unsigned u) { return __uint_as_float(u << 16); }
__device__ __forceinline__ float bfhi(unsigned u) { return __uint_as_float(u & 0xffff0000u); }
__device__ __forceinline__ bf16_t f2bf(float f) { return (bf16_t)(cvtpk(f, 0.f) & 0xffffu); }
__device__ __forceinline__ float wave_sum(float v) {
#pragma unroll
  for (int o = 1; o < 64; o <<= 1) v += __shfl_xor(v, o);
  return v;
}
__device__ __forceinline__ f32x4 mfma16(bf16x8 a, bf16x8 b, f32x4 c) { return __builtin_amdgcn_mfma_f32_16x16x32_bf16(a, b, c, 0, 0, 0); }

template <int mode, int ldc, int col_off> struct Epi {
  static constexpr bool PERM = true, AFTER_DRAIN = false;
  bf16_t* O; const float* cs; const float* tab; float scale;
  __device__ __forceinline__ void operator()(const f32x4 (&acc)[2][2][4][2], const pg8::Unit& u, int wr, int wc, int fr, int fq) const {
    const int seg = u.pm % 33; const bool islat = seg != 0;
    const int colt = u.pn * 256 + wc * 32 + 8 * fq;
#pragma unroll
    for (int ai = 0; ai < 2; ++ai)
#pragma unroll
      for (int m = 0; m < 4; ++m) {
        const int lrow = ai * 128 + wr * 64 + m * 16 + fr;
        const int row = u.pm * 256 + lrow;
        const int tok = (seg - 1) * 256 + lrow;
        bf16_t* rowp = O + (size_t)row * ldc + col_off;
#pragma unroll
        for (int bj = 0; bj < 2; ++bj) {
          const int c = colt + bj * 128;
          f32x4 v0 = acc[ai][bj][m][0], v1 = acc[ai][bj][m][1];
          if (mode == 5) {
            float* pp = (float*)O + ((size_t)(u.kp * 2048 + (u.pm / 33) * 256 + lrow) * 1024 + c);
            *(f32x4*)pp = v0; *(f32x4*)(pp + 4) = v1;
            continue;
          }
          if (mode == 1) {
#pragma unroll
            for (int i = 0; i < 4; ++i) { float a = fmaxf(v0[i], 0.f), b = fmaxf(v1[i], 0.f); v0[i] = a * a; v1[i] = b * b; }
          } else if (mode == 2) {
            const int hc = c % 96;
            if (islat && hc >= 64) {
              const int j = hc - 64, part = j >> 4, g = (j & 15) >> 3, pos = part ? (tok & 63) : (tok >> 6);
              const f32x4 cs4 = *(const f32x4*)(tab + pos * 8 + 4 * g), sn4 = *(const f32x4*)(tab + 1024 + pos * 8 + 4 * g);
              const f32x4 o0 = v0 * cs4 - v1 * sn4, o1 = v0 * sn4 + v1 * cs4; v0 = o0; v1 = o1;
            }
            v0 = v0 * scale; v1 = v1 * scale;
          } else if (mode == 3) {
            if (u.pn < 8) {
              if (islat) {
                const int hc = c & 127, part = hc >> 6, g = (hc & 63) >> 3, pos = part ? (tok & 63) : (tok >> 6);
                const f32x4 cs4 = *(const f32x4*)(tab + pos * 32 + 4 * g), sn4 = *(const f32x4*)(tab + 4096 + pos * 32 + 4 * g);
                const f32x4 o0 = v0 * cs4 - v1 * sn4, o1 = v0 * sn4 + v1 * cs4; v0 = o0; v1 = o1;
              }
              if (u.pn >= 4) { v0 = v0 * scale; v1 = v1 * scale; }
            }
          } else if (mode == 4) {
            const u32x4 old = *(const u32x4*)(rowp + c);
            const float ov[8] = {bflo(old.x), bfhi(old.x), bflo(old.y), bfhi(old.y), bflo(old.z), bfhi(old.z), bflo(old.w), bfhi(old.w)};
#pragma unroll
            for (int i = 0; i < 4; ++i) { const float a = v0[i], b = v1[i]; v0[i] = a / (1.f + __expf(-a)) * ov[i]; v1[i] = b / (1.f + __expf(-b)) * ov[4 + i]; }
          } else if (cs) {
            const f32x4 s0 = *(const f32x4*)(cs + c), s1 = *(const f32x4*)(cs + c + 4); v0 = v0 * s0; v1 = v1 * s1;
          }
          u32x4 w; w.x = cvtpk(v0[0], v0[1]); w.y = cvtpk(v0[2], v0[3]); w.z = cvtpk(v1[0], v1[1]); w.w = cvtpk(v1[2], v1[3]);
          *(u32x4*)(rowp + c) = w;
        }
      }
  }
};

__device__ __forceinline__ int src_col(int n, int mode) {
  if (mode == 1) { const int hc = n % 96; if (hc >= 64) { const int j = (hc - 64) & 15, g = j >> 3, i = j & 7; return n - j + ((i < 4) ? 4 * g + i : 8 + 4 * g + (i - 4)); } return n; }
  if (mode == 2) { if (n < 2048) { const int j = n & 63, g = j >> 3, i = j & 7; return n - j + ((i < 4) ? 4 * g + i : 32 + 4 * g + (i - 4)); } return n; }
  return n;
}
__device__ __forceinline__ void tr_item(const float* W, int K, int N, bf16_t* WT, int ldk, int mode, LAS float* scr, int item, int lane) {
  const int nblk = N / 32, kb = item / nblk, nb = item % nblk, k0 = 64 * kb, n0 = 32 * nb;
  const int sc = src_col(n0 + (lane & 31), mode);
#pragma unroll 8
  for (int i = 0; i < 32; ++i) { const int kk = 2 * i + (lane >> 5); scr[kk * 33 + (lane & 31)] = W[(size_t)(k0 + kk) * N + sc]; }
  asm volatile("s_waitcnt lgkmcnt(0)" ::: "memory");
  const int c = lane & 7;
#pragma unroll
  for (int j = 0; j < 4; ++j) { const int n = (lane >> 3) + 8 * j; const LAS float* s = scr + (8 * c) * 33 + n;
    u32x4 o; o.x = cvtpk(s[0 * 33], s[1 * 33]); o.y = cvtpk(s[2 * 33], s[3 * 33]); o.z = cvtpk(s[4 * 33], s[5 * 33]); o.w = cvtpk(s[6 * 33], s[7 * 33]);
    *(u32x4*)(WT + (size_t)(n0 + n) * ldk + k0 + 8 * c) = o; }
  asm volatile("s_waitcnt lgkmcnt(0)" ::: "memory");
}
__device__ __forceinline__ void conv_mat(const float* W, int K, int N, bf16_t* WT, int mode, LAS float* scr, int gw, int ngw, int lane, int ldk = 0) {
  const int items = (K / 64) * (N / 32);
  for (int it = gw; it < items; it += ngw) tr_item(W, K, N, WT, ldk ? ldk : K, mode, scr, it, lane);
}
__device__ __forceinline__ void conv_pool(const float* Wp, bf16_t* WT, LAS float* scr, int gw, int ngw, int lane) {
  for (int it = gw; it < 8 * 16; it += ngw) {
    const int kb = it / 16, nb = it % 16, k0 = 64 * kb, n0 = 32 * nb, gk = k0 >> 7, gn = n0 >> 7;
    if (gk == gn) {
      const float* W = Wp + (size_t)gk * 128 * 128;
#pragma unroll 8
      for (int i = 0; i < 32; ++i) { const int kk = 2 * i + (lane >> 5); scr[kk * 33 + (lane & 31)] = W[(size_t)(k0 - gk * 128 + kk) * 128 + (n0 - gn * 128) + (lane & 31)]; }
    } else {
#pragma unroll 8
      for (int i = 0; i < 32; ++i) { const int kk = 2 * i + (lane >> 5); scr[kk * 33 + (lane & 31)] = 0.f; }
    }
    asm volatile("s_waitcnt lgkmcnt(0)" ::: "memory");
    const int c = lane & 7;
#pragma unroll
    for (int j = 0; j < 4; ++j) { const int n = (lane >> 3) + 8 * j; const LAS float* s = scr + (8 * c) * 33 + n;
      u32x4 o; o.x = cvtpk(s[0 * 33], s[1 * 33]); o.y = cvtpk(s[2 * 33], s[3 * 33]); o.z = cvtpk(s[4 * 33], s[5 * 33]); o.w = cvtpk(s[6 * 33], s[7 * 33]);
      *(u32x4*)(WT + (size_t)(n0 + n) * 512 + k0 + 8 * c) = o; }
    asm volatile("s_waitcnt lgkmcnt(0)" ::: "memory");
  }
}
__device__ __forceinline__ void conv_layer(const Params& p, int L, LAS unsigned char* lds, int gw, int ngw, int wid, int lane) {
  LAS float* scr = (LAS float*)(lds + wid * 16384);
  unsigned char* ws = p.ws; const int i = L >> 1;
  conv_mat(p.w_ffn_in + (size_t)L * DM * DFF, DM, DFF, (bf16_t*)(ws + WS_WFF1), 0, scr, gw, ngw, lane);
  conv_mat(p.w_ffn_out + (size_t)L * DFF * DM, DFF, DM, (bf16_t*)(ws + WS_WFF2), 0, scr, gw, ngw, lane);
  if ((L & 1) == 0) {
    conv_mat(p.w_in_even + (size_t)i * DM * 928, DM, 928, (bf16_t*)(ws + WS_WA), 0, scr, gw, ngw, lane);
    conv_mat(p.w_uq + (size_t)i * 256 * 768, 256, 768, (bf16_t*)(ws + WS_WUQ), 1, scr, gw, ngw, lane);
    conv_mat(p.w_ukv + (size_t)i * 128 * 1024, 128, 1024, (bf16_t*)(ws + WS_WUKV), 0, scr, gw, ngw, lane, 256);
    for (int e = gw * 64 + lane; e < 1024 * 16; e += ngw * 64) { const int n = e >> 4, c = e & 15; *(u32x4*)((bf16_t*)(ws + WS_WUKV) + (size_t)n * 256 + 128 + c * 8) = (u32x4){0u, 0u, 0u, 0u}; }
    conv_pool(p.w_pool + (size_t)i * 4 * 128 * 128, (bf16_t*)(ws + WS_WPOOL), scr, gw, ngw, lane);
    conv_mat(p.w_out_even + (size_t)i * 1024 * 1024, 1024, 1024, (bf16_t*)(ws + WS_WB), 0, scr, gw, ngw, lane);
  } else {
    conv_mat(p.w_in_odd + (size_t)i * DM * 6144, DM, 6144, (bf16_t*)(ws + WS_WA), 2, scr, gw, ngw, lane);
    conv_mat(p.w_out_odd + (size_t)i * 2048 * 1024, 2048, 1024, (bf16_t*)(ws + WS_WB), 0, scr, gw, ngw, lane);
  }
}

__device__ __forceinline__ void p0_phase(const Params& p, LAS unsigned char* lds, const int tid, const int bid) {
  const int G = gridDim.x, lane = tid & 63, wid = tid >> 6;
  float* mod = (float*)(p.ws + WS_MOD);
  LAS float* sc = (LAS float*)lds;
  LAS float* part = (LAS float*)(lds + 9 * 1024 * 4);
  for (int e = tid; e < 9 * 1024; e += NTHR) { const int r = e >> 10, k = e & 1023; const float v = (r < 8) ? p.c[r * DM + k] : p.c_ctx[k]; sc[e] = v / (1.f + expf(-v)); }
  __syncthreads();
  for (int it = bid; it < 4 * 96; it += G) {
    const int L = it / 96, col0 = (it % 96) * 64;
    float a0 = 0, a1 = 0, a2 = 0, a3 = 0, a4 = 0, a5 = 0, a6 = 0, a7 = 0, a8 = 0;
    const float* wp = p.w_ada + ((size_t)L * DM + wid * 128) * 6144 + col0 + lane;
    const LAS float* s0 = sc + wid * 128;
#pragma unroll 16
    for (int k = 0; k < 128; ++k) { const float w = wp[(size_t)k * 6144];
      a0 += s0[k] * w; a1 += s0[1024 + k] * w; a2 += s0[2048 + k] * w; a3 += s0[3072 + k] * w; a4 += s0[4096 + k] * w; a5 += s0[5120 + k] * w; a6 += s0[6144 + k] * w; a7 += s0[7168 + k] * w; a8 += s0[8192 + k] * w; }
    LAS float* pp = part + wid * 9 * 64 + lane;
    pp[0] = a0; pp[64] = a1; pp[128] = a2; pp[192] = a3; pp[256] = a4; pp[320] = a5; pp[384] = a6; pp[448] = a7; pp[512] = a8;
    __syncthreads();
    for (int e = tid; e < 9 * 64; e += NTHR) { const int r = e >> 6, cl = e & 63; float v = p.b_ada[L * 6144 + col0 + cl];
#pragma unroll
      for (int w = 0; w < 8; ++w) v += part[w * 9 * 64 + e];
      mod[((size_t)L * 9 + r) * 6144 + col0 + cl] = v; }
    __syncthreads();
  }
  float* tab = (float*)(p.ws + WS_TAB);
  for (int e = bid * NTHR + tid; e < 1024 + 4096; e += G * NTHR) {
    if (e < 1024) { const int pos = e >> 3, i = e & 7; const float fr = powf(10000.f, -(float)(2 * i) / 16.f), a = (float)pos * fr; tab[e] = cosf(a); tab[1024 + e] = sinf(a); }
    else { const int q = e - 1024, pos = q >> 5, i = q & 31; const float fr = powf(10000.f, -(float)(2 * i) / 64.f), a = (float)pos * fr; tab[2048 + q] = cosf(a); tab[2048 + 4096 + q] = sinf(a); }
  }
}

__device__ __forceinline__ const float* xrow_ptr(const float* xl, const float* xc, int r) {
  const int b = r / SEGL, w = r % SEGL;
  return (w < CTXL) ? xc + (size_t)(b * CTXL + w) * DM : xl + (size_t)(b * SEQL + (w - CTXL)) * DM;
}
__device__ __forceinline__ void norm_phase(const Params& p, bool first, bool has_res, bool final_, const float* gpost, const float* gate_mod  ,
                                            const float* gpre, const float* shsc_mod  , int gw, int ngw, int lane, bool dry = false, const float* ysplit = nullptr) {
  const bf16_t* Y = (const bf16_t*)(p.ws + WS_Y); bf16_t* H = (bf16_t*)(p.ws + WS_H); float* XC = (float*)(p.ws + WS_XC);
  const float* xl = first ? p.x : p.out; const float* xc = first ? p.ctx : XC;
  const int rbeg = gw, rend = T, rstep = ngw;
  if (rbeg >= rend) return;
  int cur_m = -1;
  f32x4 cres[4], ca[4], csh[4];
#pragma unroll
  for (int j = 0; j < 4; ++j) { cres[j] = (f32x4){0.f, 0.f, 0.f, 0.f}; ca[j] = cres[j]; csh[j] = cres[j]; }
  f32x4 nx[4]; u32x2 ny[4];
  { const float* xs = xrow_ptr(xl, xc, rbeg);
#pragma unroll
    for (int j = 0; j < 4; ++j) { nx[j] = __builtin_nontemporal_load(((const f32x4*)xs) + lane + 64 * j); ny[j] = has_res ? __builtin_nontemporal_load(((const u32x2*)(Y + (size_t)rbeg * DM)) + lane + 64 * j) : (u32x2){0u, 0u}; } }
  for (int r = rbeg; r < rend; r += rstep) {
    const int b = r / SEGL, w = r % SEGL; const bool isctx = w < CTXL;
    float* xd = (isctx ? XC + (size_t)(b * CTXL + w) * DM : p.out + (size_t)(b * SEQL + (w - CTXL)) * DM);
    const int mrow = isctx ? 8 : b;
    f32x4 v[4]; u32x2 yq[4];
#pragma unroll
    for (int j = 0; j < 4; ++j) { v[j] = nx[j]; yq[j] = ny[j]; }
    if (r + rstep < rend) { const float* xs = xrow_ptr(xl, xc, r + rstep);
#pragma unroll
      for (int j = 0; j < 4; ++j) { nx[j] = __builtin_nontemporal_load(((const f32x4*)xs) + lane + 64 * j); if (has_res) ny[j] = __builtin_nontemporal_load(((const u32x2*)(Y + (size_t)(r + rstep) * DM)) + lane + 64 * j); } }
    if (final_ && isctx) continue;
    if (mrow != cur_m) { cur_m = mrow;
#pragma unroll
      for (int j = 0; j < 4; ++j) {
        if (has_res) cres[j] = ((const f32x4*)gpost)[lane + 64 * j] * ((const f32x4*)(gate_mod + (size_t)mrow * 6144))[lane + 64 * j];
        if (!final_) { ca[j] = ((const f32x4*)gpre)[lane + 64 * j] * (((const f32x4*)(shsc_mod + (size_t)mrow * 6144 + 1024))[lane + 64 * j] + 1.f); csh[j] = ((const f32x4*)(shsc_mod + (size_t)mrow * 6144))[lane + 64 * j]; } } }
    if (has_res) {
      f32x4 y[4]; float ss = 0.f;
#pragma unroll
      for (int j = 0; j < 4; ++j) y[j] = (f32x4){bflo(yq[j].x), bfhi(yq[j].x), bflo(yq[j].y), bfhi(yq[j].y)};
      if (ysplit && isctx) {
        const float* yp = ysplit + (size_t)(b * CTXL + w) * DM;
#pragma unroll
        for (int j = 0; j < 4; ++j) y[j] = ((const f32x4*)yp)[lane + 64 * j];
#pragma unroll 1
        for (int k = 1; k < 8; ++k) {
#pragma unroll
          for (int j = 0; j < 4; ++j) y[j] = y[j] + ((const f32x4*)(yp + (size_t)k * 2048 * DM))[lane + 64 * j]; }
      }
#pragma unroll
      for (int j = 0; j < 4; ++j) ss += (y[j].x * y[j].x + y[j].y * y[j].y) + (y[j].z * y[j].z + y[j].w * y[j].w);
      const float rs = rsqrtf(wave_sum(ss) * (1.f / DM) + EPS);
#pragma unroll
      for (int j = 0; j < 4; ++j) v[j] = v[j] + cres[j] * (y[j] * rs);
    }
    if ((has_res || first) && !dry) {
#pragma unroll
      for (int j = 0; j < 4; ++j) __builtin_nontemporal_store(v[j], ((f32x4*)xd) + lane + 64 * j);
    }
    if (!final_) {
      float ss = 0.f;
#pragma unroll
      for (int j = 0; j < 4; ++j) ss += (v[j].x * v[j].x + v[j].y * v[j].y) + (v[j].z * v[j].z + v[j].w * v[j].w);
      const float rs = rsqrtf(wave_sum(ss) * (1.f / DM) + EPS);
#pragma unroll
      for (int j = 0; j < 4; ++j) { const f32x4 h = (v[j] * rs) * ca[j] + csh[j];
        u32x2 o; o.x = cvtpk(h.x, h.y); o.y = cvtpk(h.z, h.w); __builtin_nontemporal_store(o, ((u32x2*)(H + (size_t)r * DM)) + lane + 64 * j); }
    }
  }
}

__device__ __forceinline__ void mid_phase(const Params& p, int i, int gw, int ngw, int lane) {
  const bf16_t* U = (const bf16_t*)(p.ws + WS_B0); bf16_t* UQN = (bf16_t*)(p.ws + WS_UQN); bf16_t* UKVN = (bf16_t*)(p.ws + WS_UKVN); bf16_t* KR = (bf16_t*)(p.ws + WS_KR); bf16_t* PD = (bf16_t*)(p.ws + WS_PD);
  const float* tab = (const float*)(p.ws + WS_TAB);
  const float* gq = p.g_q_lora + i * 256; const float* gkv = p.g_kv_lora + i * 128;
  for (int r = gw; r < T; r += ngw) {
    const int w = r % SEGL; const bool isctx = w < CTXL; const int t = isctx ? w : w - CTXL, Lseg = isctx ? CTXL : SEQL;
    const bf16_t* ur = U + (size_t)r * 1024;
    {
      const u32x2 q = ((const u32x2*)ur)[lane]; const float a0 = bflo(q.x), a1 = bfhi(q.x), a2 = bflo(q.y), a3 = bfhi(q.y);
      const float rs = rsqrtf(wave_sum(a0 * a0 + a1 * a1 + a2 * a2 + a3 * a3) * (1.f / 256.f) + EPS);
      const f32x4 g = ((const f32x4*)gq)[lane]; u32x2 o; o.x = cvtpk(a0 * rs * g.x, a1 * rs * g.y); o.y = cvtpk(a2 * rs * g.z, a3 * rs * g.w);
      ((u32x2*)(UQN + (size_t)r * 256))[lane] = o; }
    {
      const unsigned q = ((const unsigned*)(ur + 256))[lane]; const float a0 = bflo(q), a1 = bfhi(q);
      const float rs = rsqrtf(wave_sum(a0 * a0 + a1 * a1) * (1.f / 128.f) + EPS);
      ((unsigned*)(UKVN + (size_t)r * 128))[lane] = cvtpk(a0 * rs * gkv[2 * lane], a1 * rs * gkv[2 * lane + 1]); }
    {
      const int j = lane & 31; const float val = bflo((unsigned)ur[384 + j]); const float pv = __shfl_xor(val, 8);
      const int part = j >> 4, jj = j & 15, isx2 = jj >> 3, fi = jj & 7;
      float o = val;
      if (!isctx) { const int pos = part ? (t & 63) : (t >> 6); const float cs = tab[pos * 8 + fi], sn = tab[1024 + pos * 8 + fi]; o = isx2 ? (pv * sn + val * cs) : (val * cs - pv * sn); }
      const int dst = part * 16 + 8 * (fi >> 2) + (fi & 3) + 4 * isx2;
      if (lane < 32) KR[(size_t)r * 32 + dst] = f2bf(o); }
    {
      const int g = lane >> 4, wn = 2 << g; const int lo = max(t - (wn >> 1), 0), hi = min(t + wn - (wn >> 1), Lseg);
      float s[8] = {0, 0, 0, 0, 0, 0, 0, 0};
      const bf16_t* base = ur + 416 + lane * 8;
#pragma unroll
      for (int k = 0; k < 16; ++k) { const int q = t - 8 + k;
        if (q >= lo && q < hi) { const u32x4 d = *(const u32x4*)(base + (ptrdiff_t)(q - t) * 1024);
          s[0] += bflo(d.x); s[1] += bfhi(d.x); s[2] += bflo(d.y); s[3] += bfhi(d.y); s[4] += bflo(d.z); s[5] += bfhi(d.z); s[6] += bflo(d.w); s[7] += bfhi(d.w); } }
      const u32x4 own = *(const u32x4*)base; const float inv = 1.f / (float)(hi - lo);
      u32x4 o; o.x = cvtpk(s[0] * inv - bflo(own.x), s[1] * inv - bfhi(own.x)); o.y = cvtpk(s[2] * inv - bflo(own.y), s[3] * inv - bfhi(own.y));
      o.z = cvtpk(s[4] * inv - bflo(own.z), s[5] * inv - bfhi(own.z)); o.w = cvtpk(s[6] * inv - bflo(own.w), s[7] * inv - bfhi(own.w));
      *(u32x4*)(PD + (size_t)r * 512 + lane * 8) = o; }
  }
}

__device__ __forceinline__ void gn_phase(const Params& p, int gw, int ngw, int lane) {
  bf16_t* U = (bf16_t*)(p.ws + WS_B0);
  for (int r = gw; r < T; r += ngw) {
#pragma unroll
    for (int i = 0; i < 4; ++i) {
      bf16_t* ptr = U + (size_t)r * 4096 + 2048 + (i * 64 + lane) * 8;
      const u32x4 d = *(const u32x4*)ptr;
      float v[8] = {bflo(d.x), bfhi(d.x), bflo(d.y), bfhi(d.y), bflo(d.z), bfhi(d.z), bflo(d.w), bfhi(d.w)};
      float s = ((v[0] + v[1]) + (v[2] + v[3])) + ((v[4] + v[5]) + (v[6] + v[7]));
#pragma unroll
      for (int o = 1; o < 32; o <<= 1) s += __shfl_xor(s, o);
      const float mu = s * (1.f / 256.f); float q = 0.f;
#pragma unroll
      for (int e = 0; e < 8; ++e) { v[e] -= mu; q += v[e] * v[e]; }
#pragma unroll
      for (int o = 1; o < 32; o <<= 1) q += __shfl_xor(q, o);
      const float rs = rsqrtf(q * (1.f / 256.f) + EPS);
      u32x4 w; w.x = cvtpk(v[0] * rs, v[1] * rs); w.y = cvtpk(v[2] * rs, v[3] * rs); w.z = cvtpk(v[4] * rs, v[5] * rs); w.w = cvtpk(v[6] * rs, v[7] * rs);
      *(u32x4*)ptr = w;
    }
  }
}

#define XB_TMO      128
#define XB_XCNT(j)  (256  + 64 * (j))
#define XB_XSUB(j)  (1280 + 64 * (j))
#define XB_XGEN(j)  (2304 + 64 * (j))
#define XB_TOP      3328
#define XB_TOPGEN   3392
#define XCD_BAR_WORDS 3456
#define XB_SPIN_CAP (1u << 18)

__device__ __forceinline__ unsigned xb_ld(unsigned* p)              { return __hip_atomic_load(p, __ATOMIC_RELAXED, __HIP_MEMORY_SCOPE_AGENT); }
__device__ __forceinline__ unsigned xb_add(unsigned* p, unsigned v) { return __hip_atomic_fetch_add(p, v, __ATOMIC_RELAXED, __HIP_MEMORY_SCOPE_AGENT); }
__device__ __forceinline__ unsigned xb_xcc_id() { return (unsigned)__builtin_amdgcn_s_getreg((3 << 11) | 20) & 0xFu; }
#define XB_SPIN(cond, bar) do { unsigned _sp = 0; while (cond) { __builtin_amdgcn_s_sleep(1); \
    if ((++_sp & 255u) == 0u) { if (xb_ld(&(bar)[XB_TMO])) break; if (_sp > XB_SPIN_CAP) { atomicAdd(&(bar)[XB_TMO], 1u); break; } } } } while (0)

struct XcdBarrier {
    unsigned* bar; unsigned x;
    volatile LAS unsigned* st;
};

__device__ __forceinline__ XcdBarrier xcd_barrier_post(unsigned* bar, volatile LAS unsigned* st) {
    XcdBarrier b; b.bar = bar; b.x = xb_xcc_id(); b.st = st;
    if (threadIdx.x == 0) (void)xb_add(&bar[XB_XCNT(b.x)], 1u);
    return b;
}
__device__ __forceinline__ void xcd_barrier_complete(unsigned* bar, unsigned x, unsigned& nloc, unsigned& nx) {
    const unsigned G = gridDim.x * gridDim.y * gridDim.z;
    unsigned sum, cnt, mine, sp = 0u;
    for (;;) {
        sum = 0u; cnt = 0u; mine = 0u;
#pragma unroll
        for (unsigned j = 0; j < 16; ++j) { const unsigned c = xb_ld(&bar[XB_XCNT(j)]); sum += c; cnt += (c > 0u) ? 1u : 0u; mine = (j == x) ? c : mine; }
        if (sum == G) break;
        __builtin_amdgcn_s_sleep(1);
        if ((++sp & 255u) == 0u) { if (xb_ld(&bar[XB_TMO])) break; if (sp > XB_SPIN_CAP) { atomicAdd(&bar[XB_TMO], 1u); break; } }
    }
    nloc = mine > 0u ? mine : 1u; nx = cnt > 0u ? cnt : 1u;
}

__device__ __forceinline__ void xcd_barrier(const XcdBarrier& b) {
    asm volatile("s_waitcnt vmcnt(0)" ::: "memory");
    __syncthreads();
    if (threadIdx.x == 0) {
        unsigned* bar = b.bar;
        __builtin_amdgcn_s_waitcnt(0);
        unsigned nloc = b.st[0], nx = b.st[1];
        if (nloc == 0u) { xcd_barrier_complete(bar, b.x, nloc, nx); b.st[0] = nloc; b.st[1] = nx; }
        const unsigned old = xb_add(&bar[XB_XSUB(b.x)], 1u);
        const unsigned gen = old / nloc;
        if (old + 1u == (gen + 1u) * nloc) {
            __builtin_amdgcn_fence(__ATOMIC_RELEASE, "agent");
            asm volatile("s_waitcnt vmcnt(0)" ::: "memory");
            const unsigned og = xb_add(&bar[XB_TOP], 1u);
            const unsigned tg = og / nx;
            if (og + 1u == (tg + 1u) * nx) xb_add(&bar[XB_TOPGEN], 1u);
            else XB_SPIN(xb_ld(&bar[XB_TOPGEN]) == tg, bar);
            __builtin_amdgcn_fence(__ATOMIC_ACQUIRE, "agent");
            xb_add(&bar[XB_XGEN(b.x)], 1u);
            asm volatile("s_waitcnt vmcnt(0)" ::: "memory");
        } else {
            XB_SPIN(xb_ld(&bar[XB_XGEN(b.x)]) == gen, bar);
            __builtin_amdgcn_fence(__ATOMIC_ACQUIRE, "agent");
            asm volatile("s_waitcnt vmcnt(0)" ::: "memory");
        }
    }
    __syncthreads();
}

typedef short v4i16_t __attribute__((ext_vector_type(4)));
__device__ __forceinline__ u32x2 tr_rd(const LAS bf16_t* p) { return __builtin_bit_cast(u32x2, __builtin_amdgcn_ds_read_tr16_b64_v4i16((LAS v4i16_t*)p)); }
constexpr int AT_KSTR = 104, AT_VSTR = 72, AT_BUF = 64 * AT_KSTR * 2 + 64 * AT_VSTR * 2;
__device__ __forceinline__ void attn_stage(LAS unsigned char* buf, int tid, u32x4 rk, u32x4 rv, u32x4 rr) {
  LAS bf16_t* Ks = (LAS bf16_t*)buf; LAS bf16_t* Vs = (LAS bf16_t*)(buf + 64 * AT_KSTR * 2);
  const int skey = tid >> 3, sch = tid & 7;
  *(LAS u32x4*)(Ks + skey * AT_KSTR + sch * 8) = rk;
  if (tid < 256) { const int rkey = tid >> 2, rch = tid & 3; *(LAS u32x4*)(Ks + rkey * AT_KSTR + 64 + rch * 8) = rr; }
  *(LAS u32x4*)(Vs + skey * AT_VSTR + sch * 8) = rv;
}
__device__ __forceinline__ void attn_unit(LAS unsigned char* lds, const bf16_t* Q, const bf16_t* KV, const bf16_t* KR, bf16_t* MIX, size_t qrow0, size_t krow0, int ntiles, int h, const int tid) {
  const int lane = tid & 63, wid = tid >> 6, c16 = lane & 15, quad = lane >> 4, tq = (lane & 15) >> 2, tp = lane & 3;
  const bf16_t* gk = KV + (krow0 + (tid >> 3)) * 1024 + h * 128 + (tid & 7) * 8;
  const bf16_t* gr = KR + (krow0 + ((tid & 255) >> 2)) * 32 + (tid & 3) * 8;
  bf16x8 qf[2][3];
#pragma unroll
  for (int qb = 0; qb < 2; ++qb)
#pragma unroll
    for (int ks = 0; ks < 3; ++ks) qf[qb][ks] = *(const bf16x8*)(Q + (qrow0 + wid * 32 + qb * 16 + c16) * 768 + h * 96 + ks * 32 + quad * 8);
  f32x4 o[2][4];
#pragma unroll
  for (int qb = 0; qb < 2; ++qb)
#pragma unroll
    for (int eb = 0; eb < 4; ++eb) o[qb][eb] = (f32x4){0.f, 0.f, 0.f, 0.f};
  float mref[2] = {0.f, 0.f}; f32x4 lacc[2] = {(f32x4){0.f, 0.f, 0.f, 0.f}, (f32x4){0.f, 0.f, 0.f, 0.f}};
  const bf16x8 ones = (bf16x8){0x3F80, 0x3F80, 0x3F80, 0x3F80, 0x3F80, 0x3F80, 0x3F80, 0x3F80};
  u32x4 rk = *(const u32x4*)gk, rv = *(const u32x4*)(gk + 64), rr = (u32x4){0, 0, 0, 0};
  if (tid < 256) rr = *(const u32x4*)gr;
  __syncthreads();
  attn_stage(lds, tid, rk, rv, rr);
  __syncthreads();
  for (int t = 0; t < ntiles; ++t) {
    LAS unsigned char* buf = lds + (t & 1) * AT_BUF;
    const bool more = (t + 1 < ntiles);
    if (more) { const bf16_t* g2 = gk + (size_t)(t + 1) * 64 * 1024; rk = *(const u32x4*)g2; rv = *(const u32x4*)(g2 + 64); if (tid < 256) rr = *(const u32x4*)(gr + (size_t)(t + 1) * 64 * 32); }
    const LAS bf16_t* Ks = (const LAS bf16_t*)buf; const LAS bf16_t* Vs = (const LAS bf16_t*)(buf + 64 * AT_KSTR * 2);
    f32x4 s[4][2];
#pragma unroll
    for (int kb = 0; kb < 4; ++kb) {
      bf16x8 kf[3];
#pragma unroll
      for (int ks = 0; ks < 3; ++ks) kf[ks] = *(const LAS bf16x8*)(Ks + (kb * 16 + c16) * AT_KSTR + ks * 32 + quad * 8);
#pragma unroll
      for (int qb = 0; qb < 2; ++qb) { const float nm = -mref[qb]; f32x4 a = (f32x4){nm, nm, nm, nm};
#pragma unroll
        for (int ks = 0; ks < 3; ++ks) a = mfma16(kf[ks], qf[qb][ks], a);
        s[kb][qb] = a; }
    }
#pragma unroll
    for (int qb = 0; qb < 2; ++qb) {
      float mx = -1e30f;
#pragma unroll
      for (int kb = 0; kb < 4; ++kb) mx = fmaxf(fmaxf(fmaxf(s[kb][qb][0], s[kb][qb][1]), fmaxf(s[kb][qb][2], s[kb][qb][3])), mx);
      mx = fmaxf(mx, __shfl_xor(mx, 16)); mx = fmaxf(mx, __shfl_xor(mx, 32));
      if (t == 0 || __any(mx > 8.f)) {
        const float delta = (t == 0) ? mx : fmaxf(mx, 0.f), alpha = (t == 0) ? 1.f : __builtin_amdgcn_exp2f(-delta);
        mref[qb] += delta; lacc[qb] = lacc[qb] * alpha;
#pragma unroll
        for (int kb = 0; kb < 4; ++kb) s[kb][qb] = s[kb][qb] - delta;
#pragma unroll
        for (int eb = 0; eb < 4; ++eb) o[qb][eb] = o[qb][eb] * alpha;
      }
#pragma unroll
      for (int kb = 0; kb < 4; ++kb)
#pragma unroll
        for (int r = 0; r < 4; ++r) s[kb][qb][r] = __builtin_amdgcn_exp2f(s[kb][qb][r]);
    }
#pragma unroll
    for (int s2 = 0; s2 < 2; ++s2) {
      bf16x8 pf[2];
#pragma unroll
      for (int qb = 0; qb < 2; ++qb) { u32x4 w; w.x = cvtpk(s[2 * s2][qb][0], s[2 * s2][qb][1]); w.y = cvtpk(s[2 * s2][qb][2], s[2 * s2][qb][3]);
        w.z = cvtpk(s[2 * s2 + 1][qb][0], s[2 * s2 + 1][qb][1]); w.w = cvtpk(s[2 * s2 + 1][qb][2], s[2 * s2 + 1][qb][3]); pf[qb] = __builtin_bit_cast(bf16x8, w);
        lacc[qb] = mfma16(ones, pf[qb], lacc[qb]); }
      const LAS bf16_t* vb = Vs + (32 * s2 + 4 * quad + tq) * AT_VSTR + 4 * tp;
#pragma unroll
      for (int eb = 0; eb < 4; ++eb) {
        const u32x2 lo = tr_rd(vb + 16 * eb), hi = tr_rd(vb + 16 * AT_VSTR + 16 * eb);
        const u32x4 vv = (u32x4){lo.x, lo.y, hi.x, hi.y}; const bf16x8 vf = __builtin_bit_cast(bf16x8, vv);
#pragma unroll
        for (int qb = 0; qb < 2; ++qb) o[qb][eb] = mfma16(vf, pf[qb], o[qb][eb]);
      }
    }
    if (more) attn_stage(lds + ((t + 1) & 1) * AT_BUF, tid, rk, rv, rr);
    __syncthreads();
  }
#pragma unroll
  for (int qb = 0; qb < 2; ++qb) {
    const float inv = 1.f / lacc[qb][0];
    bf16_t* op = MIX + (qrow0 + wid * 32 + qb * 16 + c16) * 1024 + h * 64 + quad * 4;
#pragma unroll
    for (int eb = 0; eb < 4; ++eb) { u32x2 w; w.x = cvtpk(o[qb][eb][0] * inv, o[qb][eb][1] * inv); w.y = cvtpk(o[qb][eb][2] * inv, o[qb][eb][3] * inv); *(u32x2*)(op + eb * 16) = w; }
  }
}
__device__ __forceinline__ void attn_phase(const Params& p, LAS unsigned char* lds, const int tid, const int bid) {
  const bf16_t* Q = (const bf16_t*)(p.ws + WS_Q); const bf16_t* KV = (const bf16_t*)(p.ws + WS_KV); const bf16_t* KR = (const bf16_t*)(p.ws + WS_KR); bf16_t* MIX = (bf16_t*)(p.ws + WS_B0);
  const int G = gridDim.x;
  for (int u = bid; u < 2048; u += G) {
    const int b = u & 7, rest = u >> 3, qb = rest & 31, h = rest >> 5;
    attn_unit(lds, Q, KV, KR, MIX, (size_t)b * SEGL + CTXL + (size_t)qb * 256, (size_t)b * SEGL, SEGL / 64, h, tid);
  }
  for (int u = bid; u < 64; u += G) {
    const int b = u & 7, h = u >> 3;
    attn_unit(lds, Q, KV, KR, MIX, (size_t)b * SEGL, (size_t)b * SEGL, CTXL / 64, h, tid);
  }
}

constexpr int RT_STR = 136, RT_VSTR = 72;
constexpr int RT_QS = 0, RT_KS = 128 * RT_STR * 2, RT_VS = 2 * RT_KS, RT_ST = RT_VS + 128 * RT_VSTR * 2;
__device__ __forceinline__ u32x4 scale8(u32x4 v, float f) {
  u32x4 o; o.x = cvtpk(bflo(v.x) * f, bfhi(v.x) * f); o.y = cvtpk(bflo(v.y) * f, bfhi(v.y) * f); o.z = cvtpk(bflo(v.z) * f, bfhi(v.z) * f); o.w = cvtpk(bflo(v.w) * f, bfhi(v.w) * f); return o;
}
__device__ __forceinline__ void ret_unit(LAS unsigned char* lds, bf16_t* U, bf16_t* OF, int b, int h, int sl, const int tid, const bool dry) {
  const int lane = tid & 63, wid = tid >> 6, c16 = lane & 15, quad = lane >> 4, tq = (lane & 15) >> 2, tp = lane & 3;
  LAS bf16_t* Qs = (LAS bf16_t*)(lds + RT_QS); LAS bf16_t* Ks = (LAS bf16_t*)(lds + RT_KS); LAS bf16_t* Vs = (LAS bf16_t*)(lds + RT_VS); LAS bf16_t* St = (LAS bf16_t*)(lds + RT_ST);
  const size_t rowb = (size_t)b * SEGL;
  const int n = 16 * wid + c16;
  for (int dir = 0; dir < 2; ++dir) {
    const int hh = dir ? (7 - h) : h;
    const float lg = log2f(1.0f - exp2f(-5.0f - (float)hh));
    const float gC = exp2f(lg * 128.f), g1 = exp2f(lg), g127 = exp2f(lg * 127.f);
    const float dq = dir ? exp2f(lg * (float)(128 - n)) : exp2f(lg * (float)(n + 1));
    const float cn = dir ? exp2f(-lg * (float)n) : exp2f(lg * (float)n);
    float kf4[4];
#pragma unroll
    for (int i = 0; i < 4; ++i) { const int row = (tid + 512 * i) >> 4; kf4[i] = dir ? exp2f(lg * (float)row) : exp2f(-lg * (float)row); }
    f32x4 st[4];
#pragma unroll
    for (int eb = 0; eb < 4; ++eb) st[eb] = (f32x4){0.f, 0.f, 0.f, 0.f};
    u32x4 rq[4], rk[4], rv[2];
    { const int c0 = dir ? 1 : 0; const size_t row0 = rowb + (size_t)c0 * 128;
#pragma unroll
      for (int i = 0; i < 4; ++i) { const int idx = tid + 512 * i, row = idx >> 4, ch = idx & 15; const bf16_t* src = U + (row0 + row) * 4096 + h * 128 + ch * 8; rq[i] = *(const u32x4*)src; rk[i] = *(const u32x4*)(src + 1024); }
#pragma unroll
      for (int i = 0; i < 2; ++i) { const int idx = tid + 512 * i, row = idx >> 3, ch = idx & 7; rv[i] = *(const u32x4*)(U + (row0 + row) * 4096 + 2048 + h * 256 + sl * 64 + ch * 8); } }
    for (int step = 0; step < 66; ++step) {
      const int c = dir ? ((step < 2) ? (1 - step) : (67 - step)) : step;
      const size_t grow = rowb + (size_t)c * 128 + n;
      __syncthreads();
#pragma unroll
      for (int i = 0; i < 4; ++i) { const int idx = tid + 512 * i, row = idx >> 4, ch = idx & 15;
        *(LAS u32x4*)(Qs + row * RT_STR + ch * 8) = rq[i]; *(LAS u32x4*)(Ks + row * RT_STR + ch * 8) = scale8(rk[i], kf4[i]); }
#pragma unroll
      for (int i = 0; i < 2; ++i) { const int idx = tid + 512 * i, row = idx >> 3, ch = idx & 7; *(LAS u32x4*)(Vs + row * RT_VSTR + ch * 8) = rv[i]; }
#pragma unroll
      for (int eb = 0; eb < 4; ++eb)
#pragma unroll
        for (int r = 0; r < 4; ++r) St[(16 * eb + 4 * quad + r) * RT_STR + 16 * wid + c16] = f2bf(st[eb][r]);
      __syncthreads();
      if (step + 1 < 66) { const int s1 = step + 1; const int c1 = dir ? ((s1 < 2) ? (1 - s1) : (67 - s1)) : s1; const size_t r1 = rowb + (size_t)c1 * 128;
#pragma unroll
        for (int i = 0; i < 4; ++i) { const int idx = tid + 512 * i, row = idx >> 4, ch = idx & 15; const bf16_t* src = U + (r1 + row) * 4096 + h * 128 + ch * 8; rq[i] = *(const u32x4*)src; rk[i] = *(const u32x4*)(src + 1024); }
#pragma unroll
        for (int i = 0; i < 2; ++i) { const int idx = tid + 512 * i, row = idx >> 3, ch = idx & 7; rv[i] = *(const u32x4*)(U + (r1 + row) * 4096 + 2048 + h * 256 + sl * 64 + ch * 8); } }
      u32x2 fo[4];
      if (dir) { const bf16_t* ip = OF + grow * 2048 + h * 256 + sl * 64 + quad * 4;
#pragma unroll
        for (int eb = 0; eb < 4; ++eb) fo[eb] = *(const u32x2*)(ip + eb * 16); }
      bf16x8 qf[4];
#pragma unroll
      for (int ks = 0; ks < 4; ++ks) qf[ks] = *(const LAS bf16x8*)(Qs + n * RT_STR + ks * 32 + quad * 8);
      f32x4 o[4];
#pragma unroll
      for (int eb = 0; eb < 4; ++eb) { f32x4 a = (f32x4){0.f, 0.f, 0.f, 0.f};
#pragma unroll
        for (int ks = 0; ks < 4; ++ks) { const bf16x8 af = *(const LAS bf16x8*)(St + (16 * eb + c16) * RT_STR + ks * 32 + quad * 8); a = mfma16(af, qf[ks], a); }
        o[eb] = a * dq; }
      const float pre = dir ? gC : g1, post = dir ? 1.f : g127;
#pragma unroll
      for (int eb = 0; eb < 4; ++eb) st[eb] = st[eb] * pre;
#pragma unroll 4
      for (int s2 = 0; s2 < 4; ++s2) {
        const LAS bf16_t* vb = Vs + (32 * s2 + 4 * quad + tq) * RT_VSTR + 4 * tp;
        bf16x8 vf[4];
#pragma unroll
        for (int eb = 0; eb < 4; ++eb) { const u32x2 lo = tr_rd(vb + 16 * eb), hi = tr_rd(vb + 16 * RT_VSTR + 16 * eb); const u32x4 vv = (u32x4){lo.x, lo.y, hi.x, hi.y}; vf[eb] = __builtin_bit_cast(bf16x8, vv); }
        const bool needed = dir ? (2 * s2 + 1 >= wid) : (2 * s2 <= wid);
        if (needed) {
          float pw[8];
#pragma unroll
          for (int hf = 0; hf < 2; ++hf) { const int mb = 2 * s2 + hf; f32x4 a = (f32x4){0.f, 0.f, 0.f, 0.f};
#pragma unroll
            for (int ks = 0; ks < 4; ++ks) { const bf16x8 kf = *(const LAS bf16x8*)(Ks + (16 * mb + c16) * RT_STR + ks * 32 + quad * 8); a = mfma16(kf, qf[ks], a); }
#pragma unroll
            for (int r = 0; r < 4; ++r) { const int m = 16 * mb + 4 * quad + r; const bool keep = dir ? (m > n) : (n >= m); pw[4 * hf + r] = keep ? a[r] * cn : 0.f; } }
          u32x4 w; w.x = cvtpk(pw[0], pw[1]); w.y = cvtpk(pw[2], pw[3]); w.z = cvtpk(pw[4], pw[5]); w.w = cvtpk(pw[6], pw[7]);
          const bf16x8 pf = __builtin_bit_cast(bf16x8, w);
#pragma unroll
          for (int eb = 0; eb < 4; ++eb) o[eb] = mfma16(vf[eb], pf, o[eb]);
        }
        const LAS bf16_t* kb = Ks + (32 * s2 + 4 * quad + tq) * RT_STR + 16 * wid + 4 * tp;
        const u32x2 klo = tr_rd(kb), khi = tr_rd(kb + 16 * RT_STR);
        const u32x4 kk = (u32x4){klo.x, klo.y, khi.x, khi.y}; const bf16x8 bk = __builtin_bit_cast(bf16x8, kk);
#pragma unroll
        for (int eb = 0; eb < 4; ++eb) st[eb] = mfma16(vf[eb], bk, st[eb]);
      }
#pragma unroll
      for (int eb = 0; eb < 4; ++eb) st[eb] = st[eb] * post;
      if (dir == 0) { bf16_t* op = OF + grow * 2048 + h * 256 + sl * 64 + quad * 4;
#pragma unroll
        for (int eb = 0; eb < 4; ++eb) { u32x2 w; w.x = cvtpk(o[eb][0], o[eb][1]); w.y = cvtpk(o[eb][2], o[eb][3]); *(u32x2*)(op + eb * 16) = w; } }
      else { bf16_t* op = U + grow * 4096 + 2048 + h * 256 + sl * 64 + quad * 4;
#pragma unroll
        for (int eb = 0; eb < 4; ++eb) { u32x2 w; w.x = cvtpk(o[eb][0] + bflo(fo[eb].x), o[eb][1] + bfhi(fo[eb].x)); w.y = cvtpk(o[eb][2] + bflo(fo[eb].y), o[eb][3] + bfhi(fo[eb].y)); *(u32x2*)(op + eb * 16) = w; } }
    }
  }
}
__device__ __forceinline__ void ret_phase(const Params& p, LAS unsigned char* lds, const int tid, const int bid, const bool dry) {
  bf16_t* U = (bf16_t*)(p.ws + WS_B0); bf16_t* OF = (bf16_t*)(p.ws + WS_Y);
  for (int u = bid; u < 256; u += gridDim.x) { const int b = u & 7, rest = u >> 3, sl = rest & 3, h = rest >> 2; ret_unit(lds, U, OF, b, h, sl, tid, dry); }
}

#ifndef PHASE_MAP
#define PHASE_MAP(it) (it)
#define N_ITERS 38
#endif
#define RUN_GEMM(MODE, APTR, LDA_, BTPTR, N_, K_, OPTR, LDC_, COFF_, CS_, TAB_, SCALE_) do { const int skipc_ = ((L == 3 && s >= 4) || s == 8) ? 1 : 0; \
    pg8::Gemm g; g.A = (APTR); g.Bt = (BTPTR); g.M = T; g.N = (N_); g.K = (K_); g.lda = (LDA_); \
    Epi<MODE, LDC_, COFF_> E; E.O = (OPTR); E.cs = (CS_); E.tab = (TAB_); E.scale = (SCALE_); \
    pg8::StaticOrder S; S.init(T, (N_), G, (bid + G - rot_) % G, skipc_); \
    int tg_ = tid; asm volatile("" : "+v"(tg_)); \
    pg8::gemm_phase<Epi<MODE, LDC_, COFF_>, pg8::StaticOrder, true, true, K_, LDA_>(lds, g, S, E, tg_); \
    __syncthreads(); } while (0)
#define RUN_SPLIT(APTR, LDA_, BTPTR, LDB_, N_, KP_, NP_, OPTR) do { \
    pg8::Gemm g; g.A = (APTR); g.Bt = (BTPTR); g.M = T; g.N = (N_); g.K = (KP_); g.lda = (LDA_); \
    Epi<5, 1024, 0> E; E.O = (bf16_t*)(OPTR); E.cs = nullptr; E.tab = nullptr; E.scale = 1.f; \
    pg8::CtxSplitOrder S; S.init((N_), (NP_), G, bid); \
    int tg_ = tid; asm volatile("" : "+v"(tg_)); \
    pg8::gemm_phase<Epi<5, 1024, 0>, pg8::CtxSplitOrder, true, true, KP_, LDA_, LDB_>(lds, g, S, E, tg_); \
    __syncthreads(); } while (0)
__global__ void __launch_bounds__(NTHR, 2) mega(Params p_unused) {
  extern __shared__ __attribute__((aligned(16))) unsigned char lds_raw[];
  LAS unsigned char* lds = (LAS unsigned char*)lds_raw;
  const Params& p = *(const Params*)__builtin_amdgcn_kernarg_segment_ptr();
  const int G = gridDim.x;
  volatile LAS unsigned* bst = (volatile LAS unsigned*)(lds + LDS_BAR_OFF);
  if (threadIdx.x < 2) bst[threadIdx.x] = 0u;
  __syncthreads();
  const XcdBarrier bar = xcd_barrier_post((unsigned*)(p.ws + WS_BAR), bst);
  for (int it = p.lo; it < p.hi; ++it) {
    const int phc = PHASE_MAP(it); const int ph = phc & 63; const bool dry = (phc >> 6) != 0;
    if (it > p.lo + 1) { xcd_barrier(bar); }
    else if (it > p.lo) {
      asm volatile("s_waitcnt vmcnt(0) lgkmcnt(0)" ::: "memory");
      __syncthreads();
      if (threadIdx.x < 64) { __builtin_amdgcn_fence(__ATOMIC_RELEASE, "agent"); asm volatile("s_waitcnt vmcnt(0)" ::: "memory"); }
      cg::this_grid().sync();
      if (threadIdx.x < 64) { __builtin_amdgcn_fence(__ATOMIC_ACQUIRE, "agent"); asm volatile("s_waitcnt vmcnt(0)" ::: "memory"); }
      __syncthreads();
    }
    int tid = threadIdx.x; asm volatile("" : "+v"(tid));
    int bid = blockIdx.x; asm volatile("" : "+s"(bid));
    const int lane = tid & 63, wid = __builtin_amdgcn_readfirstlane(tid >> 6);
    const int gw = bid * NWAVE + wid, ngw = G * NWAVE;
    unsigned char* ws = p.ws;
    const float* mod = (const float*)(ws + WS_MOD);
    const float* tab = (const float*)(ws + WS_TAB);
    bf16_t* H = (bf16_t*)(ws + WS_H); bf16_t* B0 = (bf16_t*)(ws + WS_B0); bf16_t* Y = (bf16_t*)(ws + WS_Y);
    if (ph == 0) { p0_phase(p, lds, tid, bid); continue; }
    if (ph == 37) { norm_phase(p, false, true, true, p.g_ffn_post + 3 * DM, mod + (size_t)3 * 9 * 6144 + 5 * 1024, nullptr, nullptr, gw, ngw, lane); continue; }
    const int L = (ph - 1) / 9, s = (ph - 1) % 9, odd = L & 1, li = L >> 1;
    const float* modL = mod + (size_t)L * 9 * 6144;
    int rot_ = 0;
    if (s == 0) {
      conv_layer(p, L, lds, gw, ngw, wid, lane);
      norm_phase(p, L == 0, L > 0, false, p.g_ffn_post + (L > 0 ? (L - 1) : 0) * DM, mod + (size_t)(L > 0 ? (L - 1) : 0) * 9 * 6144 + 5 * 1024, p.g_mix_pre + L * DM, modL, gw, ngw, lane, false, (L > 0) ? (const float*)(ws + WS_YP) : nullptr);
      __syncthreads();
    }
    else if (s == 6) { norm_phase(p, false, true, false, p.g_mix_post + L * DM, modL + 2 * 1024, p.g_ffn_pre + L * DM, modL + 3 * 1024, gw, ngw, lane, dry); }
    else if (s == 7) { RUN_GEMM(1, H, 1024, (const bf16_t*)(ws + WS_WFF1), 4096, 1024, B0, 4096, 0, nullptr, tab, 1.f); }
    else if (s == 8) {
      RUN_GEMM(0, B0, 4096, (const bf16_t*)(ws + WS_WFF2), 1024, 4096, Y, 1024, 0, nullptr, tab, 1.f);
      if (L < 3) RUN_SPLIT(B0, 4096, (const bf16_t*)(ws + WS_WFF2), 4096, 1024, 512, 8, ws + WS_YP);
    }
    else if (!odd) {
      if (s == 1) { RUN_GEMM(0, H, 1024, (const bf16_t*)(ws + WS_WA), 1024, 1024, B0, 1024, 0, nullptr, tab, 1.f); }
      else if (s == 2) { mid_phase(p, li, gw, ngw, lane); }
      else if (s == 3) {
        RUN_GEMM(2, (const bf16_t*)(ws + WS_UQN), 256, (const bf16_t*)(ws + WS_WUQ), 768, 256, (bf16_t*)(ws + WS_Q), 768, 0, nullptr, tab, 0.10206207261596577f * 1.4426950408889634f);
        rot_ = 24;
        RUN_GEMM(0, (const bf16_t*)(ws + WS_UKVN), 128, (const bf16_t*)(ws + WS_WUKV), 1024, 256, (bf16_t*)(ws + WS_KV), 1024, 0, nullptr, tab, 1.f);
        rot_ = 56;
        RUN_GEMM(0, (const bf16_t*)(ws + WS_PD), 512, (const bf16_t*)(ws + WS_WPOOL), 512, 512, B0, 1024, 512, p.pool_scale + li * 512, tab, 1.f);
      }
      else if (s == 4) { attn_phase(p, lds, tid, bid); }
      else { RUN_GEMM(0, B0, 1024, (const bf16_t*)(ws + WS_WB), 1024, 1024, Y, 1024, 0, nullptr, tab, 1.f); }
    } else {
      if (s == 1) { RUN_GEMM(3, H, 1024, (const bf16_t*)(ws + WS_WA), 4096, 1024, B0, 4096, 0, nullptr, tab + 2048, 0.08838834764831845f); }
      else if (s == 2) { ret_phase(p, lds, tid, bid, dry); }
      else if (s == 3) { gn_phase(p, gw, ngw, lane); }
      else if (s == 4) { RUN_GEMM(4, H, 1024, (const bf16_t*)(ws + WS_WA) + (size_t)4096 * 1024, 2048, 1024, B0, 4096, 2048, nullptr, tab, 1.f); }
      else { RUN_GEMM(0, B0 + 2048, 4096, (const bf16_t*)(ws + WS_WB), 1024, 2048, Y, 1024, 0, nullptr, tab, 1.f); }
    }
  }
}

extern "C" void kernel_launch(void* const* d_in, const int* in_sizes, int n_in, void* d_out, int out_size, void* d_ws, size_t ws_size, hipStream_t stream) {
  static int grid = 0;
  if (grid == 0) {
    if (n_in != 22 || ws_size < WS_END) { fprintf(stderr, "kernel_launch: unexpected n_in %d or workspace %zu < %zu\n", n_in, ws_size, (size_t)WS_END); grid = -1; return; }
    int dev = 0, cus = 0, per_cu = 0;
    hipGetDevice(&dev); hipDeviceGetAttribute(&cus, hipDeviceAttributeMultiprocessorCount, dev);
    if (hipFuncSetAttribute((const void*)mega, hipFuncAttributeMaxDynamicSharedMemorySize, LDS_BYTES) != hipSuccess) { fprintf(stderr, "kernel_launch: hipFuncSetAttribute failed\n"); }
    if (hipOccupancyMaxActiveBlocksPerMultiprocessor(&per_cu, (const void*)mega, NTHR, LDS_BYTES) != hipSuccess || per_cu < 1) { fprintf(stderr, "kernel_launch: occupancy query gave %d\n", per_cu); per_cu = 1; }
    (void)hipGetLastError();
    grid = cus * 1;
  }
  if (grid < 0) return;
  if (hipMemsetAsync((char*)d_ws + WS_BAR, 0, XCD_BAR_WORDS * 4, stream) != hipSuccess) fprintf(stderr, "kernel_launch: memset of the barrier words failed\n");
  Params p{};
  const float** pp = (const float**)&p;
  for (int i = 0; i < 22; ++i) pp[i] = (const float*)d_in[i];
  p.out = (float*)d_out; p.ws = (unsigned char*)d_ws;
#ifndef N_SPLIT
  p.lo = 0; p.hi = N_ITERS;
  void* args[] = {&p};
  hipError_t e = hipLaunchCooperativeKernel((const void*)mega, dim3(grid), dim3(NTHR), args, LDS_BYTES, stream);
  if (e != hipSuccess) fprintf(stderr, "cooperative launch failed: %s (grid %d)\n", hipGetErrorString(e), grid);
#else
  for (int ph = 0; ph < 38; ++ph) { p.lo = ph; p.hi = ph + 1; hipLaunchKernelGGL(mega, dim3(grid), dim3(NTHR), LDS_BYTES, stream, p); }
#endif
}
```

```cpp
#include <hip/hip_runtime.h>
#include <hip/hip_cooperative_groups.h>
#include <cstdio>
#include <cstdint>
namespace cg = cooperative_groups;
namespace pg8 {
#define PG8_LAS __attribute__((address_space(3)))
typedef unsigned short bf16_t;
typedef short bf16x8 __attribute__((ext_vector_type(8)));
typedef float f32x4 __attribute__((ext_vector_type(4)));
typedef unsigned u32x4 __attribute__((ext_vector_type(4)));
constexpr int BM = 256, BK = 64, HALF = 128, HTB = HALF * BK * 2  , STAGE_BYTES = 8 * HTB, NXCD = 8, WGM = 8;

__host__ __device__ __forceinline__ int lds_byte(int r, int c) { const int st = (r >> 4) * 2 + (c >> 5), rr = r & 15, cc = c & 31, ob = rr * 64 + cc * 2; return st * 1024 + (ob ^ (((ob >> 9) & 1) << 5)); }
__host__ __device__ __forceinline__ void stage_rc(int b, int& R, int& C) { const int st = b / 1024, sb = b % 1024, swz = sb ^ (((sb >> 9) & 1) << 5); R = (st >> 1) * 16 + swz / 64; C = (st & 1) * 32 + (swz % 64) / 2; }
__host__ __device__ __forceinline__ int perm32(int rho) { const int n = rho >> 4, i = rho & 15; return 8 * (i >> 2) + 4 * n + (i & 3); }

struct Unit { int pm, pn, kp; };
struct Gemm { const bf16_t* A; const bf16_t* Bt; int M, N, K, lda; };

struct StaticOrder {
    int nM, nN, nwg, G, c, skip;
    __host__ __device__ void init(int M, int N, int G_, int c_, int skip_ = 0) { skip = skip_; nM = skip_ ? (M / BM / 33) * 32 : M / BM; nN = N / BM; nwg = nM * nN; G = G_; c = c_; }
    __host__ __device__ bool next(int i, Unit& u) const {
        const long L = (long)i * G + c; if (L >= nwg) return false;
        int wgid = (int)L; { const int q = nwg / NXCD, r = nwg % NXCD, xcd = wgid % NXCD, off = wgid / NXCD; wgid = (xcd < r ? xcd * (q + 1) : r * (q + 1) + (xcd - r) * q) + off; }
        const int nig = WGM * nN, gid = wgid / nig, fm = gid * WGM, gsz = (nM - fm) < WGM ? (nM - fm) : WGM;
        u.kp = 0; u.pm = fm + ((wgid % nig) % gsz); u.pn = (wgid % nig) / gsz; if (skip) u.pm = (u.pm >> 5) * 33 + 1 + (u.pm & 31); return true;
    }
    __device__ __forceinline__ void a_ready(const Unit&) const {}
    __device__ __forceinline__ void done(const Unit&) const {}
};

struct CtxSplitOrder {
    int nN, NP, G, c;
    __host__ __device__ void init(int N, int NP_, int G_, int c_) { nN = N / BM; NP = NP_; G = G_; c = c_; }
    __host__ __device__ bool next(int i, Unit& u) const {
        const int L = i * G + c; if (L >= 8 * nN * NP) return false;
        u.kp = L % NP; const int rest = L / NP; u.pn = rest % nN; u.pm = (rest / nN) * 33; return true;
    }
    __device__ __forceinline__ void a_ready(const Unit&) const {}
    __device__ __forceinline__ void done(const Unit&) const {}
};

template <class Epi, class Sched, bool ALIGN_EPI, bool SP2, int KC, int LDAC, int LDBC = KC>
__device__ __forceinline__ void gemm_phase(PG8_LAS unsigned char* lds, const Gemm g, const Sched& S, const Epi& E, const int tid) {
    const int wid = __builtin_amdgcn_readfirstlane(tid >> 6), lane = tid & 63, wr = wid >> 2, wc = wid & 3, fr = lane & 15, fq = lane >> 4;
    constexpr int K = KC, nt = K / BK;
    unsigned voffA[2], voffB[2];
#pragma unroll
    for (int i = 0; i < 2; ++i) { int R, C; stage_rc(tid * 16 + i * 8192, R, C); const int Rb = Epi::PERM ? ((R & ~31) + perm32(R & 31)) : R;
        voffA[i] = (unsigned)(R * LDAC + C) * 2u; voffB[i] = (unsigned)(Rb * LDBC + C) * 2u; }
    const size_t kstep = (size_t)(BK * 2);
    const size_t hstepA = (size_t)HALF * LDAC * 2, hstepB = (size_t)HALF * LDBC * 2;
    const size_t tstepA = 2 * hstepA, tstepB = 2 * hstepB;
    const unsigned ldsw = (unsigned)wid * 1024u;
    const int aoff = lds_byte(wr * 64 + fr, fq * 8), boff = lds_byte(wc * 32 + fr, fq * 8);
#define PG8_SA(b, h) (((b) * 2 + (h)) * HTB)
#define PG8_SB(b, h) ((4 + (b) * 2 + (h)) * HTB)
#define PG8_STAGE(bufoff, gbase, voff) do { _Pragma("unroll") for (int _i = 0; _i < 2; ++_i) \
        __builtin_amdgcn_global_load_lds((const unsigned*)((const char*)(gbase) + (voff)[_i]), (PG8_LAS unsigned*)(lds + (bufoff) + ldsw + _i * 8192), 16, 0, 0); } while (0)
#define PG8_LDA(dst, b, h) do { _Pragma("unroll") for (int m = 0; m < 4; ++m) _Pragma("unroll") for (int k = 0; k < 2; ++k) dst[m][k] = *(const PG8_LAS bf16x8*)(lds + PG8_SA(b, h) + aoff + m * 2048 + k * 1024); } while (0)
#define PG8_LDB(dst, b, h) do { _Pragma("unroll") for (int n = 0; n < 2; ++n) _Pragma("unroll") for (int k = 0; k < 2; ++k) dst[n][k] = *(const PG8_LAS bf16x8*)(lds + PG8_SB(b, h) + boff + n * 2048 + k * 1024); } while (0)
#define PG8_MMA(ai, bj, At, Bt) do { __builtin_amdgcn_s_setprio(1); _Pragma("unroll") for (int m = 0; m < 4; ++m) _Pragma("unroll") for (int n = 0; n < 2; ++n) _Pragma("unroll") for (int k = 0; k < 2; ++k) \
        acc[ai][bj][m][n] = __builtin_amdgcn_mfma_f32_16x16x32_bf16(Bt[n][k], At[m][k], acc[ai][bj][m][n], 0, 0, 0); __builtin_amdgcn_s_setprio(0); } while (0)
#define PG8_WAIT_V(n) asm volatile("s_waitcnt vmcnt(" #n ")" ::: "memory")
#define PG8_WAIT_L(n) asm volatile("s_waitcnt lgkmcnt(" #n ")" ::: "memory")
#define PG8_BAR __builtin_amdgcn_s_barrier()
#define PG8_SCHED __builtin_amdgcn_sched_barrier(0)
    Unit cur, nxt; int ui = 0;
    if (!S.next(0, cur)) return;
    f32x4 acc[2][2][4][2];
#pragma unroll
    for (int a = 0; a < 2; ++a)
#pragma unroll
        for (int b = 0; b < 2; ++b)
#pragma unroll
            for (int m = 0; m < 4; ++m)
#pragma unroll
                for (int n = 0; n < 2; ++n) acc[a][b][m][n] = (f32x4){0.f, 0.f, 0.f, 0.f};
    bf16x8 At[4][2], B0[2][2], B1[2][2];
    const char* cA = (const char*)g.A + (size_t)cur.pm * tstepA + (size_t)cur.kp * (K * 2); const char* cB = (const char*)g.Bt + (size_t)cur.pn * tstepB + (size_t)cur.kp * (K * 2);
    S.a_ready(cur);
    if constexpr (SP2) {
        PG8_STAGE(PG8_SB(0, 0), cB, voffB); PG8_STAGE(PG8_SB(0, 1), cB + hstepB, voffB); PG8_STAGE(PG8_SA(0, 0), cA, voffA); PG8_STAGE(PG8_SA(0, 1), cA + hstepA, voffA);
        if (wr == 1) PG8_BAR;
        PG8_WAIT_V(2); PG8_BAR;
        PG8_STAGE(PG8_SB(1, 0), cB + kstep, voffB); PG8_STAGE(PG8_SA(1, 0), cA + kstep, voffA); PG8_STAGE(PG8_SB(1, 1), cB + hstepB + kstep, voffB);
        PG8_WAIT_V(6); PG8_BAR;
    } else {
        PG8_STAGE(PG8_SB(0, 0), cB, voffB); PG8_STAGE(PG8_SA(0, 0), cA, voffA); PG8_STAGE(PG8_SB(0, 1), cB + hstepB, voffB); PG8_STAGE(PG8_SA(0, 1), cA + hstepA, voffA);
        if (wr == 1) PG8_BAR;
        PG8_WAIT_V(4); PG8_BAR;
        PG8_STAGE(PG8_SB(1, 0), cB + kstep, voffB); PG8_STAGE(PG8_SA(1, 0), cA + kstep, voffA); PG8_STAGE(PG8_SB(1, 1), cB + hstepB + kstep, voffB);
        PG8_WAIT_V(6); PG8_BAR;
    }
    for (;;) {
        const bool has_next = S.next(ui + 1, nxt);
        const char* nA = has_next ? (const char*)g.A + (size_t)nxt.pm * tstepA + (size_t)nxt.kp * (K * 2) : cA; const char* nB = has_next ? (const char*)g.Bt + (size_t)nxt.pn * tstepB + (size_t)nxt.kp * (K * 2) : cB;
#pragma nounroll
        for (int t = 0; t < nt; t += 2) {
            const bool last = (t == nt - 2);
            const char* a1 = cA + (size_t)(t + 1) * kstep;
            const char* a2 = last ? nA : cA + (size_t)(t + 2) * kstep; const char* b2 = last ? nB : cB + (size_t)(t + 2) * kstep;
            const char* a3 = a2 + kstep; const char* b3 = b2 + kstep;
            if (last && has_next) S.a_ready(nxt);
            if constexpr (SP2) {
            PG8_LDB(B0, 0, 0); PG8_LDB(B1, 0, 1); PG8_SCHED; PG8_LDA(At, 0, 0); PG8_STAGE(PG8_SA(1, 1), a1 + hstepA, voffA);
            PG8_WAIT_V(8); PG8_WAIT_L(0); PG8_BAR; PG8_MMA(0, 0, At, B0); PG8_MMA(0, 1, At, B1); PG8_BAR; PG8_SCHED;
            PG8_LDA(At, 0, 1); PG8_STAGE(PG8_SB(0, 0), b2, voffB); PG8_STAGE(PG8_SB(0, 1), b2 + hstepB, voffB); PG8_STAGE(PG8_SA(0, 0), a2, voffA);
            PG8_WAIT_V(8); PG8_WAIT_L(0); PG8_BAR; PG8_MMA(1, 0, At, B0); PG8_MMA(1, 1, At, B1); PG8_BAR; PG8_SCHED;
            PG8_LDB(B0, 1, 0); PG8_LDB(B1, 1, 1); PG8_SCHED; PG8_LDA(At, 1, 0); PG8_STAGE(PG8_SA(0, 1), a2 + hstepA, voffA);
            PG8_WAIT_V(8); PG8_WAIT_L(0); PG8_BAR; PG8_MMA(0, 0, At, B0); PG8_MMA(0, 1, At, B1); PG8_BAR; PG8_SCHED;
            PG8_LDA(At, 1, 1); PG8_STAGE(PG8_SB(1, 0), b3, voffB); PG8_STAGE(PG8_SB(1, 1), b3 + hstepB, voffB); PG8_STAGE(PG8_SA(1, 0), a3, voffA);
            PG8_WAIT_V(8); PG8_WAIT_L(0); PG8_BAR; PG8_MMA(1, 0, At, B0); PG8_MMA(1, 1, At, B1); PG8_BAR; PG8_SCHED;
            } else {
            PG8_LDB(B0, 0, 0); PG8_SCHED; PG8_LDA(At, 0, 0); PG8_STAGE(PG8_SA(1, 1), a1 + hstepA, voffA);
            PG8_WAIT_L(8); PG8_BAR; PG8_WAIT_L(0); PG8_MMA(0, 0, At, B0); PG8_BAR; PG8_SCHED;
            PG8_LDB(B1, 0, 1); PG8_STAGE(PG8_SB(0, 0), b2, voffB);
            PG8_BAR; PG8_WAIT_L(0); PG8_MMA(0, 1, At, B1); PG8_BAR;
            PG8_LDA(At, 0, 1); PG8_STAGE(PG8_SA(0, 0), a2, voffA);
            PG8_BAR; PG8_WAIT_L(0); PG8_MMA(1, 0, At, B0); PG8_BAR; PG8_SCHED;
            PG8_STAGE(PG8_SB(0, 1), b2 + hstepB, voffB);
            PG8_WAIT_V(6); PG8_BAR; PG8_MMA(1, 1, At, B1); PG8_BAR;
            PG8_LDB(B0, 1, 0); PG8_SCHED; PG8_LDA(At, 1, 0); PG8_STAGE(PG8_SA(0, 1), a2 + hstepA, voffA);
            PG8_WAIT_L(8); PG8_BAR; PG8_WAIT_L(0); PG8_MMA(0, 0, At, B0); PG8_BAR; PG8_SCHED;
            PG8_LDB(B1, 1, 1); PG8_STAGE(PG8_SB(1, 0), b3, voffB);
            PG8_BAR; PG8_WAIT_L(0); PG8_MMA(0, 1, At, B1); PG8_BAR;
            PG8_LDA(At, 1, 1); PG8_STAGE(PG8_SA(1, 0), a3, voffA);
            PG8_BAR; PG8_WAIT_L(0); PG8_MMA(1, 0, At, B0); PG8_BAR; PG8_SCHED;
            PG8_STAGE(PG8_SB(1, 1), b3 + hstepB, voffB);
            PG8_WAIT_V(6); PG8_BAR; PG8_MMA(1, 1, At, B1); PG8_BAR;
            }
        }
        if constexpr (ALIGN_EPI) { if (wr == 0) PG8_BAR; }
        if constexpr (!Epi::AFTER_DRAIN) { int te = tid; asm volatile("" : "+v"(te)); E(acc, cur, wr, wc, te & 15, (te & 63) >> 4); S.done(cur); }
        if (!has_next) break;
#pragma unroll
        for (int a = 0; a < 2; ++a)
#pragma unroll
            for (int b = 0; b < 2; ++b)
#pragma unroll
                for (int m = 0; m < 4; ++m)
#pragma unroll
                    for (int n = 0; n < 2; ++n) acc[a][b][m][n] = (f32x4){0.f, 0.f, 0.f, 0.f};
        cur = nxt; cA = nA; cB = nB; ++ui;
        if constexpr (ALIGN_EPI) { if (wr == 1) PG8_BAR; }
    }
    PG8_WAIT_V(0);
    if constexpr (!ALIGN_EPI) { if (wr == 0) PG8_BAR; }
    PG8_BAR;
    if constexpr (Epi::AFTER_DRAIN) { E.fused(acc, cur, wr, wc, fr, fq, lds, wid, lane); S.done(cur); }
#undef PG8_SA
#undef PG8_SB
#undef PG8_STAGE
#undef PG8_LDA
#undef PG8_LDB
#undef PG8_MMA
#undef PG8_WAIT_V
#undef PG8_WAIT_L
#undef PG8_BAR
#undef PG8_SCHED
}
}


#define LAS __attribute__((address_space(3)))
typedef unsigned short bf16_t;
typedef short bf16x8 __attribute__((ext_vector_type(8)));
typedef float f32x4 __attribute__((ext_vector_type(4)));
typedef unsigned u32x4 __attribute__((ext_vector_type(4)));
typedef unsigned u32x2 __attribute__((ext_vector_type(2)));
typedef float f32x2_t __attribute__((ext_vector_type(2)));
typedef __bf16 bf16x2_t __attribute__((ext_vector_type(2)));

constexpr int DM = 1024, NB = 8, SEQL = 8192, CTXL = 256, SEGL = SEQL + CTXL  , T = NB * SEGL  ;
constexpr int DFF = 4096, NTHR = 512, NWAVE = 8;
constexpr float EPS = 1e-6f;
constexpr size_t MiB = 1u << 20;
constexpr size_t WS_MOD = 0;
constexpr size_t WS_TAB = 1 * MiB;
constexpr size_t WS_XC = 2 * MiB;
constexpr size_t WS_WFF1 = 10 * MiB, WS_WFF2 = 18 * MiB, WS_WA = 26 * MiB, WS_WB = 38 * MiB;
constexpr size_t WS_WUQ = 28 * MiB, WS_WUKV = WS_WUQ + 512 * 1024, WS_WPOOL = 29 * MiB;
constexpr size_t WS_H = 46 * MiB;
constexpr size_t WS_B0 = 178 * MiB;
constexpr size_t WS_UQN = 310 * MiB, WS_UKVN = 343 * MiB, WS_KR = 360 * MiB, WS_PD = 365 * MiB, WS_Q = 431 * MiB, WS_KV = 530 * MiB;
constexpr size_t WS_Y = 706 * MiB;
constexpr size_t WS_YP = 838 * MiB;
constexpr size_t WS_END = 970 * MiB;
constexpr size_t WS_BAR = 900 * 1024;
constexpr int LDS_BAR_OFF = 141312;
constexpr int LDS_BYTES = 143360;

struct Params {
  const float *x, *c, *ctx, *c_ctx, *w_ada, *b_ada, *g_mix_pre, *g_mix_post, *g_ffn_pre, *g_ffn_post, *w_ffn_in, *w_ffn_out, *w_in_even, *g_q_lora, *g_kv_lora,
      *w_uq, *w_ukv, *w_pool, *pool_scale, *w_out_even, *w_in_odd, *w_out_odd;
  float* out; unsigned char* ws; int lo, hi;
};

__device__ __forceinline__ unsigned cvtpk(float lo, float hi) { f32x2_t v = {lo, hi}; bf16x2_t b = __builtin_convertvector(v, bf16x2_t); return __builtin_bit_cast(unsigned, b); }
__device__ __forceinline__ float bflo(unsigned u) { return __uint_as_float(u << 16); }
__device__ __forceinline__ float bfhi(unsigned u) { return __uint_as_float(u & 0xffff0000u); }
__device__ __forceinline__ bf16_t f2bf(float f) { return (bf16_t)(cvtpk(f, 0.f) & 0xffffu); }
__device__ __forceinline__ float wave_sum(float v) {
#pragma unroll
  for (int o = 1; o < 64; o <<= 1) v += __shfl_xor(v, o);
  return v;
}
__device__ __forceinline__ f32x4 mfma16(bf16x8 a, bf16x8 b, f32x4 c) { return __builtin_amdgcn_mfma_f32_16x16x32_bf16(a, b, c, 0, 0, 0); }

template <int mode, int ldc, int col_off> struct Epi {
  static constexpr bool PERM = true, AFTER_DRAIN = false;
  bf16_t* O; const float* cs; const float* tab; float scale;
  __device__ __forceinline__ void operator()(const f32x4 (&acc)[2][2][4][2], const pg8::Unit& u, int wr, int wc, int fr, int fq) const {
    const int seg = u.pm % 33; const bool islat = seg != 0;
    const int colt = u.pn * 256 + wc * 32 + 8 * fq;
#pragma unroll
    for (int ai = 0; ai < 2; ++ai)
#pragma unroll
      for (int m = 0; m < 4; ++m) {
        const int lrow = ai * 128 + wr * 64 + m * 16 + fr;
        const int row = u.pm * 256 + lrow;
        const int tok = (seg - 1) * 256 + lrow;
        bf16_t* rowp = O + (size_t)row * ldc + col_off;
#pragma unroll
        for (int bj = 0; bj < 2; ++bj) {
          const int c = colt + bj * 128;
          f32x4 v0 = acc[ai][bj][m][0], v1 = acc[ai][bj][m][1];
          if (mode == 5) {
            float* pp = (float*)O + ((size_t)(u.kp * 2048 + (u.pm / 33) * 256 + lrow) * 1024 + c);
            *(f32x4*)pp = v0; *(f32x4*)(pp + 4) = v1;
            continue;
          }
          if (mode == 1) {
#pragma unroll
            for (int i = 0; i < 4; ++i) { float a = fmaxf(v0[i], 0.f), b = fmaxf(v1[i], 0.f); v0[i] = a * a; v1[i] = b * b; }
          } else if (mode == 2) {
            const int hc = c % 96;
            if (islat && hc >= 64) {
              const int j = hc - 64, part = j >> 4, g = (j & 15) >> 3, pos = part ? (tok & 63) : (tok >> 6);
              const f32x4 cs4 = *(const f32x4*)(tab + pos * 8 + 4 * g), sn4 = *(const f32x4*)(tab + 1024 + pos * 8 + 4 * g);
              const f32x4 o0 = v0 * cs4 - v1 * sn4, o1 = v0 * sn4 + v1 * cs4; v0 = o0; v1 = o1;
            }
            v0 = v0 * scale; v1 = v1 * scale;
          } else if (mode == 3) {
            if (u.pn < 8) {
              if (islat) {
                const int hc = c & 127, part = hc >> 6, g = (hc & 63) >> 3, pos = part ? (tok & 63) : (tok >> 6);
                const f32x4 cs4 = *(const f32x4*)(tab + pos * 32 + 4 * g), sn4 = *(const f32x4*)(tab + 4096 + pos * 32 + 4 * g);
                const f32x4 o0 = v0 * cs4 - v1 * sn4, o1 = v0 * sn4 + v1 * cs4; v0 = o0; v1 = o1;
              }
              if (u.pn >= 4) { v0 = v0 * scale; v1 = v1 * scale; }
            }
          } else if (mode == 4) {
            const u32x4 old = *(const u32x4*)(rowp + c);
            const float ov[8] = {bflo(old.x), bfhi(old.x), bflo(old.y), bfhi(old.y), bflo(old.z), bfhi(old.z), bflo(old.w), bfhi(old.w)};
#pragma unroll
            for (int i = 0; i < 4; ++i) { const float a = v0[i], b = v1[i]; v0[i] = a / (1.f + __expf(-a)) * ov[i]; v1[i] = b / (1.f + __expf(-b)) * ov[4 + i]; }
          } else if (cs) {
            const f32x4 s0 = *(const f32x4*)(cs + c), s1 = *(const f32x4*)(cs + c + 4); v0 = v0 * s0; v1 = v1 * s1;
          }
          u32x4 w; w.x = cvtpk(v0[0], v0[1]); w.y = cvtpk(v0[2], v0[3]); w.z = cvtpk(v1[0], v1[1]); w.w = cvtpk(v1[2], v1[3]);
          *(u32x4*)(rowp + c) = w;
        }
      }
  }
};

__device__ __forceinline__ int src_col(int n, int mode) {
  if (mode == 1) { const int hc = n % 96; if (hc >= 64) { const int j = (hc - 64) & 15, g = j >> 3, i = j & 7; return n - j + ((i < 4) ? 4 * g + i : 8 + 4 * g + (i - 4)); } return n; }
  if (mode == 2) { if (n < 2048) { const int j = n & 63, g = j >> 3, i = j & 7; return n - j + ((i < 4) ? 4 * g + i : 32 + 4 * g + (i - 4)); } return n; }
  return n;
}
__device__ __forceinline__ void tr_item(const float* W, int K, int N, bf16_t* WT, int ldk, int mode, LAS float* scr, int item, int lane) {
  const int nblk = N / 32, kb = item / nblk, nb = item % nblk, k0 = 64 * kb, n0 = 32 * nb;
  const int sc = src_col(n0 + (lane & 31), mode);
#pragma unroll 8
  for (int i = 0; i < 32; ++i) { const int kk = 2 * i + (lane >> 5); scr[kk * 33 + (lane & 31)] = W[(size_t)(k0 + kk) * N + sc]; }
  asm volatile("s_waitcnt lgkmcnt(0)" ::: "memory");
  const int c = lane & 7;
#pragma unroll
  for (int j = 0; j < 4; ++j) { const int n = (lane >> 3) + 8 * j; const LAS float* s = scr + (8 * c) * 33 + n;
    u32x4 o; o.x = cvtpk(s[0 * 33], s[1 * 33]); o.y = cvtpk(s[2 * 33], s[3 * 33]); o.z = cvtpk(s[4 * 33], s[5 * 33]); o.w = cvtpk(s[6 * 33], s[7 * 33]);
    *(u32x4*)(WT + (size_t)(n0 + n) * ldk + k0 + 8 * c) = o; }
  asm volatile("s_waitcnt lgkmcnt(0)" ::: "memory");
}
__device__ __forceinline__ void conv_mat(const float* W, int K, int N, bf16_t* WT, int mode, LAS float* scr, int gw, int ngw, int lane, int ldk = 0) {
  const int items = (K / 64) * (N / 32);
  for (int it = gw; it < items; it += ngw) tr_item(W, K, N, WT, ldk ? ldk : K, mode, scr, it, lane);
}
__device__ __forceinline__ void conv_pool(const float* Wp, bf16_t* WT, LAS float* scr, int gw, int ngw, int lane) {
  for (int it = gw; it < 8 * 16; it += ngw) {
    const int kb = it / 16, nb = it % 16, k0 = 64 * kb, n0 = 32 * nb, gk = k0 >> 7, gn = n0 >> 7;
    if (gk == gn) {
      const float* W = Wp + (size_t)gk * 128 * 128;
#pragma unroll 8
      for (int i = 0; i < 32; ++i) { const int kk = 2 * i + (lane >> 5); scr[kk * 33 + (lane & 31)] = W[(size_t)(k0 - gk * 128 + kk) * 128 + (n0 - gn * 128) + (lane & 31)]; }
    } else {
#pragma unroll 8
      for (int i = 0; i < 32; ++i) { const int kk = 2 * i + (lane >> 5); scr[kk * 33 + (lane & 31)] = 0.f; }
    }
    asm volatile("s_waitcnt lgkmcnt(0)" ::: "memory");
    const int c = lane & 7;
#pragma unroll
    for (int j = 0; j < 4; ++j) { const int n = (lane >> 3) + 8 * j; const LAS float* s = scr + (8 * c) * 33 + n;
      u32x4 o; o.x = cvtpk(s[0 * 33], s[1 * 33]); o.y = cvtpk(s[2 * 33], s[3 * 33]); o.z = cvtpk(s[4 * 33], s[5 * 33]); o.w = cvtpk(s[6 * 33], s[7 * 33]);
      *(u32x4*)(WT + (size_t)(n0 + n) * 512 + k0 + 8 * c) = o; }
    asm volatile("s_waitcnt lgkmcnt(0)" ::: "memory");
  }
}
__device__ __forceinline__ void conv_layer(const Params& p, int L, LAS unsigned char* lds, int gw, int ngw, int wid, int lane) {
  LAS float* scr = (LAS float*)(lds + wid * 16384);
  unsigned char* ws = p.ws; const int i = L >> 1;
  conv_mat(p.w_ffn_in + (size_t)L * DM * DFF, DM, DFF, (bf16_t*)(ws + WS_WFF1), 0, scr, gw, ngw, lane);
  conv_mat(p.w_ffn_out + (size_t)L * DFF * DM, DFF, DM, (bf16_t*)(ws + WS_WFF2), 0, scr, gw, ngw, lane);
  if ((L & 1) == 0) {
    conv_mat(p.w_in_even + (size_t)i * DM * 928, DM, 928, (bf16_t*)(ws + WS_WA), 0, scr, gw, ngw, lane);
    conv_mat(p.w_uq + (size_t)i * 256 * 768, 256, 768, (bf16_t*)(ws + WS_WUQ), 1, scr, gw, ngw, lane);
    conv_mat(p.w_ukv + (size_t)i * 128 * 1024, 128, 1024, (bf16_t*)(ws + WS_WUKV), 0, scr, gw, ngw, lane, 256);
    for (int e = gw * 64 + lane; e < 1024 * 16; e += ngw * 64) { const int n = e >> 4, c = e & 15; *(u32x4*)((bf16_t*)(ws + WS_WUKV) + (size_t)n * 256 + 128 + c * 8) = (u32x4){0u, 0u, 0u, 0u}; }
    conv_pool(p.w_pool + (size_t)i * 4 * 128 * 128, (bf16_t*)(ws + WS_WPOOL), scr, gw, ngw, lane);
    conv_mat(p.w_out_even + (size_t)i * 1024 * 1024, 1024, 1024, (bf16_t*)(ws + WS_WB), 0, scr, gw, ngw, lane);
  } else {
    conv_mat(p.w_in_odd + (size_t)i * DM * 6144, DM, 6144, (bf16_t*)(ws + WS_WA), 2, scr, gw, ngw, lane);
    conv_mat(p.w_out_odd + (size_t)i * 2048 * 1024, 2048, 1024, (bf16_t*)(ws + WS_WB), 0, scr, gw, ngw, lane);
  }
}

__device__ __forceinline__ void p0_phase(const Params& p, LAS unsigned char* lds, const int tid, const int bid) {
  const int G = gridDim.x, lane = tid & 63, wid = tid >> 6;
  float* mod = (float*)(p.ws + WS_MOD);
  LAS float* sc = (LAS float*)lds;
  LAS float* part = (LAS float*)(lds + 9 * 1024 * 4);
  for (int e = tid; e < 9 * 1024; e += NTHR) { const int r = e >> 10, k = e & 1023; const float v = (r < 8) ? p.c[r * DM + k] : p.c_ctx[k]; sc[e] = v / (1.f + expf(-v)); }
  __syncthreads();
  for (int it = bid; it < 4 * 96; it += G) {
    const int L = it / 96, col0 = (it % 96) * 64;
    float a0 = 0, a1 = 0, a2 = 0, a3 = 0, a4 = 0, a5 = 0, a6 = 0, a7 = 0, a8 = 0;
    const float* wp = p.w_ada + ((size_t)L * DM + wid * 128) * 6144 + col0 + lane;
    const LAS float* s0 = sc + wid * 128;
#pragma unroll 16
    for (int k = 0; k < 128; ++k) { const float w = wp[(size_t)k * 6144];
      a0 += s0[k] * w; a1 += s0[1024 + k] * w; a2 += s0[2048 + k] * w; a3 += s0[3072 + k] * w; a4 += s0[4096 + k] * w; a5 += s0[5120 + k] * w; a6 += s0[6144 + k] * w; a7 += s0[7168 + k] * w; a8 += s0[8192 + k] * w; }
    LAS float* pp = part + wid * 9 * 64 + lane;
    pp[0] = a0; pp[64] = a1; pp[128] = a2; pp[192] = a3; pp[256] = a4; pp[320] = a5; pp[384] = a6; pp[448] = a7; pp[512] = a8;
    __syncthreads();
    for (int e = tid; e < 9 * 64; e += NTHR) { const int r = e >> 6, cl = e & 63; float v = p.b_ada[L * 6144 + col0 + cl];
#pragma unroll
      for (int w = 0; w < 8; ++w) v += part[w * 9 * 64 + e];
      mod[((size_t)L * 9 + r) * 6144 + col0 + cl] = v; }
    __syncthreads();
  }
  float* tab = (float*)(p.ws + WS_TAB);
  for (int e = bid * NTHR + tid; e < 1024 + 4096; e += G * NTHR) {
    if (e < 1024) { const int pos = e >> 3, i = e & 7; const float fr = powf(10000.f, -(float)(2 * i) / 16.f), a = (float)pos * fr; tab[e] = cosf(a); tab[1024 + e] = sinf(a); }
    else { const int q = e - 1024, pos = q >> 5, i = q & 31; const float fr = powf(10000.f, -(float)(2 * i) / 64.f), a = (float)pos * fr; tab[2048 + q] = cosf(a); tab[2048 + 4096 + q] = sinf(a); }
  }
}

__device__ __forceinline__ const float* xrow_ptr(const float* xl, const float* xc, int r) {
  const int b = r / SEGL, w = r % SEGL;
  return (w < CTXL) ? xc + (size_t)(b * CTXL + w) * DM : xl + (size_t)(b * SEQL + (w - CTXL)) * DM;
}
__device__ __forceinline__ void norm_phase(const Params& p, bool first, bool has_res, bool final_, const float* gpost, const float* gate_mod  ,
                                            const float* gpre, const float* shsc_mod  , int gw, int ngw, int lane, bool dry = false, const float* ysplit = nullptr) {
  const bf16_t* Y = (const bf16_t*)(p.ws + WS_Y); bf16_t* H = (bf16_t*)(p.ws + WS_H); float* XC = (float*)(p.ws + WS_XC);
  const float* xl = first ? p.x : p.out; const float* xc = first ? p.ctx : XC;
  const int rbeg = gw, rend = T, rstep = ngw;
  if (rbeg >= rend) return;
  int cur_m = -1;
  f32x4 cres[4], ca[4], csh[4];
#pragma unroll
  for (int j = 0; j < 4; ++j) { cres[j] = (f32x4){0.f, 0.f, 0.f, 0.f}; ca[j] = cres[j]; csh[j] = cres[j]; }
  f32x4 nx[4]; u32x2 ny[4];
  { const float* xs = xrow_ptr(xl, xc, rbeg);
#pragma unroll
    for (int j = 0; j < 4; ++j) { nx[j] = __builtin_nontemporal_load(((const f32x4*)xs) + lane + 64 * j); ny[j] = has_res ? __builtin_nontemporal_load(((const u32x2*)(Y + (size_t)rbeg * DM)) + lane + 64 * j) : (u32x2){0u, 0u}; } }
  for (int r = rbeg; r < rend; r += rstep) {
    const int b = r / SEGL, w = r % SEGL; const bool isctx = w < CTXL;
    float* xd = (isctx ? XC + (size_t)(b * CTXL + w) * DM : p.out + (size_t)(b * SEQL + (w - CTXL)) * DM);
    const int mrow = isctx ? 8 : b;
    f32x4 v[4]; u32x2 yq[4];
#pragma unroll
    for (int j = 0; j < 4; ++j) { v[j] = nx[j]; yq[j] = ny[j]; }
    if (r + rstep < rend) { const float* xs = xrow_ptr(xl, xc, r + rstep);
#pragma unroll
      for (int j = 0; j < 4; ++j) { nx[j] = __builtin_nontemporal_load(((const f32x4*)xs) + lane + 64 * j); if (has_res) ny[j] = __builtin_nontemporal_load(((const u32x2*)(Y + (size_t)(r + rstep) * DM)) + lane + 64 * j); } }
    if (final_ && isctx) continue;
    if (mrow != cur_m) { cur_m = mrow;
#pragma unroll
      for (int j = 0; j < 4; ++j) {
        if (has_res) cres[j] = ((const f32x4*)gpost)[lane + 64 * j] * ((const f32x4*)(gate_mod + (size_t)mrow * 6144))[lane + 64 * j];
        if (!final_) { ca[j] = ((const f32x4*)gpre)[lane + 64 * j] * (((const f32x4*)(shsc_mod + (size_t)mrow * 6144 + 1024))[lane + 64 * j] + 1.f); csh[j] = ((const f32x4*)(shsc_mod + (size_t)mrow * 6144))[lane + 64 * j]; } } }
    if (has_res) {
      f32x4 y[4]; float ss = 0.f;
#pragma unroll
      for (int j = 0; j < 4; ++j) y[j] = (f32x4){bflo(yq[j].x), bfhi(yq[j].x), bflo(yq[j].y), bfhi(yq[j].y)};
      if (ysplit && isctx) {
        const float* yp = ysplit + (size_t)(b * CTXL + w) * DM;
#pragma unroll
        for (int j = 0; j < 4; ++j) y[j] = ((const f32x4*)yp)[lane + 64 * j];
#pragma unroll 1
        for (int k = 1; k < 8; ++k) {
#pragma unroll
          for (int j = 0; j < 4; ++j) y[j] = y[j] + ((const f32x4*)(yp + (size_t)k * 2048 * DM))[lane + 64 * j]; }
      }
#pragma unroll
      for (int j = 0; j < 4; ++j) ss += (y[j].x * y[j].x + y[j].y * y[j].y) + (y[j].z * y[j].z + y[j].w * y[j].w);
      const float rs = rsqrtf(wave_sum(ss) * (1.f / DM) + EPS);
#pragma unroll
      for (int j = 0; j < 4; ++j) v[j] = v[j] + cres[j] * (y[j] * rs);
    }
    if ((has_res || first) && !dry) {
#pragma unroll
      for (int j = 0; j < 4; ++j) __builtin_nontemporal_store(v[j], ((f32x4*)xd) + lane + 64 * j);
    }
    if (!final_) {
      float ss = 0.f;
#pragma unroll
      for (int j = 0; j < 4; ++j) ss += (v[j].x * v[j].x + v[j].y * v[j].y) + (v[j].z * v[j].z + v[j].w * v[j].w);
      const float rs = rsqrtf(wave_sum(ss) * (1.f / DM) + EPS);
#pragma unroll
      for (int j = 0; j < 4; ++j) { const f32x4 h = (v[j] * rs) * ca[j] + csh[j];
        u32x2 o; o.x = cvtpk(h.x, h.y); o.y = cvtpk(h.z, h.w); __builtin_nontemporal_store(o, ((u32x2*)(H + (size_t)r * DM)) + lane + 64 * j); }
    }
  }
}

__device__ __forceinline__ void mid_phase(const Params& p, int i, int gw, int ngw, int lane) {
  const bf16_t* U = (const bf16_t*)(p.ws + WS_B0); bf16_t* UQN = (bf16_t*)(p.ws + WS_UQN); bf16_t* UKVN = (bf16_t*)(p.ws + WS_UKVN); bf16_t* KR = (bf16_t*)(p.ws + WS_KR); bf16_t* PD = (bf16_t*)(p.ws + WS_PD);
  const float* tab = (const float*)(p.ws + WS_TAB);
  const float* gq = p.g_q_lora + i * 256; const float* gkv = p.g_kv_lora + i * 128;
  const f32x4 g4 = ((const f32x4*)gq)[lane]; const float gk0 = gkv[2 * lane], gk1 = gkv[2 * lane + 1];
  for (int r = gw; r < T; r += ngw) {
    const int w = r % SEGL; const bool isctx = w < CTXL; const int t = isctx ? w : w - CTXL, Lseg = isctx ? CTXL : SEQL;
    const bf16_t* ur = U + (size_t)r * 1024;
    const u32x2 qw = ((const u32x2*)ur)[lane];
    const unsigned kvw = ((const unsigned*)(ur + 256))[lane];
    const int j = lane & 31; const float val = bflo((unsigned)ur[384 + j]);
    const int part = j >> 4, jj = j & 15, isx2 = jj >> 3, fi = jj & 7;
    float cs = 1.f, sn = 0.f;
    if (!isctx) { const int pos = part ? (t & 63) : (t >> 6); cs = tab[pos * 8 + fi]; sn = tab[1024 + pos * 8 + fi]; }
    const int g = lane >> 4, wn = 2 << g; const int lo = max(t - (wn >> 1), 0), hi = min(t + wn - (wn >> 1), Lseg);
    float s[8] = {0, 0, 0, 0, 0, 0, 0, 0};
    const bf16_t* base = ur + 416 + lane * 8;
#pragma unroll
    for (int k = 0; k < 16; ++k) { const int q = t - 8 + k;
      if (q >= lo && q < hi) { const u32x4 d = *(const u32x4*)(base + (ptrdiff_t)(q - t) * 1024);
        s[0] += bflo(d.x); s[1] += bfhi(d.x); s[2] += bflo(d.y); s[3] += bfhi(d.y); s[4] += bflo(d.z); s[5] += bfhi(d.z); s[6] += bflo(d.w); s[7] += bfhi(d.w); } }
    const u32x4 own = *(const u32x4*)base;
    const float a0 = bflo(qw.x), a1 = bfhi(qw.x), a2 = bflo(qw.y), a3 = bfhi(qw.y);
    const float rsq = rsqrtf(wave_sum(a0 * a0 + a1 * a1 + a2 * a2 + a3 * a3) * (1.f / 256.f) + EPS);
    const float b0 = bflo(kvw), b1 = bfhi(kvw);
    const float rsk = rsqrtf(wave_sum(b0 * b0 + b1 * b1) * (1.f / 128.f) + EPS);
    const float pv = __shfl_xor(val, 8);
    const float ko = isx2 ? (pv * sn + val * cs) : (val * cs - pv * sn);
    const int dst = part * 16 + 8 * (fi >> 2) + (fi & 3) + 4 * isx2;
    const float inv = 1.f / (float)(hi - lo);
    { u32x2 o; o.x = cvtpk(a0 * rsq * g4.x, a1 * rsq * g4.y); o.y = cvtpk(a2 * rsq * g4.z, a3 * rsq * g4.w); ((u32x2*)(UQN + (size_t)r * 256))[lane] = o; }
    ((unsigned*)(UKVN + (size_t)r * 128))[lane] = cvtpk(b0 * rsk * gk0, b1 * rsk * gk1);
    if (lane < 32) KR[(size_t)r * 32 + dst] = f2bf(ko);
    { u32x4 o; o.x = cvtpk(s[0] * inv - bflo(own.x), s[1] * inv - bfhi(own.x)); o.y = cvtpk(s[2] * inv - bflo(own.y), s[3] * inv - bfhi(own.y));
      o.z = cvtpk(s[4] * inv - bflo(own.z), s[5] * inv - bfhi(own.z)); o.w = cvtpk(s[6] * inv - bflo(own.w), s[7] * inv - bfhi(own.w));
      *(u32x4*)(PD + (size_t)r * 512 + lane * 8) = o; }
  }
}

__device__ __forceinline__ void gn_phase(const Params& p, int gw, int ngw, int lane) {
  bf16_t* U = (bf16_t*)(p.ws + WS_B0);
  for (int r = gw; r < T; r += ngw) {
    bf16_t* rowp = U + (size_t)r * 4096 + 2048 + lane * 8;
    u32x4 d[4];
#pragma unroll
    for (int i = 0; i < 4; ++i) d[i] = *(const u32x4*)(rowp + i * 512);
#pragma unroll
    for (int i = 0; i < 4; ++i) {
      float v[8] = {bflo(d[i].x), bfhi(d[i].x), bflo(d[i].y), bfhi(d[i].y), bflo(d[i].z), bfhi(d[i].z), bflo(d[i].w), bfhi(d[i].w)};
      float s = ((v[0] + v[1]) + (v[2] + v[3])) + ((v[4] + v[5]) + (v[6] + v[7]));
#pragma unroll
      for (int o = 1; o < 32; o <<= 1) s += __shfl_xor(s, o);
      const float mu = s * (1.f / 256.f); float q = 0.f;
#pragma unroll
      for (int e2 = 0; e2 < 8; ++e2) { v[e2] -= mu; q += v[e2] * v[e2]; }
#pragma unroll
      for (int o = 1; o < 32; o <<= 1) q += __shfl_xor(q, o);
      const float rs = rsqrtf(q * (1.f / 256.f) + EPS);
      u32x4 w; w.x = cvtpk(v[0] * rs, v[1] * rs); w.y = cvtpk(v[2] * rs, v[3] * rs); w.z = cvtpk(v[4] * rs, v[5] * rs); w.w = cvtpk(v[6] * rs, v[7] * rs);
      *(u32x4*)(rowp + i * 512) = w;
    }
  }
}

#define XB_TMO      128
#define XB_XCNT(j)  (256  + 64 * (j))
#define XB_XSUB(j)  (1280 + 64 * (j))
#define XB_XGEN(j)  (2304 + 64 * (j))
#define XB_TOP      3328
#define XB_TOPGEN   3392
#define XCD_BAR_WORDS 3456
#define XB_SPIN_CAP (1u << 18)

__device__ __forceinline__ unsigned xb_ld(unsigned* p)              { return __hip_atomic_load(p, __ATOMIC_RELAXED, __HIP_MEMORY_SCOPE_AGENT); }
__device__ __forceinline__ unsigned xb_add(unsigned* p, unsigned v) { return __hip_atomic_fetch_add(p, v, __ATOMIC_RELAXED, __HIP_MEMORY_SCOPE_AGENT); }
__device__ __forceinline__ unsigned xb_xcc_id() { return (unsigned)__builtin_amdgcn_s_getreg((3 << 11) | 20) & 0xFu; }
#define XB_SPIN(cond, bar) do { unsigned _sp = 0; while (cond) { __builtin_amdgcn_s_sleep(1); \
    if ((++_sp & 255u) == 0u) { if (xb_ld(&(bar)[XB_TMO])) break; if (_sp > XB_SPIN_CAP) { atomicAdd(&(bar)[XB_TMO], 1u); break; } } } } while (0)

struct XcdBarrier {
    unsigned* bar; unsigned x;
    volatile LAS unsigned* st;
};

__device__ __forceinline__ XcdBarrier xcd_barrier_post(unsigned* bar, volatile LAS unsigned* st) {
    XcdBarrier b; b.bar = bar; b.x = xb_xcc_id(); b.st = st;
    if (threadIdx.x == 0) (void)xb_add(&bar[XB_XCNT(b.x)], 1u);
    return b;
}
__device__ __forceinline__ void xcd_barrier_complete(unsigned* bar, unsigned x, unsigned& nloc, unsigned& nx) {
    const unsigned G = gridDim.x * gridDim.y * gridDim.z;
    unsigned sum, cnt, mine, sp = 0u;
    for (;;) {
        sum = 0u; cnt = 0u; mine = 0u;
#pragma unroll
        for (unsigned j = 0; j < 16; ++j) { const unsigned c = xb_ld(&bar[XB_XCNT(j)]); sum += c; cnt += (c > 0u) ? 1u : 0u; mine = (j == x) ? c : mine; }
        if (sum == G) break;
        __builtin_amdgcn_s_sleep(1);
        if ((++sp & 255u) == 0u) { if (xb_ld(&bar[XB_TMO])) break; if (sp > XB_SPIN_CAP) { atomicAdd(&bar[XB_TMO], 1u); break; } }
    }
    nloc = mine > 0u ? mine : 1u; nx = cnt > 0u ? cnt : 1u;
}

__device__ __forceinline__ void xcd_barrier(const XcdBarrier& b) {
    asm volatile("s_waitcnt vmcnt(0)" ::: "memory");
    __syncthreads();
    if (threadIdx.x == 0) {
        unsigned* bar = b.bar;
        __builtin_amdgcn_s_waitcnt(0);
        unsigned nloc = b.st[0], nx = b.st[1];
        if (nloc == 0u) { xcd_barrier_complete(bar, b.x, nloc, nx); b.st[0] = nloc; b.st[1] = nx; }
        const unsigned old = xb_add(&bar[XB_XSUB(b.x)], 1u);
        const unsigned gen = old / nloc;
        if (old + 1u == (gen + 1u) * nloc) {
            __builtin_amdgcn_fence(__ATOMIC_RELEASE, "agent");
            asm volatile("s_waitcnt vmcnt(0)" ::: "memory");
            const unsigned og = xb_add(&bar[XB_TOP], 1u);
            const unsigned tg = og / nx;
            if (og + 1u == (tg + 1u) * nx) xb_add(&bar[XB_TOPGEN], 1u);
            else XB_SPIN(xb_ld(&bar[XB_TOPGEN]) == tg, bar);
            __builtin_amdgcn_fence(__ATOMIC_ACQUIRE, "agent");
            xb_add(&bar[XB_XGEN(b.x)], 1u);
            asm volatile("s_waitcnt vmcnt(0)" ::: "memory");
        } else {
            XB_SPIN(xb_ld(&bar[XB_XGEN(b.x)]) == gen, bar);
            __builtin_amdgcn_fence(__ATOMIC_ACQUIRE, "agent");
            asm volatile("s_waitcnt vmcnt(0)" ::: "memory");
        }
    }
    __syncthreads();
}

typedef short v4i16_t __attribute__((ext_vector_type(4)));
__device__ __forceinline__ u32x2 tr_rd(const LAS bf16_t* p) { return __builtin_bit_cast(u32x2, __builtin_amdgcn_ds_read_tr16_b64_v4i16((LAS v4i16_t*)p)); }
constexpr int AT_KSTR = 104, AT_VSTR = 72, AT_BUF = 64 * AT_KSTR * 2 + 64 * AT_VSTR * 2;
__device__ __forceinline__ void attn_stage(LAS unsigned char* buf, int tid, u32x4 rk, u32x4 rv, u32x4 rr) {
  LAS bf16_t* Ks = (LAS bf16_t*)buf; LAS bf16_t* Vs = (LAS bf16_t*)(buf + 64 * AT_KSTR * 2);
  const int skey = tid >> 3, sch = tid & 7;
  *(LAS u32x4*)(Ks + skey * AT_KSTR + sch * 8) = rk;
  if (tid < 256) { const int rkey = tid >> 2, rch = tid & 3; *(LAS u32x4*)(Ks + rkey * AT_KSTR + 64 + rch * 8) = rr; }
  *(LAS u32x4*)(Vs + skey * AT_VSTR + sch * 8) = rv;
}
__device__ __forceinline__ void attn_unit(LAS unsigned char* lds, const bf16_t* Q, const bf16_t* KV, const bf16_t* KR, bf16_t* MIX, size_t qrow0, size_t krow0, int ntiles, int h, const int tid) {
  const int lane = tid & 63, wid = tid >> 6, c16 = lane & 15, quad = lane >> 4, tq = (lane & 15) >> 2, tp = lane & 3;
  const bf16_t* gk = KV + (krow0 + (tid >> 3)) * 1024 + h * 128 + (tid & 7) * 8;
  const bf16_t* gr = KR + (krow0 + ((tid & 255) >> 2)) * 32 + (tid & 3) * 8;
  bf16x8 qf[2][3];
#pragma unroll
  for (int qb = 0; qb < 2; ++qb)
#pragma unroll
    for (int ks = 0; ks < 3; ++ks) qf[qb][ks] = *(const bf16x8*)(Q + (qrow0 + wid * 32 + qb * 16 + c16) * 768 + h * 96 + ks * 32 + quad * 8);
  f32x4 o[2][4];
#pragma unroll
  for (int qb = 0; qb < 2; ++qb)
#pragma unroll
    for (int eb = 0; eb < 4; ++eb) o[qb][eb] = (f32x4){0.f, 0.f, 0.f, 0.f};
  float mref[2] = {0.f, 0.f}; f32x4 lacc[2] = {(f32x4){0.f, 0.f, 0.f, 0.f}, (f32x4){0.f, 0.f, 0.f, 0.f}};
  const bf16x8 ones = (bf16x8){0x3F80, 0x3F80, 0x3F80, 0x3F80, 0x3F80, 0x3F80, 0x3F80, 0x3F80};
  u32x4 rk = *(const u32x4*)gk, rv = *(const u32x4*)(gk + 64), rr = (u32x4){0, 0, 0, 0};
  if (tid < 256) rr = *(const u32x4*)gr;
  __syncthreads();
  attn_stage(lds, tid, rk, rv, rr);
  __syncthreads();
  for (int t = 0; t < ntiles; ++t) {
    LAS unsigned char* buf = lds + (t & 1) * AT_BUF;
    const bool more = (t + 1 < ntiles);
    if (more) { const bf16_t* g2 = gk + (size_t)(t + 1) * 64 * 1024; rk = *(const u32x4*)g2; rv = *(const u32x4*)(g2 + 64); if (tid < 256) rr = *(const u32x4*)(gr + (size_t)(t + 1) * 64 * 32); }
    const LAS bf16_t* Ks = (const LAS bf16_t*)buf; const LAS bf16_t* Vs = (const LAS bf16_t*)(buf + 64 * AT_KSTR * 2);
    f32x4 s[4][2];
#pragma unroll
    for (int kb = 0; kb < 4; ++kb) {
      bf16x8 kf[3];
#pragma unroll
      for (int ks = 0; ks < 3; ++ks) kf[ks] = *(const LAS bf16x8*)(Ks + (kb * 16 + c16) * AT_KSTR + ks * 32 + quad * 8);
#pragma unroll
      for (int qb = 0; qb < 2; ++qb) { const float nm = -mref[qb]; f32x4 a = (f32x4){nm, nm, nm, nm};
#pragma unroll
        for (int ks = 0; ks < 3; ++ks) a = mfma16(kf[ks], qf[qb][ks], a);
        s[kb][qb] = a; }
    }
#pragma unroll
    for (int qb = 0; qb < 2; ++qb) {
      float mx = -1e30f;
#pragma unroll
      for (int kb = 0; kb < 4; ++kb) mx = fmaxf(fmaxf(fmaxf(s[kb][qb][0], s[kb][qb][1]), fmaxf(s[kb][qb][2], s[kb][qb][3])), mx);
      mx = fmaxf(mx, __shfl_xor(mx, 16)); mx = fmaxf(mx, __shfl_xor(mx, 32));
      if (t == 0 || __any(mx > 8.f)) {
        const float delta = (t == 0) ? mx : fmaxf(mx, 0.f), alpha = (t == 0) ? 1.f : __builtin_amdgcn_exp2f(-delta);
        mref[qb] += delta; lacc[qb] = lacc[qb] * alpha;
#pragma unroll
        for (int kb = 0; kb < 4; ++kb) s[kb][qb] = s[kb][qb] - delta;
#pragma unroll
        for (int eb = 0; eb < 4; ++eb) o[qb][eb] = o[qb][eb] * alpha;
      }
#pragma unroll
      for (int kb = 0; kb < 4; ++kb)
#pragma unroll
        for (int r = 0; r < 4; ++r) s[kb][qb][r] = __builtin_amdgcn_exp2f(s[kb][qb][r]);
    }
#pragma unroll
    for (int s2 = 0; s2 < 2; ++s2) {
      bf16x8 pf[2];
#pragma unroll
      for (int qb = 0; qb < 2; ++qb) { u32x4 w; w.x = cvtpk(s[2 * s2][qb][0], s[2 * s2][qb][1]); w.y = cvtpk(s[2 * s2][qb][2], s[2 * s2][qb][3]);
        w.z = cvtpk(s[2 * s2 + 1][qb][0], s[2 * s2 + 1][qb][1]); w.w = cvtpk(s[2 * s2 + 1][qb][2], s[2 * s2 + 1][qb][3]); pf[qb] = __builtin_bit_cast(bf16x8, w);
        lacc[qb] = mfma16(ones, pf[qb], lacc[qb]); }
      const LAS bf16_t* vb = Vs + (32 * s2 + 4 * quad + tq) * AT_VSTR + 4 * tp;
#pragma unroll
      for (int eb = 0; eb < 4; ++eb) {
        const u32x2 lo = tr_rd(vb + 16 * eb), hi = tr_rd(vb + 16 * AT_VSTR + 16 * eb);
        const u32x4 vv = (u32x4){lo.x, lo.y, hi.x, hi.y}; const bf16x8 vf = __builtin_bit_cast(bf16x8, vv);
#pragma unroll
        for (int qb = 0; qb < 2; ++qb) o[qb][eb] = mfma16(vf, pf[qb], o[qb][eb]);
      }
    }
    if (more) attn_stage(lds + ((t + 1) & 1) * AT_BUF, tid, rk, rv, rr);
    __syncthreads();
  }
#pragma unroll
  for (int qb = 0; qb < 2; ++qb) {
    const float inv = 1.f / lacc[qb][0];
    bf16_t* op = MIX + (qrow0 + wid * 32 + qb * 16 + c16) * 1024 + h * 64 + quad * 4;
#pragma unroll
    for (int eb = 0; eb < 4; ++eb) { u32x2 w; w.x = cvtpk(o[qb][eb][0] * inv, o[qb][eb][1] * inv); w.y = cvtpk(o[qb][eb][2] * inv, o[qb][eb][3] * inv); *(u32x2*)(op + eb * 16) = w; }
  }
}
__device__ __forceinline__ void attn_phase(const Params& p, LAS unsigned char* lds, const int tid, const int bid) {
  const bf16_t* Q = (const bf16_t*)(p.ws + WS_Q); const bf16_t* KV = (const bf16_t*)(p.ws + WS_KV); const bf16_t* KR = (const bf16_t*)(p.ws + WS_KR); bf16_t* MIX = (bf16_t*)(p.ws + WS_B0);
  const int G = gridDim.x;
  for (int u = bid; u < 2048; u += G) {
    const int b = u & 7, rest = u >> 3, qb = rest & 31, h = rest >> 5;
    attn_unit(lds, Q, KV, KR, MIX, (size_t)b * SEGL + CTXL + (size_t)qb * 256, (size_t)b * SEGL, SEGL / 64, h, tid);
  }
  for (int u = bid; u < 64; u += G) {
    const int b = u & 7, h = u >> 3;
    attn_unit(lds, Q, KV, KR, MIX, (size_t)b * SEGL, (size_t)b * SEGL, CTXL / 64, h, tid);
  }
}

constexpr int RT_STR = 136, RT_VSTR = 72;
constexpr int RT_QS = 0, RT_KS = 128 * RT_STR * 2, RT_VS = 2 * RT_KS, RT_ST = RT_VS + 128 * RT_VSTR * 2;
__device__ __forceinline__ u32x4 scale8(u32x4 v, float f) {
  u32x4 o; o.x = cvtpk(bflo(v.x) * f, bfhi(v.x) * f); o.y = cvtpk(bflo(v.y) * f, bfhi(v.y) * f); o.z = cvtpk(bflo(v.z) * f, bfhi(v.z) * f); o.w = cvtpk(bflo(v.w) * f, bfhi(v.w) * f); return o;
}
__device__ __forceinline__ void ret_unit(LAS unsigned char* lds, bf16_t* U, bf16_t* OF, int b, int h, int sl, const int tid, const bool dry) {
  const int lane = tid & 63, wid = tid >> 6, c16 = lane & 15, quad = lane >> 4, tq = (lane & 15) >> 2, tp = lane & 3;
  LAS bf16_t* Qs = (LAS bf16_t*)(lds + RT_QS); LAS bf16_t* Ks = (LAS bf16_t*)(lds + RT_KS); LAS bf16_t* Vs = (LAS bf16_t*)(lds + RT_VS); LAS bf16_t* St = (LAS bf16_t*)(lds + RT_ST);
  const size_t rowb = (size_t)b * SEGL;
  const int n = 16 * wid + c16;
  for (int dir = 0; dir < 2; ++dir) {
    const int hh = dir ? (7 - h) : h;
    const float lg = log2f(1.0f - exp2f(-5.0f - (float)hh));
    const float gC = exp2f(lg * 128.f), g1 = exp2f(lg), g127 = exp2f(lg * 127.f);
    const float dq = dir ? exp2f(lg * (float)(128 - n)) : exp2f(lg * (float)(n + 1));
    const float cn = dir ? exp2f(-lg * (float)n) : exp2f(lg * (float)n);
    float kf4[4];
#pragma unroll
    for (int i = 0; i < 4; ++i) { const int row = (tid + 512 * i) >> 4; kf4[i] = dir ? exp2f(lg * (float)row) : exp2f(-lg * (float)row); }
    f32x4 st[4];
#pragma unroll
    for (int eb = 0; eb < 4; ++eb) st[eb] = (f32x4){0.f, 0.f, 0.f, 0.f};
    u32x4 rq[4], rk[4], rv[2];
    { const int c0 = dir ? 1 : 0; const size_t row0 = rowb + (size_t)c0 * 128;
#pragma unroll
      for (int i = 0; i < 4; ++i) { const int idx = tid + 512 * i, row = idx >> 4, ch = idx & 15; const bf16_t* src = U + (row0 + row) * 4096 + h * 128 + ch * 8; rq[i] = *(const u32x4*)src; rk[i] = *(const u32x4*)(src + 1024); }
#pragma unroll
      for (int i = 0; i < 2; ++i) { const int idx = tid + 512 * i, row = idx >> 3, ch = idx & 7; rv[i] = *(const u32x4*)(U + (row0 + row) * 4096 + 2048 + h * 256 + sl * 64 + ch * 8); } }
    for (int step = 0; step < 66; ++step) {
      const int c = dir ? ((step < 2) ? (1 - step) : (67 - step)) : step;
      const size_t grow = rowb + (size_t)c * 128 + n;
      __syncthreads();
#pragma unroll
      for (int i = 0; i < 4; ++i) { const int idx = tid + 512 * i, row = idx >> 4, ch = idx & 15;
        *(LAS u32x4*)(Qs + row * RT_STR + ch * 8) = rq[i]; *(LAS u32x4*)(Ks + row * RT_STR + ch * 8) = scale8(rk[i], kf4[i]); }
#pragma unroll
      for (int i = 0; i < 2; ++i) { const int idx = tid + 512 * i, row = idx >> 3, ch = idx & 7; *(LAS u32x4*)(Vs + row * RT_VSTR + ch * 8) = rv[i]; }
#pragma unroll
      for (int eb = 0; eb < 4; ++eb)
#pragma unroll
        for (int r = 0; r < 4; ++r) St[(16 * eb + 4 * quad + r) * RT_STR + 16 * wid + c16] = f2bf(st[eb][r]);
      __syncthreads();
      if (step + 1 < 66) { const int s1 = step + 1; const int c1 = dir ? ((s1 < 2) ? (1 - s1) : (67 - s1)) : s1; const size_t r1 = rowb + (size_t)c1 * 128;
#pragma unroll
        for (int i = 0; i < 4; ++i) { const int idx = tid + 512 * i, row = idx >> 4, ch = idx & 15; const bf16_t* src = U + (r1 + row) * 4096 + h * 128 + ch * 8; rq[i] = *(const u32x4*)src; rk[i] = *(const u32x4*)(src + 1024); }
#pragma unroll
        for (int i = 0; i < 2; ++i) { const int idx = tid + 512 * i, row = idx >> 3, ch = idx & 7; rv[i] = *(const u32x4*)(U + (r1 + row) * 4096 + 2048 + h * 256 + sl * 64 + ch * 8); } }
      u32x2 fo[4];
      if (dir) { const bf16_t* ip = OF + grow * 2048 + h * 256 + sl * 64 + quad * 4;
#pragma unroll
        for (int eb = 0; eb < 4; ++eb) fo[eb] = *(const u32x2*)(ip + eb * 16); }
      bf16x8 qf[4];
#pragma unroll
      for (int ks = 0; ks < 4; ++ks) qf[ks] = *(const LAS bf16x8*)(Qs + n * RT_STR + ks * 32 + quad * 8);
      f32x4 o[4];
#pragma unroll
      for (int eb = 0; eb < 4; ++eb) { f32x4 a = (f32x4){0.f, 0.f, 0.f, 0.f};
#pragma unroll
        for (int ks = 0; ks < 4; ++ks) { const bf16x8 af = *(const LAS bf16x8*)(St + (16 * eb + c16) * RT_STR + ks * 32 + quad * 8); a = mfma16(af, qf[ks], a); }
        o[eb] = a * dq; }
      const float pre = dir ? gC : g1, post = dir ? 1.f : g127;
#pragma unroll
      for (int eb = 0; eb < 4; ++eb) st[eb] = st[eb] * pre;
#pragma unroll 4
      for (int s2 = 0; s2 < 4; ++s2) {
        const LAS bf16_t* vb = Vs + (32 * s2 + 4 * quad + tq) * RT_VSTR + 4 * tp;
        bf16x8 vf[4];
#pragma unroll
        for (int eb = 0; eb < 4; ++eb) { const u32x2 lo = tr_rd(vb + 16 * eb), hi = tr_rd(vb + 16 * RT_VSTR + 16 * eb); const u32x4 vv = (u32x4){lo.x, lo.y, hi.x, hi.y}; vf[eb] = __builtin_bit_cast(bf16x8, vv); }
        const bool needed = dir ? (2 * s2 + 1 >= wid) : (2 * s2 <= wid);
        if (needed) {
          float pw[8];
#pragma unroll
          for (int hf = 0; hf < 2; ++hf) { const int mb = 2 * s2 + hf; f32x4 a = (f32x4){0.f, 0.f, 0.f, 0.f};
#pragma unroll
            for (int ks = 0; ks < 4; ++ks) { const bf16x8 kf = *(const LAS bf16x8*)(Ks + (16 * mb + c16) * RT_STR + ks * 32 + quad * 8); a = mfma16(kf, qf[ks], a); }
#pragma unroll
            for (int r = 0; r < 4; ++r) { const int m = 16 * mb + 4 * quad + r; const bool keep = dir ? (m > n) : (n >= m); pw[4 * hf + r] = keep ? a[r] * cn : 0.f; } }
          u32x4 w; w.x = cvtpk(pw[0], pw[1]); w.y = cvtpk(pw[2], pw[3]); w.z = cvtpk(pw[4], pw[5]); w.w = cvtpk(pw[6], pw[7]);
          const bf16x8 pf = __builtin_bit_cast(bf16x8, w);
#pragma unroll
          for (int eb = 0; eb < 4; ++eb) o[eb] = mfma16(vf[eb], pf, o[eb]);
        }
        const LAS bf16_t* kb = Ks + (32 * s2 + 4 * quad + tq) * RT_STR + 16 * wid + 4 * tp;
        const u32x2 klo = tr_rd(kb), khi = tr_rd(kb + 16 * RT_STR);
        const u32x4 kk = (u32x4){klo.x, klo.y, khi.x, khi.y}; const bf16x8 bk = __builtin_bit_cast(bf16x8, kk);
#pragma unroll
        for (int eb = 0; eb < 4; ++eb) st[eb] = mfma16(vf[eb], bk, st[eb]);
      }
#pragma unroll
      for (int eb = 0; eb < 4; ++eb) st[eb] = st[eb] * post;
      if (dir == 0) { bf16_t* op = OF + grow * 2048 + h * 256 + sl * 64 + quad * 4;
#pragma unroll
        for (int eb = 0; eb < 4; ++eb) { u32x2 w; w.x = cvtpk(o[eb][0], o[eb][1]); w.y = cvtpk(o[eb][2], o[eb][3]); *(u32x2*)(op + eb * 16) = w; } }
      else { bf16_t* op = U + grow * 4096 + 2048 + h * 256 + sl * 64 + quad * 4;
#pragma unroll
        for (int eb = 0; eb < 4; ++eb) { u32x2 w; w.x = cvtpk(o[eb][0] + bflo(fo[eb].x), o[eb][1] + bfhi(fo[eb].x)); w.y = cvtpk(o[eb][2] + bflo(fo[eb].y), o[eb][3] + bfhi(fo[eb].y)); *(u32x2*)(op + eb * 16) = w; } }
    }
  }
}
__device__ __forceinline__ void ret_phase(const Params& p, LAS unsigned char* lds, const int tid, const int bid, const bool dry) {
  bf16_t* U = (bf16_t*)(p.ws + WS_B0); bf16_t* OF = (bf16_t*)(p.ws + WS_Y);
  for (int u = bid; u < 256; u += gridDim.x) { const int b = u & 7, rest = u >> 3, sl = rest & 3, h = rest >> 2; ret_unit(lds, U, OF, b, h, sl, tid, dry); }
}

#ifndef PHASE_MAP
#define PHASE_MAP(it) (it)
#define N_ITERS 38
#endif
#define RUN_GEMM(MODE, APTR, LDA_, BTPTR, N_, K_, OPTR, LDC_, COFF_, CS_, TAB_, SCALE_) do { const int skipc_ = ((L == 3 && s >= 4) || s == 8) ? 1 : 0; \
    pg8::Gemm g; g.A = (APTR); g.Bt = (BTPTR); g.M = T; g.N = (N_); g.K = (K_); g.lda = (LDA_); \
    Epi<MODE, LDC_, COFF_> E; E.O = (OPTR); E.cs = (CS_); E.tab = (TAB_); E.scale = (SCALE_); \
    pg8::StaticOrder S; S.init(T, (N_), G, (bid + G - rot_) % G, skipc_); \
    int tg_ = tid; asm volatile("" : "+v"(tg_)); \
    pg8::gemm_phase<Epi<MODE, LDC_, COFF_>, pg8::StaticOrder, true, true, K_, LDA_>(lds, g, S, E, tg_); \
    __syncthreads(); } while (0)
#define RUN_SPLIT(APTR, LDA_, BTPTR, LDB_, N_, KP_, NP_, OPTR) do { \
    pg8::Gemm g; g.A = (APTR); g.Bt = (BTPTR); g.M = T; g.N = (N_); g.K = (KP_); g.lda = (LDA_); \
    Epi<5, 1024, 0> E; E.O = (bf16_t*)(OPTR); E.cs = nullptr; E.tab = nullptr; E.scale = 1.f; \
    pg8::CtxSplitOrder S; S.init((N_), (NP_), G, bid); \
    int tg_ = tid; asm volatile("" : "+v"(tg_)); \
    pg8::gemm_phase<Epi<5, 1024, 0>, pg8::CtxSplitOrder, true, true, KP_, LDA_, LDB_>(lds, g, S, E, tg_); \
    __syncthreads(); } while (0)
__global__ void __launch_bounds__(NTHR, 2) mega(Params p_unused) {
  extern __shared__ __attribute__((aligned(16))) unsigned char lds_raw[];
  LAS unsigned char* lds = (LAS unsigned char*)lds_raw;
  const Params& p = *(const Params*)__builtin_amdgcn_kernarg_segment_ptr();
  const int G = gridDim.x;
  volatile LAS unsigned* bst = (volatile LAS unsigned*)(lds + LDS_BAR_OFF);
  if (threadIdx.x < 2) bst[threadIdx.x] = 0u;
  __syncthreads();
  const XcdBarrier bar = xcd_barrier_post((unsigned*)(p.ws + WS_BAR), bst);
  for (int it = p.lo; it < p.hi; ++it) {
    const int phc = PHASE_MAP(it); const int ph = phc & 63; const bool dry = (phc >> 6) != 0;
    if (it > p.lo + 1) { xcd_barrier(bar); }
    else if (it > p.lo) {
      asm volatile("s_waitcnt vmcnt(0) lgkmcnt(0)" ::: "memory");
      __syncthreads();
      if (threadIdx.x < 64) { __builtin_amdgcn_fence(__ATOMIC_RELEASE, "agent"); asm volatile("s_waitcnt vmcnt(0)" ::: "memory"); }
      cg::this_grid().sync();
      if (threadIdx.x < 64) { __builtin_amdgcn_fence(__ATOMIC_ACQUIRE, "agent"); asm volatile("s_waitcnt vmcnt(0)" ::: "memory"); }
      __syncthreads();
    }
    int tid = threadIdx.x; asm volatile("" : "+v"(tid));
    int bid = blockIdx.x; asm volatile("" : "+s"(bid));
    const int lane = tid & 63, wid = __builtin_amdgcn_readfirstlane(tid >> 6);
    const int gw = bid * NWAVE + wid, ngw = G * NWAVE;
    unsigned char* ws = p.ws;
    const float* mod = (const float*)(ws + WS_MOD);
    const float* tab = (const float*)(ws + WS_TAB);
    bf16_t* H = (bf16_t*)(ws + WS_H); bf16_t* B0 = (bf16_t*)(ws + WS_B0); bf16_t* Y = (bf16_t*)(ws + WS_Y);
    if (ph == 0) { p0_phase(p, lds, tid, bid); continue; }
    if (ph == 37) { norm_phase(p, false, true, true, p.g_ffn_post + 3 * DM, mod + (size_t)3 * 9 * 6144 + 5 * 1024, nullptr, nullptr, gw, ngw, lane); continue; }
    const int L = (ph - 1) / 9, s = (ph - 1) % 9, odd = L & 1, li = L >> 1;
    const float* modL = mod + (size_t)L * 9 * 6144;
    int rot_ = 0;
    if (s == 0) {
      conv_layer(p, L, lds, gw, ngw, wid, lane);
      norm_phase(p, L == 0, L > 0, false, p.g_ffn_post + (L > 0 ? (L - 1) : 0) * DM, mod + (size_t)(L > 0 ? (L - 1) : 0) * 9 * 6144 + 5 * 1024, p.g_mix_pre + L * DM, modL, gw, ngw, lane, false, (L > 0) ? (const float*)(ws + WS_YP) : nullptr);
      __syncthreads();
    }
    else if (s == 6) { norm_phase(p, false, true, false, p.g_mix_post + L * DM, modL + 2 * 1024, p.g_ffn_pre + L * DM, modL + 3 * 1024, gw, ngw, lane, dry); }
    else if (s == 7) { RUN_GEMM(1, H, 1024, (const bf16_t*)(ws + WS_WFF1), 4096, 1024, B0, 4096, 0, nullptr, tab, 1.f); }
    else if (s == 8) {
      RUN_GEMM(0, B0, 4096, (const bf16_t*)(ws + WS_WFF2), 1024, 4096, Y, 1024, 0, nullptr, tab, 1.f);
      if (L < 3) RUN_SPLIT(B0, 4096, (const bf16_t*)(ws + WS_WFF2), 4096, 1024, 512, 8, ws + WS_YP);
    }
    else if (!odd) {
      if (s == 1) { RUN_GEMM(0, H, 1024, (const bf16_t*)(ws + WS_WA), 1024, 1024, B0, 1024, 0, nullptr, tab, 1.f); }
      else if (s == 2) { mid_phase(p, li, gw, ngw, lane); }
      else if (s == 3) {
        RUN_GEMM(2, (const bf16_t*)(ws + WS_UQN), 256, (const bf16_t*)(ws + WS_WUQ), 768, 256, (bf16_t*)(ws + WS_Q), 768, 0, nullptr, tab, 0.10206207261596577f * 1.4426950408889634f);
        rot_ = 24;
        RUN_GEMM(0, (const bf16_t*)(ws + WS_UKVN), 128, (const bf16_t*)(ws + WS_WUKV), 1024, 256, (bf16_t*)(ws + WS_KV), 1024, 0, nullptr, tab, 1.f);
        rot_ = 56;
        RUN_GEMM(0, (const bf16_t*)(ws + WS_PD), 512, (const bf16_t*)(ws + WS_WPOOL), 512, 512, B0, 1024, 512, p.pool_scale + li * 512, tab, 1.f);
      }
      else if (s == 4) { attn_phase(p, lds, tid, bid); }
      else { RUN_GEMM(0, B0, 1024, (const bf16_t*)(ws + WS_WB), 1024, 1024, Y, 1024, 0, nullptr, tab, 1.f); }
    } else {
      if (s == 1) { RUN_GEMM(3, H, 1024, (const bf16_t*)(ws + WS_WA), 4096, 1024, B0, 4096, 0, nullptr, tab + 2048, 0.08838834764831845f); }
      else if (s == 2) { ret_phase(p, lds, tid, bid, dry); }
      else if (s == 3) { gn_phase(p, gw, ngw, lane); }
      else if (s == 4) { RUN_GEMM(4, H, 1024, (const bf16_t*)(ws + WS_WA) + (size_t)4096 * 1024, 2048, 1024, B0, 4096, 2048, nullptr, tab, 1.f); }
      else { RUN_GEMM(0, B0 + 2048, 4096, (const bf16_t*)(ws + WS_WB), 1024, 2048, Y, 1024, 0, nullptr, tab, 1.f); }
    }
  }
}

extern "C" void kernel_launch(void* const* d_in, const int* in_sizes, int n_in, void* d_out, int out_size, void* d_ws, size_t ws_size, hipStream_t stream) {
  static int grid = 0;
  if (grid == 0) {
    if (n_in != 22 || ws_size < WS_END) { fprintf(stderr, "kernel_launch: unexpected n_in %d or workspace %zu < %zu\n", n_in, ws_size, (size_t)WS_END); grid = -1; return; }
    int dev = 0, cus = 0, per_cu = 0;
    hipGetDevice(&dev); hipDeviceGetAttribute(&cus, hipDeviceAttributeMultiprocessorCount, dev);
    if (hipFuncSetAttribute((const void*)mega, hipFuncAttributeMaxDynamicSharedMemorySize, LDS_BYTES) != hipSuccess) { fprintf(stderr, "kernel_launch: hipFuncSetAttribute failed\n"); }
    if (hipOccupancyMaxActiveBlocksPerMultiprocessor(&per_cu, (const void*)mega, NTHR, LDS_BYTES) != hipSuccess || per_cu < 1) { fprintf(stderr, "kernel_launch: occupancy query gave %d\n", per_cu); per_cu = 1; }
    (void)hipGetLastError();
    grid = cus * 1;
  }
  if (grid < 0) return;
  if (hipMemsetAsync((char*)d_ws + WS_BAR, 0, XCD_BAR_WORDS * 4, stream) != hipSuccess) fprintf(stderr, "kernel_launch: memset of the barrier words failed\n");
  Params p{};
  const float** pp = (const float**)&p;
  for (int i = 0; i < 22; ++i) pp[i] = (const float*)d_in[i];
  p.out = (float*)d_out; p.ws = (unsigned char*)d_ws;
#ifndef N_SPLIT
  p.lo = 0; p.hi = N_ITERS;
  void* args[] = {&p};
  hipError_t e = hipLaunchCooperativeKernel((const void*)mega, dim3(grid), dim3(NTHR), args, LDS_BYTES, stream);
  if (e != hipSuccess) fprintf(stderr, "cooperative launch failed: %s (grid %d)\n", hipGetErrorString(e), grid);
#else
  for (int ph = 0; ph < 38; ++ph) { p.lo = ph; p.hi = ph + 1; hipLaunchKernelGGL(mega, dim3(grid), dim3(NTHR), LDS_BYTES, stream, p); }
#endif
}
```

```cpp
#include <hip/hip_runtime.h>
#include <hip/hip_cooperative_groups.h>
#include <cstdio>
#include <cstdint>
namespace cg = cooperative_groups;
namespace pg8 {
#define PG8_LAS __attribute__((address_space(3)))
typedef unsigned short bf16_t;
typedef short bf16x8 __attribute__((ext_vector_type(8)));
typedef float f32x4 __attribute__((ext_vector_type(4)));
typedef unsigned u32x4 __attribute__((ext_vector_type(4)));
constexpr int BM = 256, BK = 64, HALF = 128, HTB = HALF * BK * 2  , STAGE_BYTES = 8 * HTB, NXCD = 8, WGM = 8;

__host__ __device__ __forceinline__ int lds_byte(int r, int c) { const int st = (r >> 4) * 2 + (c >> 5), rr = r & 15, cc = c & 31, ob = rr * 64 + cc * 2; return st * 1024 + (ob ^ (((ob >> 9) & 1) << 5)); }
__host__ __device__ __forceinline__ void stage_rc(int b, int& R, int& C) { const int st = b / 1024, sb = b % 1024, swz = sb ^ (((sb >> 9) & 1) << 5); R = (st >> 1) * 16 + swz / 64; C = (st & 1) * 32 + (swz % 64) / 2; }
__host__ __device__ __forceinline__ int perm32(int rho) { const int n = rho >> 4, i = rho & 15; return 8 * (i >> 2) + 4 * n + (i & 3); }

struct Unit { int pm, pn, kp; };
struct Gemm { const bf16_t* A; const bf16_t* Bt; int M, N, K, lda; };

struct StaticOrder {
    int nM, nN, nwg, G, c, skip;
    __host__ __device__ void init(int M, int N, int G_, int c_, int skip_ = 0) { skip = skip_; nM = skip_ ? (M / BM / 33) * 32 : M / BM; nN = N / BM; nwg = nM * nN; G = G_; c = c_; }
    __host__ __device__ bool next(int i, Unit& u) const {
        const long L = (long)i * G + c; if (L >= nwg) return false;
        int wgid = (int)L; { const int q = nwg / NXCD, r = nwg % NXCD, xcd = wgid % NXCD, off = wgid / NXCD; wgid = (xcd < r ? xcd * (q + 1) : r * (q + 1) + (xcd - r) * q) + off; }
        const int nig = WGM * nN, gid = wgid / nig, fm = gid * WGM, gsz = (nM - fm) < WGM ? (nM - fm) : WGM;
        u.kp = 0; u.pm = fm + ((wgid % nig) % gsz); u.pn = (wgid % nig) / gsz; if (skip) u.pm = (u.pm >> 5) * 33 + 1 + (u.pm & 31); return true;
    }
    __device__ __forceinline__ void a_ready(const Unit&) const {}
    __device__ __forceinline__ void done(const Unit&) const {}
};

struct CtxSplitOrder {
    int nN, NP, G, c;
    __host__ __device__ void init(int N, int NP_, int G_, int c_) { nN = N / BM; NP = NP_; G = G_; c = c_; }
    __host__ __device__ bool next(int i, Unit& u) const {
        const int L = i * G + c; if (L >= 8 * nN * NP) return false;
        u.kp = L % NP; const int rest = L / NP; u.pn = rest % nN; u.pm = (rest / nN) * 33; return true;
    }
    __device__ __forceinline__ void a_ready(const Unit&) const {}
    __device__ __forceinline__ void done(const Unit&) const {}
};

template <class Epi, class Sched, bool ALIGN_EPI, bool SP2, int KC, int LDAC, int LDBC = KC>
__device__ __forceinline__ void gemm_phase(PG8_LAS unsigned char* lds, const Gemm g, const Sched& S, const Epi& E, const int tid) {
    const int wid = __builtin_amdgcn_readfirstlane(tid >> 6), lane = tid & 63, wr = wid >> 2, wc = wid & 3, fr = lane & 15, fq = lane >> 4;
    constexpr int K = KC, nt = K / BK;
    unsigned voffA[2], voffB[2];
#pragma unroll
    for (int i = 0; i < 2; ++i) { int R, C; stage_rc(tid * 16 + i * 8192, R, C); const int Rb = Epi::PERM ? ((R & ~31) + perm32(R & 31)) : R;
        voffA[i] = (unsigned)(R * LDAC + C) * 2u; voffB[i] = (unsigned)(Rb * LDBC + C) * 2u; }
    const size_t kstep = (size_t)(BK * 2);
    const size_t hstepA = (size_t)HALF * LDAC * 2, hstepB = (size_t)HALF * LDBC * 2;
    const size_t tstepA = 2 * hstepA, tstepB = 2 * hstepB;
    const unsigned ldsw = (unsigned)wid * 1024u;
    const int aoff = lds_byte(wr * 64 + fr, fq * 8), boff = lds_byte(wc * 32 + fr, fq * 8);
#define PG8_SA(b, h) (((b) * 2 + (h)) * HTB)
#define PG8_SB(b, h) ((4 + (b) * 2 + (h)) * HTB)
#define PG8_STAGE(bufoff, gbase, voff) do { _Pragma("unroll") for (int _i = 0; _i < 2; ++_i) \
        __builtin_amdgcn_global_load_lds((const unsigned*)((const char*)(gbase) + (voff)[_i]), (PG8_LAS unsigned*)(lds + (bufoff) + ldsw + _i * 8192), 16, 0, 0); } while (0)
#define PG8_LDA(dst, b, h) do { _Pragma("unroll") for (int m = 0; m < 4; ++m) _Pragma("unroll") for (int k = 0; k < 2; ++k) dst[m][k] = *(const PG8_LAS bf16x8*)(lds + PG8_SA(b, h) + aoff + m * 2048 + k * 1024); } while (0)
#define PG8_LDB(dst, b, h) do { _Pragma("unroll") for (int n = 0; n < 2; ++n) _Pragma("unroll") for (int k = 0; k < 2; ++k) dst[n][k] = *(const PG8_LAS bf16x8*)(lds + PG8_SB(b, h) + boff + n * 2048 + k * 1024); } while (0)
#define PG8_MMA(ai, bj, At, Bt) do { __builtin_amdgcn_s_setprio(1); _Pragma("unroll") for (int m = 0; m < 4; ++m) _Pragma("unroll") for (int n = 0; n < 2; ++n) _Pragma("unroll") for (int k = 0; k < 2; ++k) \
        acc[ai][bj][m][n] = __builtin_amdgcn_mfma_f32_16x16x32_bf16(Bt[n][k], At[m][k], acc[ai][bj][m][n], 0, 0, 0); __builtin_amdgcn_s_setprio(0); } while (0)
#define PG8_WAIT_V(n) asm volatile("s_waitcnt vmcnt(" #n ")" ::: "memory")
#define PG8_WAIT_L(n) asm volatile("s_waitcnt lgkmcnt(" #n ")" ::: "memory")
#define PG8_BAR __builtin_amdgcn_s_barrier()
#define PG8_SCHED __builtin_amdgcn_sched_barrier(0)
    Unit cur, nxt; int ui = 0;
    if (!S.next(0, cur)) return;
    f32x4 acc[2][2][4][2];
#pragma unroll
    for (int a = 0; a < 2; ++a)
#pragma unroll
        for (int b = 0; b < 2; ++b)
#pragma unroll
            for (int m = 0; m < 4; ++m)
#pragma unroll
                for (int n = 0; n < 2; ++n) acc[a][b][m][n] = (f32x4){0.f, 0.f, 0.f, 0.f};
    bf16x8 At[4][2], B0[2][2], B1[2][2];
    const char* cA = (const char*)g.A + (size_t)cur.pm * tstepA + (size_t)cur.kp * (K * 2); const char* cB = (const char*)g.Bt + (size_t)cur.pn * tstepB + (size_t)cur.kp * (K * 2);
    S.a_ready(cur);
    if constexpr (SP2) {
        PG8_STAGE(PG8_SB(0, 0), cB, voffB); PG8_STAGE(PG8_SB(0, 1), cB + hstepB, voffB); PG8_STAGE(PG8_SA(0, 0), cA, voffA); PG8_STAGE(PG8_SA(0, 1), cA + hstepA, voffA);
        if (wr == 1) PG8_BAR;
        PG8_WAIT_V(2); PG8_BAR;
        PG8_STAGE(PG8_SB(1, 0), cB + kstep, voffB); PG8_STAGE(PG8_SA(1, 0), cA + kstep, voffA); PG8_STAGE(PG8_SB(1, 1), cB + hstepB + kstep, voffB);
        PG8_WAIT_V(6); PG8_BAR;
    } else {
        PG8_STAGE(PG8_SB(0, 0), cB, voffB); PG8_STAGE(PG8_SA(0, 0), cA, voffA); PG8_STAGE(PG8_SB(0, 1), cB + hstepB, voffB); PG8_STAGE(PG8_SA(0, 1), cA + hstepA, voffA);
        if (wr == 1) PG8_BAR;
        PG8_WAIT_V(4); PG8_BAR;
        PG8_STAGE(PG8_SB(1, 0), cB + kstep, voffB); PG8_STAGE(PG8_SA(1, 0), cA + kstep, voffA); PG8_STAGE(PG8_SB(1, 1), cB + hstepB + kstep, voffB);
        PG8_WAIT_V(6); PG8_BAR;
    }
    for (;;) {
        const bool has_next = S.next(ui + 1, nxt);
        const char* nA = has_next ? (const char*)g.A + (size_t)nxt.pm * tstepA + (size_t)nxt.kp * (K * 2) : cA; const char* nB = has_next ? (const char*)g.Bt + (size_t)nxt.pn * tstepB + (size_t)nxt.kp * (K * 2) : cB;
#pragma nounroll
        for (int t = 0; t < nt; t += 2) {
            const bool last = (t == nt - 2);
            const char* a1 = cA + (size_t)(t + 1) * kstep;
            const char* a2 = last ? nA : cA + (size_t)(t + 2) * kstep; const char* b2 = last ? nB : cB + (size_t)(t + 2) * kstep;
            const char* a3 = a2 + kstep; const char* b3 = b2 + kstep;
            if (last && has_next) S.a_ready(nxt);
            if constexpr (SP2) {
            PG8_LDB(B0, 0, 0); PG8_LDB(B1, 0, 1); PG8_SCHED; PG8_LDA(At, 0, 0); PG8_STAGE(PG8_SA(1, 1), a1 + hstepA, voffA);
            PG8_WAIT_V(8); PG8_WAIT_L(0); PG8_BAR; PG8_MMA(0, 0, At, B0); PG8_MMA(0, 1, At, B1); PG8_BAR; PG8_SCHED;
            PG8_LDA(At, 0, 1); PG8_STAGE(PG8_SB(0, 0), b2, voffB); PG8_STAGE(PG8_SB(0, 1), b2 + hstepB, voffB); PG8_STAGE(PG8_SA(0, 0), a2, voffA);
            PG8_WAIT_V(8); PG8_WAIT_L(0); PG8_BAR; PG8_MMA(1, 0, At, B0); PG8_MMA(1, 1, At, B1); PG8_BAR; PG8_SCHED;
            PG8_LDB(B0, 1, 0); PG8_LDB(B1, 1, 1); PG8_SCHED; PG8_LDA(At, 1, 0); PG8_STAGE(PG8_SA(0, 1), a2 + hstepA, voffA);
            PG8_WAIT_V(8); PG8_WAIT_L(0); PG8_BAR; PG8_MMA(0, 0, At, B0); PG8_MMA(0, 1, At, B1); PG8_BAR; PG8_SCHED;
            PG8_LDA(At, 1, 1); PG8_STAGE(PG8_SB(1, 0), b3, voffB); PG8_STAGE(PG8_SB(1, 1), b3 + hstepB, voffB); PG8_STAGE(PG8_SA(1, 0), a3, voffA);
            PG8_WAIT_V(8); PG8_WAIT_L(0); PG8_BAR; PG8_MMA(1, 0, At, B0); PG8_MMA(1, 1, At, B1); PG8_BAR; PG8_SCHED;
            } else {
            PG8_LDB(B0, 0, 0); PG8_SCHED; PG8_LDA(At, 0, 0); PG8_STAGE(PG8_SA(1, 1), a1 + hstepA, voffA);
            PG8_WAIT_L(8); PG8_BAR; PG8_WAIT_L(0); PG8_MMA(0, 0, At, B0); PG8_BAR; PG8_SCHED;
            PG8_LDB(B1, 0, 1); PG8_STAGE(PG8_SB(0, 0), b2, voffB);
            PG8_BAR; PG8_WAIT_L(0); PG8_MMA(0, 1, At, B1); PG8_BAR;
            PG8_LDA(At, 0, 1); PG8_STAGE(PG8_SA(0, 0), a2, voffA);
            PG8_BAR; PG8_WAIT_L(0); PG8_MMA(1, 0, At, B0); PG8_BAR; PG8_SCHED;
            PG8_STAGE(PG8_SB(0, 1), b2 + hstepB, voffB);
            PG8_WAIT_V(6); PG8_BAR; PG8_MMA(1, 1, At, B1); PG8_BAR;
            PG8_LDB(B0, 1, 0); PG8_SCHED; PG8_LDA(At, 1, 0); PG8_STAGE(PG8_SA(0, 1), a2 + hstepA, voffA);
            PG8_WAIT_L(8); PG8_BAR; PG8_WAIT_L(0); PG8_MMA(0, 0, At, B0); PG8_BAR; PG8_SCHED;
            PG8_LDB(B1, 1, 1); PG8_STAGE(PG8_SB(1, 0), b3, voffB);
            PG8_BAR; PG8_WAIT_L(0); PG8_MMA(0, 1, At, B1); PG8_BAR;
            PG8_LDA(At, 1, 1); PG8_STAGE(PG8_SA(1, 0), a3, voffA);
            PG8_BAR; PG8_WAIT_L(0); PG8_MMA(1, 0, At, B0); PG8_BAR; PG8_SCHED;
            PG8_STAGE(PG8_SB(1, 1), b3 + hstepB, voffB);
            PG8_WAIT_V(6); PG8_BAR; PG8_MMA(1, 1, At, B1); PG8_BAR;
            }
        }
        if constexpr (ALIGN_EPI) { if (wr == 0) PG8_BAR; }
        if constexpr (!Epi::AFTER_DRAIN) { int te = tid; asm volatile("" : "+v"(te)); E(acc, cur, wr, wc, te & 15, (te & 63) >> 4); S.done(cur); }
        if (!has_next) break;
#pragma unroll
        for (int a = 0; a < 2; ++a)
#pragma unroll
            for (int b = 0; b < 2; ++b)
#pragma unroll
                for (int m = 0; m < 4; ++m)
#pragma unroll
                    for (int n = 0; n < 2; ++n) acc[a][b][m][n] = (f32x4){0.f, 0.f, 0.f, 0.f};
        cur = nxt; cA = nA; cB = nB; ++ui;
        if constexpr (ALIGN_EPI) { if (wr == 1) PG8_BAR; }
    }
    PG8_WAIT_V(0);
    if constexpr (!ALIGN_EPI) { if (wr == 0) PG8_BAR; }
    PG8_BAR;
    if constexpr (Epi::AFTER_DRAIN) { E.fused(acc, cur, wr, wc, fr, fq, lds, wid, lane); S.done(cur); }
#undef PG8_SA
#undef PG8_SB
#undef PG8_STAGE
#undef PG8_LDA
#undef PG8_LDB
#undef PG8_MMA
#undef PG8_WAIT_V
#undef PG8_WAIT_L
#undef PG8_BAR
#undef PG8_SCHED
}
}


#define LAS __attribute__((address_space(3)))
typedef unsigned short bf16_t;
typedef short bf16x8 __attribute__((ext_vector_type(8)));
typedef float f32x4 __attribute__((ext_vector_type(4)));
typedef unsigned u32x4 __attribute__((ext_vector_type(4)));
typedef unsigned u32x2 __attribute__((ext_vector_type(2)));
typedef float f32x2_t __attribute__((ext_vector_type(2)));
typedef __bf16 bf16x2_t __attribute__((ext_vector_type(2)));

constexpr int DM = 1024, NB = 8, SEQL = 8192, CTXL = 256, SEGL = SEQL + CTXL  , T = NB * SEGL  ;
constexpr int DFF = 4096, NTHR = 512, NWAVE = 8;
constexpr float EPS = 1e-6f;
constexpr size_t MiB = 1u << 20;
constexpr size_t WS_MOD = 0;
constexpr size_t WS_TAB = 1 * MiB;
constexpr size_t WS_XC = 2 * MiB;
constexpr size_t WS_WFF1 = 10 * MiB, WS_WFF2 = 18 * MiB, WS_WA = 26 * MiB, WS_WB = 38 * MiB;
constexpr size_t WS_WUQ = 28 * MiB, WS_WUKV = WS_WUQ + 512 * 1024, WS_WPOOL = 29 * MiB;
constexpr size_t WS_H = 46 * MiB;
constexpr size_t WS_B0 = 178 * MiB;
constexpr size_t WS_UQN = 310 * MiB, WS_UKVN = 343 * MiB, WS_KR = 360 * MiB, WS_PD = 365 * MiB, WS_Q = 431 * MiB, WS_KV = 530 * MiB;
constexpr size_t WS_Y = 706 * MiB;
constexpr size_t WS_YP = 838 * MiB;
constexpr size_t WS_END = 970 * MiB;
constexpr size_t WS_BAR = 900 * 1024;
constexpr int LDS_BAR_OFF = 141312;
constexpr int LDS_BYTES = 143360;

struct Params {
  const float *x, *c, *ctx, *c_ctx, *w_ada, *b_ada, *g_mix_pre, *g_mix_post, *g_ffn_pre, *g_ffn_post, *w_ffn_in, *w_ffn_out, *w_in_even, *g_q_lora, *g_kv_lora,
      *w_uq, *w_ukv, *w_pool, *pool_scale, *w_out_even, *w_in_odd, *w_out_odd;
  float* out; unsigned char* ws; int lo, hi;
};

__device__ __forceinline__ unsigned cvtpk(float lo, float hi) { f32x2_t v = {lo, hi}; bf16x2_t b = __builtin_convertvector(v, bf16x2_t); return __builtin_bit_cast(unsigned, b); }
__device__ __forceinline__ float bflo(unsigned u) { return __uint_as_float(u << 16); }
__device__ __forceinline__ float bfhi(unsigned u) { return __uint_as_float(u & 0xffff0000u); }
__device__ __forceinline__ bf16_t f2bf(float f) { return (bf16_t)(cvtpk(f, 0.f) & 0xffffu); }
__device__ __forceinline__ float wave_sum(float v) {
#pragma unroll
  for (int o = 1; o < 64; o <<= 1) v += __shfl_xor(v, o);
  return v;
}
__device__ __forceinline__ f32x4 mfma16(bf16x8 a, bf16x8 b, f32x4 c) { return __builtin_amdgcn_mfma_f32_16x16x32_bf16(a, b, c, 0, 0, 0); }

template <int mode, int ldc, int col_off> struct Epi {
  static constexpr bool PERM = true, AFTER_DRAIN = false;
  bf16_t* O; const float* cs; const float* tab; float scale;
  __device__ __forceinline__ void operator()(const f32x4 (&acc)[2][2][4][2], const pg8::Unit& u, int wr, int wc, int fr, int fq) const {
    const int seg = u.pm % 33; const bool islat = seg != 0;
    const int colt = u.pn * 256 + wc * 32 + 8 * fq;
    f32x4 tcm[4], tsm[4], tca[2], tsa[2]; u32x4 oldv[2][4][2]; bool rpart = false;
    if (mode == 3) {
      const int hc = colt & 127, g = (hc & 63) >> 3; rpart = (hc >> 6) != 0;
      if (u.pn < 8 && islat) {
#pragma unroll
        for (int m = 0; m < 4; ++m) { const int pos = m * 16 + fr; tcm[m] = *(const f32x4*)(tab + pos * 32 + 4 * g); tsm[m] = *(const f32x4*)(tab + 4096 + pos * 32 + 4 * g); }
#pragma unroll
        for (int ai = 0; ai < 2; ++ai) { const int pos = (seg - 1) * 4 + ai * 2 + wr; tca[ai] = *(const f32x4*)(tab + pos * 32 + 4 * g); tsa[ai] = *(const f32x4*)(tab + 4096 + pos * 32 + 4 * g); }
      }
    }
#pragma unroll
    for (int ai = 0; ai < 2; ++ai) {
      if (mode == 4) {
#pragma unroll
        for (int m = 0; m < 4; ++m)
#pragma unroll
          for (int bj = 0; bj < 2; ++bj) oldv[ai][m][bj] = *(const u32x4*)(O + (size_t)(u.pm * 256 + ai * 128 + wr * 64 + m * 16 + fr) * ldc + col_off + colt + bj * 128);
      }
#pragma unroll
      for (int m = 0; m < 4; ++m) {
        const int lrow = ai * 128 + wr * 64 + m * 16 + fr;
        const int row = u.pm * 256 + lrow;
        const int tok = (seg - 1) * 256 + lrow;
        bf16_t* rowp = O + (size_t)row * ldc + col_off;
#pragma unroll
        for (int bj = 0; bj < 2; ++bj) {
          const int c = colt + bj * 128;
          f32x4 v0 = acc[ai][bj][m][0], v1 = acc[ai][bj][m][1];
          if (mode == 5) {
            float* pp = (float*)O + ((size_t)(u.kp * 2048 + (u.pm / 33) * 256 + lrow) * 1024 + c);
            *(f32x4*)pp = v0; *(f32x4*)(pp + 4) = v1;
            continue;
          }
          if (mode == 1) {
#pragma unroll
            for (int i = 0; i < 4; ++i) { float a = fmaxf(v0[i], 0.f), b = fmaxf(v1[i], 0.f); v0[i] = a * a; v1[i] = b * b; }
          } else if (mode == 2) {
            const int hc = c % 96;
            if (islat && hc >= 64) {
              const int j = hc - 64, part = j >> 4, g = (j & 15) >> 3, pos = part ? (tok & 63) : (tok >> 6);
              const f32x4 cs4 = *(const f32x4*)(tab + pos * 8 + 4 * g), sn4 = *(const f32x4*)(tab + 1024 + pos * 8 + 4 * g);
              const f32x4 o0 = v0 * cs4 - v1 * sn4, o1 = v0 * sn4 + v1 * cs4; v0 = o0; v1 = o1;
            }
            v0 = v0 * scale; v1 = v1 * scale;
          } else if (mode == 3) {
            if (u.pn < 8) {
              if (islat) {
                const f32x4 cs4 = rpart ? tcm[m] : tca[ai], sn4 = rpart ? tsm[m] : tsa[ai];
                const f32x4 o0 = v0 * cs4 - v1 * sn4, o1 = v0 * sn4 + v1 * cs4; v0 = o0; v1 = o1;
              }
              if (u.pn >= 4) { v0 = v0 * scale; v1 = v1 * scale; }
            }
          } else if (mode == 4) {
            const u32x4 old = oldv[ai][m][bj];
            const float ov[8] = {bflo(old.x), bfhi(old.x), bflo(old.y), bfhi(old.y), bflo(old.z), bfhi(old.z), bflo(old.w), bfhi(old.w)};
#pragma unroll
            for (int i = 0; i < 4; ++i) { const float a = v0[i], b = v1[i]; v0[i] = a / (1.f + __expf(-a)) * ov[i]; v1[i] = b / (1.f + __expf(-b)) * ov[4 + i]; }
          } else if (cs) {
            const f32x4 s0 = *(const f32x4*)(cs + c), s1 = *(const f32x4*)(cs + c + 4); v0 = v0 * s0; v1 = v1 * s1;
          }
          u32x4 w; w.x = cvtpk(v0[0], v0[1]); w.y = cvtpk(v0[2], v0[3]); w.z = cvtpk(v1[0], v1[1]); w.w = cvtpk(v1[2], v1[3]);
          *(u32x4*)(rowp + c) = w;
        }
      }
    }
  }
};

__device__ __forceinline__ int src_col(int n, int mode) {
  if (mode == 1) { const int hc = n % 96; if (hc >= 64) { const int j = (hc - 64) & 15, g = j >> 3, i = j & 7; return n - j + ((i < 4) ? 4 * g + i : 8 + 4 * g + (i - 4)); } return n; }
  if (mode == 2) { if (n < 2048) { const int j = n & 63, g = j >> 3, i = j & 7; return n - j + ((i < 4) ? 4 * g + i : 32 + 4 * g + (i - 4)); } return n; }
  return n;
}
__device__ __forceinline__ void tr_item(const float* W, int K, int N, bf16_t* WT, int ldk, int mode, LAS float* scr, int item, int lane) {
  const int nblk = N / 32, kb = item / nblk, nb = item % nblk, k0 = 64 * kb, n0 = 32 * nb;
  const int sc = src_col(n0 + (lane & 31), mode);
#pragma unroll 8
  for (int i = 0; i < 32; ++i) { const int kk = 2 * i + (lane >> 5); scr[kk * 33 + (lane & 31)] = W[(size_t)(k0 + kk) * N + sc]; }
  asm volatile("s_waitcnt lgkmcnt(0)" ::: "memory");
  const int c = lane & 7;
#pragma unroll
  for (int j = 0; j < 4; ++j) { const int n = (lane >> 3) + 8 * j; const LAS float* s = scr + (8 * c) * 33 + n;
    u32x4 o; o.x = cvtpk(s[0 * 33], s[1 * 33]); o.y = cvtpk(s[2 * 33], s[3 * 33]); o.z = cvtpk(s[4 * 33], s[5 * 33]); o.w = cvtpk(s[6 * 33], s[7 * 33]);
    *(u32x4*)(WT + (size_t)(n0 + n) * ldk + k0 + 8 * c) = o; }
  asm volatile("s_waitcnt lgkmcnt(0)" ::: "memory");
}
__device__ __forceinline__ void conv_mat(const float* W, int K, int N, bf16_t* WT, int mode, LAS float* scr, int gw, int ngw, int lane, int ldk = 0) {
  const int items = (K / 64) * (N / 32);
  for (int it = gw; it < items; it += ngw) tr_item(W, K, N, WT, ldk ? ldk : K, mode, scr, it, lane);
}
__device__ __forceinline__ void conv_pool(const float* Wp, bf16_t* WT, LAS float* scr, int gw, int ngw, int lane) {
  for (int it = gw; it < 8 * 16; it += ngw) {
    const int kb = it / 16, nb = it % 16, k0 = 64 * kb, n0 = 32 * nb, gk = k0 >> 7, gn = n0 >> 7;
    if (gk == gn) {
      const float* W = Wp + (size_t)gk * 128 * 128;
#pragma unroll 8
      for (int i = 0; i < 32; ++i) { const int kk = 2 * i + (lane >> 5); scr[kk * 33 + (lane & 31)] = W[(size_t)(k0 - gk * 128 + kk) * 128 + (n0 - gn * 128) + (lane & 31)]; }
    } else {
#pragma unroll 8
      for (int i = 0; i < 32; ++i) { const int kk = 2 * i + (lane >> 5); scr[kk * 33 + (lane & 31)] = 0.f; }
    }
    asm volatile("s_waitcnt lgkmcnt(0)" ::: "memory");
    const int c = lane & 7;
#pragma unroll
    for (int j = 0; j < 4; ++j) { const int n = (lane >> 3) + 8 * j; const LAS float* s = scr + (8 * c) * 33 + n;
      u32x4 o; o.x = cvtpk(s[0 * 33], s[1 * 33]); o.y = cvtpk(s[2 * 33], s[3 * 33]); o.z = cvtpk(s[4 * 33], s[5 * 33]); o.w = cvtpk(s[6 * 33], s[7 * 33]);
      *(u32x4*)(WT + (size_t)(n0 + n) * 512 + k0 + 8 * c) = o; }
    asm volatile("s_waitcnt lgkmcnt(0)" ::: "memory");
  }
}
__device__ __forceinline__ void conv_layer(const Params& p, int L, LAS unsigned char* lds, int gw, int ngw, int wid, int lane) {
  LAS float* scr = (LAS float*)(lds + wid * 16384);
  unsigned char* ws = p.ws; const int i = L >> 1;
  conv_mat(p.w_ffn_in + (size_t)L * DM * DFF, DM, DFF, (bf16_t*)(ws + WS_WFF1), 0, scr, gw, ngw, lane);
  conv_mat(p.w_ffn_out + (size_t)L * DFF * DM, DFF, DM, (bf16_t*)(ws + WS_WFF2), 0, scr, gw, ngw, lane);
  if ((L & 1) == 0) {
    conv_mat(p.w_in_even + (size_t)i * DM * 928, DM, 928, (bf16_t*)(ws + WS_WA), 0, scr, gw, ngw, lane);
    conv_mat(p.w_uq + (size_t)i * 256 * 768, 256, 768, (bf16_t*)(ws + WS_WUQ), 1, scr, gw, ngw, lane);
    conv_mat(p.w_ukv + (size_t)i * 128 * 1024, 128, 1024, (bf16_t*)(ws + WS_WUKV), 0, scr, gw, ngw, lane, 256);
    for (int e = gw * 64 + lane; e < 1024 * 16; e += ngw * 64) { const int n = e >> 4, c = e & 15; *(u32x4*)((bf16_t*)(ws + WS_WUKV) + (size_t)n * 256 + 128 + c * 8) = (u32x4){0u, 0u, 0u, 0u}; }
    conv_pool(p.w_pool + (size_t)i * 4 * 128 * 128, (bf16_t*)(ws + WS_WPOOL), scr, gw, ngw, lane);
    conv_mat(p.w_out_even + (size_t)i * 1024 * 1024, 1024, 1024, (bf16_t*)(ws + WS_WB), 0, scr, gw, ngw, lane);
  } else {
    conv_mat(p.w_in_odd + (size_t)i * DM * 6144, DM, 6144, (bf16_t*)(ws + WS_WA), 2, scr, gw, ngw, lane);
    conv_mat(p.w_out_odd + (size_t)i * 2048 * 1024, 2048, 1024, (bf16_t*)(ws + WS_WB), 0, scr, gw, ngw, lane);
  }
}

__device__ __forceinline__ void p0_phase(const Params& p, LAS unsigned char* lds, const int tid, const int bid) {
  const int G = gridDim.x, lane = tid & 63, wid = tid >> 6;
  float* mod = (float*)(p.ws + WS_MOD);
  LAS float* sc = (LAS float*)lds;
  LAS float* part = (LAS float*)(lds + 9 * 1024 * 4);
  for (int e = tid; e < 9 * 1024; e += NTHR) { const int r = e >> 10, k = e & 1023; const float v = (r < 8) ? p.c[r * DM + k] : p.c_ctx[k]; sc[e] = v / (1.f + expf(-v)); }
  __syncthreads();
  for (int it = bid; it < 4 * 96; it += G) {
    const int L = it / 96, col0 = (it % 96) * 64;
    float a0 = 0, a1 = 0, a2 = 0, a3 = 0, a4 = 0, a5 = 0, a6 = 0, a7 = 0, a8 = 0;
    const float* wp = p.w_ada + ((size_t)L * DM + wid * 128) * 6144 + col0 + lane;
    const LAS float* s0 = sc + wid * 128;
#pragma unroll 16
    for (int k = 0; k < 128; ++k) { const float w = wp[(size_t)k * 6144];
      a0 += s0[k] * w; a1 += s0[1024 + k] * w; a2 += s0[2048 + k] * w; a3 += s0[3072 + k] * w; a4 += s0[4096 + k] * w; a5 += s0[5120 + k] * w; a6 += s0[6144 + k] * w; a7 += s0[7168 + k] * w; a8 += s0[8192 + k] * w; }
    LAS float* pp = part + wid * 9 * 64 + lane;
    pp[0] = a0; pp[64] = a1; pp[128] = a2; pp[192] = a3; pp[256] = a4; pp[320] = a5; pp[384] = a6; pp[448] = a7; pp[512] = a8;
    __syncthreads();
    for (int e = tid; e < 9 * 64; e += NTHR) { const int r = e >> 6, cl = e & 63; float v = p.b_ada[L * 6144 + col0 + cl];
#pragma unroll
      for (int w = 0; w < 8; ++w) v += part[w * 9 * 64 + e];
      mod[((size_t)L * 9 + r) * 6144 + col0 + cl] = v; }
    __syncthreads();
  }
  float* tab = (float*)(p.ws + WS_TAB);
  for (int e = bid * NTHR + tid; e < 1024 + 4096; e += G * NTHR) {
    if (e < 1024) { const int pos = e >> 3, i = e & 7; const float fr = powf(10000.f, -(float)(2 * i) / 16.f), a = (float)pos * fr; tab[e] = cosf(a); tab[1024 + e] = sinf(a); }
    else { const int q = e - 1024, pos = q >> 5, i = q & 31; const float fr = powf(10000.f, -(float)(2 * i) / 64.f), a = (float)pos * fr; tab[2048 + q] = cosf(a); tab[2048 + 4096 + q] = sinf(a); }
  }
}

__device__ __forceinline__ const float* xrow_ptr(const float* xl, const float* xc, int r) {
  const int b = r / SEGL, w = r % SEGL;
  return (w < CTXL) ? xc + (size_t)(b * CTXL + w) * DM : xl + (size_t)(b * SEQL + (w - CTXL)) * DM;
}
__device__ __forceinline__ void norm_phase(const Params& p, bool first, bool has_res, bool final_, const float* gpost, const float* gate_mod  ,
                                            const float* gpre, const float* shsc_mod  , int gw, int ngw, int lane, bool dry = false, const float* ysplit = nullptr) {
  const bf16_t* Y = (const bf16_t*)(p.ws + WS_Y); bf16_t* H = (bf16_t*)(p.ws + WS_H); float* XC = (float*)(p.ws + WS_XC);
  const float* xl = first ? p.x : p.out; const float* xc = first ? p.ctx : XC;
  const int rbeg = gw, rend = T, rstep = ngw;
  if (rbeg >= rend) return;
  int cur_m = -1;
  f32x4 cres[4], ca[4], csh[4];
#pragma unroll
  for (int j = 0; j < 4; ++j) { cres[j] = (f32x4){0.f, 0.f, 0.f, 0.f}; ca[j] = cres[j]; csh[j] = cres[j]; }
  f32x4 nx[4]; u32x2 ny[4];
  { const float* xs = xrow_ptr(xl, xc, rbeg);
#pragma unroll
    for (int j = 0; j < 4; ++j) { nx[j] = __builtin_nontemporal_load(((const f32x4*)xs) + lane + 64 * j); ny[j] = has_res ? __builtin_nontemporal_load(((const u32x2*)(Y + (size_t)rbeg * DM)) + lane + 64 * j) : (u32x2){0u, 0u}; } }
  for (int r = rbeg; r < rend; r += rstep) {
    const int b = r / SEGL, w = r % SEGL; const bool isctx = w < CTXL;
    float* xd = (isctx ? XC + (size_t)(b * CTXL + w) * DM : p.out + (size_t)(b * SEQL + (w - CTXL)) * DM);
    const int mrow = isctx ? 8 : b;
    f32x4 v[4]; u32x2 yq[4];
#pragma unroll
    for (int j = 0; j < 4; ++j) { v[j] = nx[j]; yq[j] = ny[j]; }
    if (r + rstep < rend) { const float* xs = xrow_ptr(xl, xc, r + rstep);
#pragma unroll
      for (int j = 0; j < 4; ++j) { nx[j] = __builtin_nontemporal_load(((const f32x4*)xs) + lane + 64 * j); if (has_res) ny[j] = __builtin_nontemporal_load(((const u32x2*)(Y + (size_t)(r + rstep) * DM)) + lane + 64 * j); } }
    if (final_ && isctx) continue;
    if (mrow != cur_m) { cur_m = mrow;
#pragma unroll
      for (int j = 0; j < 4; ++j) {
        if (has_res) cres[j] = ((const f32x4*)gpost)[lane + 64 * j] * ((const f32x4*)(gate_mod + (size_t)mrow * 6144))[lane + 64 * j];
        if (!final_) { ca[j] = ((const f32x4*)gpre)[lane + 64 * j] * (((const f32x4*)(shsc_mod + (size_t)mrow * 6144 + 1024))[lane + 64 * j] + 1.f); csh[j] = ((const f32x4*)(shsc_mod + (size_t)mrow * 6144))[lane + 64 * j]; } } }
    if (has_res) {
      f32x4 y[4]; float ss = 0.f;
#pragma unroll
      for (int j = 0; j < 4; ++j) y[j] = (f32x4){bflo(yq[j].x), bfhi(yq[j].x), bflo(yq[j].y), bfhi(yq[j].y)};
      if (ysplit && isctx) {
        const float* yp = ysplit + (size_t)(b * CTXL + w) * DM;
#pragma unroll
        for (int j = 0; j < 4; ++j) y[j] = ((const f32x4*)yp)[lane + 64 * j];
#pragma unroll 1
        for (int k = 1; k < 8; ++k) {
#pragma unroll
          for (int j = 0; j < 4; ++j) y[j] = y[j] + ((const f32x4*)(yp + (size_t)k * 2048 * DM))[lane + 64 * j]; }
      }
#pragma unroll
      for (int j = 0; j < 4; ++j) ss += (y[j].x * y[j].x + y[j].y * y[j].y) + (y[j].z * y[j].z + y[j].w * y[j].w);
      const float rs = rsqrtf(wave_sum(ss) * (1.f / DM) + EPS);
#pragma unroll
      for (int j = 0; j < 4; ++j) v[j] = v[j] + cres[j] * (y[j] * rs);
    }
    if ((has_res || first) && !dry) {
#pragma unroll
      for (int j = 0; j < 4; ++j) __builtin_nontemporal_store(v[j], ((f32x4*)xd) + lane + 64 * j);
    }
    if (!final_) {
      float ss = 0.f;
#pragma unroll
      for (int j = 0; j < 4; ++j) ss += (v[j].x * v[j].x + v[j].y * v[j].y) + (v[j].z * v[j].z + v[j].w * v[j].w);
      const float rs = rsqrtf(wave_sum(ss) * (1.f / DM) + EPS);
#pragma unroll
      for (int j = 0; j < 4; ++j) { const f32x4 h = (v[j] * rs) * ca[j] + csh[j];
        u32x2 o; o.x = cvtpk(h.x, h.y); o.y = cvtpk(h.z, h.w); __builtin_nontemporal_store(o, ((u32x2*)(H + (size_t)r * DM)) + lane + 64 * j); }
    }
  }
}

__device__ __forceinline__ void mid_phase(const Params& p, int i, int gw, int ngw, int lane) {
  const bf16_t* U = (const bf16_t*)(p.ws + WS_B0); bf16_t* UQN = (bf16_t*)(p.ws + WS_UQN); bf16_t* UKVN = (bf16_t*)(p.ws + WS_UKVN); bf16_t* KR = (bf16_t*)(p.ws + WS_KR); bf16_t* PD = (bf16_t*)(p.ws + WS_PD);
  const float* tab = (const float*)(p.ws + WS_TAB);
  const float* gq = p.g_q_lora + i * 256; const float* gkv = p.g_kv_lora + i * 128;
  const f32x4 g4 = ((const f32x4*)gq)[lane]; const float gk0 = gkv[2 * lane], gk1 = gkv[2 * lane + 1];
  for (int r = gw; r < T; r += ngw) {
    const int w = r % SEGL; const bool isctx = w < CTXL; const int t = isctx ? w : w - CTXL, Lseg = isctx ? CTXL : SEQL;
    const bf16_t* ur = U + (size_t)r * 1024;
    const u32x2 qw = ((const u32x2*)ur)[lane];
    const unsigned kvw = ((const unsigned*)(ur + 256))[lane];
    const int j = lane & 31; const float val = bflo((unsigned)ur[384 + j]);
    const int part = j >> 4, jj = j & 15, isx2 = jj >> 3, fi = jj & 7;
    float cs = 1.f, sn = 0.f;
    if (!isctx) { const int pos = part ? (t & 63) : (t >> 6); cs = tab[pos * 8 + fi]; sn = tab[1024 + pos * 8 + fi]; }
    const int g = lane >> 4, wn = 2 << g; const int lo = max(t - (wn >> 1), 0), hi = min(t + wn - (wn >> 1), Lseg);
    float s[8] = {0, 0, 0, 0, 0, 0, 0, 0};
    const bf16_t* base = ur + 416 + lane * 8;
#pragma unroll
    for (int k = 0; k < 16; ++k) { const int q = t - 8 + k;
      if (q >= lo && q < hi) { const u32x4 d = *(const u32x4*)(base + (ptrdiff_t)(q - t) * 1024);
        s[0] += bflo(d.x); s[1] += bfhi(d.x); s[2] += bflo(d.y); s[3] += bfhi(d.y); s[4] += bflo(d.z); s[5] += bfhi(d.z); s[6] += bflo(d.w); s[7] += bfhi(d.w); } }
    const u32x4 own = *(const u32x4*)base;
    const float a0 = bflo(qw.x), a1 = bfhi(qw.x), a2 = bflo(qw.y), a3 = bfhi(qw.y);
    const float rsq = rsqrtf(wave_sum(a0 * a0 + a1 * a1 + a2 * a2 + a3 * a3) * (1.f / 256.f) + EPS);
    const float b0 = bflo(kvw), b1 = bfhi(kvw);
    const float rsk = rsqrtf(wave_sum(b0 * b0 + b1 * b1) * (1.f / 128.f) + EPS);
    const float pv = __shfl_xor(val, 8);
    const float ko = isx2 ? (pv * sn + val * cs) : (val * cs - pv * sn);
    const int dst = part * 16 + 8 * (fi >> 2) + (fi & 3) + 4 * isx2;
    const float inv = 1.f / (float)(hi - lo);
    { u32x2 o; o.x = cvtpk(a0 * rsq * g4.x, a1 * rsq * g4.y); o.y = cvtpk(a2 * rsq * g4.z, a3 * rsq * g4.w); ((u32x2*)(UQN + (size_t)r * 256))[lane] = o; }
    ((unsigned*)(UKVN + (size_t)r * 128))[lane] = cvtpk(b0 * rsk * gk0, b1 * rsk * gk1);
    if (lane < 32) KR[(size_t)r * 32 + dst] = f2bf(ko);
    { u32x4 o; o.x = cvtpk(s[0] * inv - bflo(own.x), s[1] * inv - bfhi(own.x)); o.y = cvtpk(s[2] * inv - bflo(own.y), s[3] * inv - bfhi(own.y));
      o.z = cvtpk(s[4] * inv - bflo(own.z), s[5] * inv - bfhi(own.z)); o.w = cvtpk(s[6] * inv - bflo(own.w), s[7] * inv - bfhi(own.w));
      *(u32x4*)(PD + (size_t)r * 512 + lane * 8) = o; }
  }
}

__device__ __forceinline__ void gn_phase(const Params& p, int gw, int ngw, int lane) {
  bf16_t* U = (bf16_t*)(p.ws + WS_B0);
  for (int r = gw; r < T; r += ngw) {
    bf16_t* rowp = U + (size_t)r * 4096 + 2048 + lane * 8;
    u32x4 d[4];
#pragma unroll
    for (int i = 0; i < 4; ++i) d[i] = *(const u32x4*)(rowp + i * 512);
#pragma unroll
    for (int i = 0; i < 4; ++i) {
      float v[8] = {bflo(d[i].x), bfhi(d[i].x), bflo(d[i].y), bfhi(d[i].y), bflo(d[i].z), bfhi(d[i].z), bflo(d[i].w), bfhi(d[i].w)};
      float s = ((v[0] + v[1]) + (v[2] + v[3])) + ((v[4] + v[5]) + (v[6] + v[7]));
#pragma unroll
      for (int o = 1; o < 32; o <<= 1) s += __shfl_xor(s, o);
      const float mu = s * (1.f / 256.f); float q = 0.f;
#pragma unroll
      for (int e2 = 0; e2 < 8; ++e2) { v[e2] -= mu; q += v[e2] * v[e2]; }
#pragma unroll
      for (int o = 1; o < 32; o <<= 1) q += __shfl_xor(q, o);
      const float rs = rsqrtf(q * (1.f / 256.f) + EPS);
      u32x4 w; w.x = cvtpk(v[0] * rs, v[1] * rs); w.y = cvtpk(v[2] * rs, v[3] * rs); w.z = cvtpk(v[4] * rs, v[5] * rs); w.w = cvtpk(v[6] * rs, v[7] * rs);
      *(u32x4*)(rowp + i * 512) = w;
    }
  }
}

#define XB_TMO      128
#define XB_XCNT(j)  (256  + 64 * (j))
#define XB_XSUB(j)  (1280 + 64 * (j))
#define XB_XGEN(j)  (2304 + 64 * (j))
#define XB_TOP      3328
#define XB_TOPGEN   3392
#define XCD_BAR_WORDS 3456
#define XB_SPIN_CAP (1u << 18)

__device__ __forceinline__ unsigned xb_ld(unsigned* p)              { return __hip_atomic_load(p, __ATOMIC_RELAXED, __HIP_MEMORY_SCOPE_AGENT); }
__device__ __forceinline__ unsigned xb_add(unsigned* p, unsigned v) { return __hip_atomic_fetch_add(p, v, __ATOMIC_RELAXED, __HIP_MEMORY_SCOPE_AGENT); }
__device__ __forceinline__ unsigned xb_xcc_id() { return (unsigned)__builtin_amdgcn_s_getreg((3 << 11) | 20) & 0xFu; }
#define XB_SPIN(cond, bar) do { unsigned _sp = 0; while (cond) { __builtin_amdgcn_s_sleep(1); \
    if ((++_sp & 255u) == 0u) { if (xb_ld(&(bar)[XB_TMO])) break; if (_sp > XB_SPIN_CAP) { atomicAdd(&(bar)[XB_TMO], 1u); break; } } } } while (0)

struct XcdBarrier {
    unsigned* bar; unsigned x;
    volatile LAS unsigned* st;
};

__device__ __forceinline__ XcdBarrier xcd_barrier_post(unsigned* bar, volatile LAS unsigned* st) {
    XcdBarrier b; b.bar = bar; b.x = xb_xcc_id(); b.st = st;
    if (threadIdx.x == 0) (void)xb_add(&bar[XB_XCNT(b.x)], 1u);
    return b;
}
__device__ __forceinline__ void xcd_barrier_complete(unsigned* bar, unsigned x, unsigned& nloc, unsigned& nx) {
    const unsigned G = gridDim.x * gridDim.y * gridDim.z;
    unsigned sum, cnt, mine, sp = 0u;
    for (;;) {
        sum = 0u; cnt = 0u; mine = 0u;
#pragma unroll
        for (unsigned j = 0; j < 16; ++j) { const unsigned c = xb_ld(&bar[XB_XCNT(j)]); sum += c; cnt += (c > 0u) ? 1u : 0u; mine = (j == x) ? c : mine; }
        if (sum == G) break;
        __builtin_amdgcn_s_sleep(1);
        if ((++sp & 255u) == 0u) { if (xb_ld(&bar[XB_TMO])) break; if (sp > XB_SPIN_CAP) { atomicAdd(&bar[XB_TMO], 1u); break; } }
    }
    nloc = mine > 0u ? mine : 1u; nx = cnt > 0u ? cnt : 1u;
}

__device__ __forceinline__ void xcd_barrier(const XcdBarrier& b) {
    asm volatile("s_waitcnt vmcnt(0)" ::: "memory");
    __syncthreads();
    if (threadIdx.x == 0) {
        unsigned* bar = b.bar;
        __builtin_amdgcn_s_waitcnt(0);
        unsigned nloc = b.st[0], nx = b.st[1];
        if (nloc == 0u) { xcd_barrier_complete(bar, b.x, nloc, nx); b.st[0] = nloc; b.st[1] = nx; }
        const unsigned old = xb_add(&bar[XB_XSUB(b.x)], 1u);
        const unsigned gen = old / nloc;
        if (old + 1u == (gen + 1u) * nloc) {
            __builtin_amdgcn_fence(__ATOMIC_RELEASE, "agent");
            asm volatile("s_waitcnt vmcnt(0)" ::: "memory");
            const unsigned og = xb_add(&bar[XB_TOP], 1u);
            const unsigned tg = og / nx;
            if (og + 1u == (tg + 1u) * nx) xb_add(&bar[XB_TOPGEN], 1u);
            else XB_SPIN(xb_ld(&bar[XB_TOPGEN]) == tg, bar);
            __builtin_amdgcn_fence(__ATOMIC_ACQUIRE, "agent");
            xb_add(&bar[XB_XGEN(b.x)], 1u);
            asm volatile("s_waitcnt vmcnt(0)" ::: "memory");
        } else {
            XB_SPIN(xb_ld(&bar[XB_XGEN(b.x)]) == gen, bar);
            __builtin_amdgcn_fence(__ATOMIC_ACQUIRE, "agent");
            asm volatile("s_waitcnt vmcnt(0)" ::: "memory");
        }
    }
    __syncthreads();
}

typedef short v4i16_t __attribute__((ext_vector_type(4)));
__device__ __forceinline__ u32x2 tr_rd(const LAS bf16_t* p) { return __builtin_bit_cast(u32x2, __builtin_amdgcn_ds_read_tr16_b64_v4i16((LAS v4i16_t*)p)); }
constexpr int AT_KSTR = 104, AT_VSTR = 72, AT_BUF = 64 * AT_KSTR * 2 + 64 * AT_VSTR * 2;
__device__ __forceinline__ void attn_stage(LAS unsigned char* buf, int tid, u32x4 rk, u32x4 rv, u32x4 rr) {
  LAS bf16_t* Ks = (LAS bf16_t*)buf; LAS bf16_t* Vs = (LAS bf16_t*)(buf + 64 * AT_KSTR * 2);
  const int skey = tid >> 3, sch = tid & 7;
  *(LAS u32x4*)(Ks + skey * AT_KSTR + sch * 8) = rk;
  if (tid < 256) { const int rkey = tid >> 2, rch = tid & 3; *(LAS u32x4*)(Ks + rkey * AT_KSTR + 64 + rch * 8) = rr; }
  *(LAS u32x4*)(Vs + skey * AT_VSTR + sch * 8) = rv;
}
__device__ __forceinline__ void attn_unit(LAS unsigned char* lds, const bf16_t* Q, const bf16_t* KV, const bf16_t* KR, bf16_t* MIX, size_t qrow0, size_t krow0, int ntiles, int h, const int tid) {
  const int lane = tid & 63, wid = tid >> 6, c16 = lane & 15, quad = lane >> 4, tq = (lane & 15) >> 2, tp = lane & 3;
  const bf16_t* gk = KV + (krow0 + (tid >> 3)) * 1024 + h * 128 + (tid & 7) * 8;
  const bf16_t* gr = KR + (krow0 + ((tid & 255) >> 2)) * 32 + (tid & 3) * 8;
  bf16x8 qf[2][3];
#pragma unroll
  for (int qb = 0; qb < 2; ++qb)
#pragma unroll
    for (int ks = 0; ks < 3; ++ks) qf[qb][ks] = *(const bf16x8*)(Q + (qrow0 + wid * 32 + qb * 16 + c16) * 768 + h * 96 + ks * 32 + quad * 8);
  f32x4 o[2][4];
#pragma unroll
  for (int qb = 0; qb < 2; ++qb)
#pragma unroll
    for (int eb = 0; eb < 4; ++eb) o[qb][eb] = (f32x4){0.f, 0.f, 0.f, 0.f};
  float mref[2] = {0.f, 0.f}; f32x4 lacc[2] = {(f32x4){0.f, 0.f, 0.f, 0.f}, (f32x4){0.f, 0.f, 0.f, 0.f}};
  const bf16x8 ones = (bf16x8){0x3F80, 0x3F80, 0x3F80, 0x3F80, 0x3F80, 0x3F80, 0x3F80, 0x3F80};
  u32x4 rk = *(const u32x4*)gk, rv = *(const u32x4*)(gk + 64), rr = (u32x4){0, 0, 0, 0};
  if (tid < 256) rr = *(const u32x4*)gr;
  __syncthreads();
  attn_stage(lds, tid, rk, rv, rr);
  __syncthreads();
  for (int t = 0; t < ntiles; ++t) {
    LAS unsigned char* buf = lds + (t & 1) * AT_BUF;
    const bool more = (t + 1 < ntiles);
    if (more) { const bf16_t* g2 = gk + (size_t)(t + 1) * 64 * 1024; rk = *(const u32x4*)g2; rv = *(const u32x4*)(g2 + 64); if (tid < 256) rr = *(const u32x4*)(gr + (size_t)(t + 1) * 64 * 32); }
    const LAS bf16_t* Ks = (const LAS bf16_t*)buf; const LAS bf16_t* Vs = (const LAS bf16_t*)(buf + 64 * AT_KSTR * 2);
    f32x4 s[4][2];
#pragma unroll
    for (int kb = 0; kb < 4; ++kb) {
      bf16x8 kf[3];
#pragma unroll
      for (int ks = 0; ks < 3; ++ks) kf[ks] = *(const LAS bf16x8*)(Ks + (kb * 16 + c16) * AT_KSTR + ks * 32 + quad * 8);
#pragma unroll
      for (int qb = 0; qb < 2; ++qb) { const float nm = -mref[qb]; f32x4 a = (f32x4){nm, nm, nm, nm};
#pragma unroll
        for (int ks = 0; ks < 3; ++ks) a = mfma16(kf[ks], qf[qb][ks], a);
        s[kb][qb] = a; }
    }
#pragma unroll
    for (int qb = 0; qb < 2; ++qb) {
      float mx = -1e30f;
#pragma unroll
      for (int kb = 0; kb < 4; ++kb) mx = fmaxf(fmaxf(fmaxf(s[kb][qb][0], s[kb][qb][1]), fmaxf(s[kb][qb][2], s[kb][qb][3])), mx);
      mx = fmaxf(mx, __shfl_xor(mx, 16)); mx = fmaxf(mx, __shfl_xor(mx, 32));
      if (t == 0 || __any(mx > 8.f)) {
        const float delta = (t == 0) ? mx : fmaxf(mx, 0.f), alpha = (t == 0) ? 1.f : __builtin_amdgcn_exp2f(-delta);
        mref[qb] += delta; lacc[qb] = lacc[qb] * alpha;
#pragma unroll
        for (int kb = 0; kb < 4; ++kb) s[kb][qb] = s[kb][qb] - delta;
#pragma unroll
        for (int eb = 0; eb < 4; ++eb) o[qb][eb] = o[qb][eb] * alpha;
      }
#pragma unroll
      for (int kb = 0; kb < 4; ++kb)
#pragma unroll
        for (int r = 0; r < 4; ++r) s[kb][qb][r] = __builtin_amdgcn_exp2f(s[kb][qb][r]);
    }
#pragma unroll
    for (int s2 = 0; s2 < 2; ++s2) {
      bf16x8 pf[2];
#pragma unroll
      for (int qb = 0; qb < 2; ++qb) { u32x4 w; w.x = cvtpk(s[2 * s2][qb][0], s[2 * s2][qb][1]); w.y = cvtpk(s[2 * s2][qb][2], s[2 * s2][qb][3]);
        w.z = cvtpk(s[2 * s2 + 1][qb][0], s[2 * s2 + 1][qb][1]); w.w = cvtpk(s[2 * s2 + 1][qb][2], s[2 * s2 + 1][qb][3]); pf[qb] = __builtin_bit_cast(bf16x8, w);
        lacc[qb] = mfma16(ones, pf[qb], lacc[qb]); }
      const LAS bf16_t* vb = Vs + (32 * s2 + 4 * quad + tq) * AT_VSTR + 4 * tp;
#pragma unroll
      for (int eb = 0; eb < 4; ++eb) {
        const u32x2 lo = tr_rd(vb + 16 * eb), hi = tr_rd(vb + 16 * AT_VSTR + 16 * eb);
        const u32x4 vv = (u32x4){lo.x, lo.y, hi.x, hi.y}; const bf16x8 vf = __builtin_bit_cast(bf16x8, vv);
#pragma unroll
        for (int qb = 0; qb < 2; ++qb) o[qb][eb] = mfma16(vf, pf[qb], o[qb][eb]);
      }
    }
    if (more) attn_stage(lds + ((t + 1) & 1) * AT_BUF, tid, rk, rv, rr);
    __syncthreads();
  }
#pragma unroll
  for (int qb = 0; qb < 2; ++qb) {
    const float inv = 1.f / lacc[qb][0];
    bf16_t* op = MIX + (qrow0 + wid * 32 + qb * 16 + c16) * 1024 + h * 64 + quad * 4;
#pragma unroll
    for (int eb = 0; eb < 4; ++eb) { u32x2 w; w.x = cvtpk(o[qb][eb][0] * inv, o[qb][eb][1] * inv); w.y = cvtpk(o[qb][eb][2] * inv, o[qb][eb][3] * inv); *(u32x2*)(op + eb * 16) = w; }
  }
}
__device__ __forceinline__ void attn_phase(const Params& p, LAS unsigned char* lds, const int tid, const int bid) {
  const bf16_t* Q = (const bf16_t*)(p.ws + WS_Q); const bf16_t* KV = (const bf16_t*)(p.ws + WS_KV); const bf16_t* KR = (const bf16_t*)(p.ws + WS_KR); bf16_t* MIX = (bf16_t*)(p.ws + WS_B0);
  const int G = gridDim.x;
  for (int u = bid; u < 2048; u += G) {
    const int b = u & 7, rest = u >> 3, qb = rest & 31, h = rest >> 5;
    attn_unit(lds, Q, KV, KR, MIX, (size_t)b * SEGL + CTXL + (size_t)qb * 256, (size_t)b * SEGL, SEGL / 64, h, tid);
  }
  for (int u = bid; u < 64; u += G) {
    const int b = u & 7, h = u >> 3;
    attn_unit(lds, Q, KV, KR, MIX, (size_t)b * SEGL, (size_t)b * SEGL, CTXL / 64, h, tid);
  }
}

constexpr int RT_STR = 136, RT_VSTR = 72;
constexpr int RT_QS = 0, RT_KS = 128 * RT_STR * 2, RT_VS = 2 * RT_KS, RT_ST = RT_VS + 128 * RT_VSTR * 2;
__device__ __forceinline__ u32x4 scale8(u32x4 v, float f) {
  u32x4 o; o.x = cvtpk(bflo(v.x) * f, bfhi(v.x) * f); o.y = cvtpk(bflo(v.y) * f, bfhi(v.y) * f); o.z = cvtpk(bflo(v.z) * f, bfhi(v.z) * f); o.w = cvtpk(bflo(v.w) * f, bfhi(v.w) * f); return o;
}
__device__ __forceinline__ void ret_unit(LAS unsigned char* lds, bf16_t* U, bf16_t* OF, int b, int h, int sl, const int tid, const bool dry) {
  const int lane = tid & 63, wid = tid >> 6, c16 = lane & 15, quad = lane >> 4, tq = (lane & 15) >> 2, tp = lane & 3;
  LAS bf16_t* Qs = (LAS bf16_t*)(lds + RT_QS); LAS bf16_t* Ks = (LAS bf16_t*)(lds + RT_KS); LAS bf16_t* Vs = (LAS bf16_t*)(lds + RT_VS); LAS bf16_t* St = (LAS bf16_t*)(lds + RT_ST);
  const size_t rowb = (size_t)b * SEGL;
  const int n = 16 * wid + c16;
  for (int dir = 0; dir < 2; ++dir) {
    const int hh = dir ? (7 - h) : h;
    const float lg = log2f(1.0f - exp2f(-5.0f - (float)hh));
    const float gC = exp2f(lg * 128.f), g1 = exp2f(lg), g127 = exp2f(lg * 127.f);
    const float dq = dir ? exp2f(lg * (float)(128 - n)) : exp2f(lg * (float)(n + 1));
    const float cn = dir ? exp2f(-lg * (float)n) : exp2f(lg * (float)n);
    float kf4[4];
#pragma unroll
    for (int i = 0; i < 4; ++i) { const int row = (tid + 512 * i) >> 4; kf4[i] = dir ? exp2f(lg * (float)row) : exp2f(-lg * (float)row); }
    f32x4 st[4];
#pragma unroll
    for (int eb = 0; eb < 4; ++eb) st[eb] = (f32x4){0.f, 0.f, 0.f, 0.f};
    u32x4 rq[4], rk[4], rv[2];
    { const int c0 = dir ? 1 : 0; const size_t row0 = rowb + (size_t)c0 * 128;
#pragma unroll
      for (int i = 0; i < 4; ++i) { const int idx = tid + 512 * i, row = idx >> 4, ch = idx & 15; const bf16_t* src = U + (row0 + row) * 4096 + h * 128 + ch * 8; rq[i] = *(const u32x4*)src; rk[i] = *(const u32x4*)(src + 1024); }
#pragma unroll
      for (int i = 0; i < 2; ++i) { const int idx = tid + 512 * i, row = idx >> 3, ch = idx & 7; rv[i] = *(const u32x4*)(U + (row0 + row) * 4096 + 2048 + h * 256 + sl * 64 + ch * 8); } }
    for (int step = 0; step < 66; ++step) {
      const int c = dir ? ((step < 2) ? (1 - step) : (67 - step)) : step;
      const size_t grow = rowb + (size_t)c * 128 + n;
      __syncthreads();
#pragma unroll
      for (int i = 0; i < 4; ++i) { const int idx = tid + 512 * i, row = idx >> 4, ch = idx & 15;
        *(LAS u32x4*)(Qs + row * RT_STR + ch * 8) = rq[i]; *(LAS u32x4*)(Ks + row * RT_STR + ch * 8) = scale8(rk[i], kf4[i]); }
#pragma unroll
      for (int i = 0; i < 2; ++i) { const int idx = tid + 512 * i, row = idx >> 3, ch = idx & 7; *(LAS u32x4*)(Vs + row * RT_VSTR + ch * 8) = rv[i]; }
#pragma unroll
      for (int eb = 0; eb < 4; ++eb)
#pragma unroll
        for (int r = 0; r < 4; ++r) St[(16 * eb + 4 * quad + r) * RT_STR + 16 * wid + c16] = f2bf(st[eb][r]);
      __syncthreads();
      if (step + 1 < 66) { const int s1 = step + 1; const int c1 = dir ? ((s1 < 2) ? (1 - s1) : (67 - s1)) : s1; const size_t r1 = rowb + (size_t)c1 * 128;
#pragma unroll
        for (int i = 0; i < 4; ++i) { const int idx = tid + 512 * i, row = idx >> 4, ch = idx & 15; const bf16_t* src = U + (r1 + row) * 4096 + h * 128 + ch * 8; rq[i] = *(const u32x4*)src; rk[i] = *(const u32x4*)(src + 1024); }
#pragma unroll
        for (int i = 0; i < 2; ++i) { const int idx = tid + 512 * i, row = idx >> 3, ch = idx & 7; rv[i] = *(const u32x4*)(U + (r1 + row) * 4096 + 2048 + h * 256 + sl * 64 + ch * 8); } }
      u32x2 fo[4];
      if (dir) { const bf16_t* ip = OF + grow * 2048 + h * 256 + sl * 64 + quad * 4;
#pragma unroll
        for (int eb = 0; eb < 4; ++eb) fo[eb] = *(const u32x2*)(ip + eb * 16); }
      bf16x8 qf[4];
#pragma unroll
      for (int ks = 0; ks < 4; ++ks) qf[ks] = *(const LAS bf16x8*)(Qs + n * RT_STR + ks * 32 + quad * 8);
      f32x4 o[4];
#pragma unroll
      for (int eb = 0; eb < 4; ++eb) { f32x4 a = (f32x4){0.f, 0.f, 0.f, 0.f};
#pragma unroll
        for (int ks = 0; ks < 4; ++ks) { const bf16x8 af = *(const LAS bf16x8*)(St + (16 * eb + c16) * RT_STR + ks * 32 + quad * 8); a = mfma16(af, qf[ks], a); }
        o[eb] = a * dq; }
      const float pre = dir ? gC : g1, post = dir ? 1.f : g127;
#pragma unroll
      for (int eb = 0; eb < 4; ++eb) st[eb] = st[eb] * pre;
#pragma unroll 4
      for (int s2 = 0; s2 < 4; ++s2) {
        const LAS bf16_t* vb = Vs + (32 * s2 + 4 * quad + tq) * RT_VSTR + 4 * tp;
        bf16x8 vf[4];
#pragma unroll
        for (int eb = 0; eb < 4; ++eb) { const u32x2 lo = tr_rd(vb + 16 * eb), hi = tr_rd(vb + 16 * RT_VSTR + 16 * eb); const u32x4 vv = (u32x4){lo.x, lo.y, hi.x, hi.y}; vf[eb] = __builtin_bit_cast(bf16x8, vv); }
        const bool needed = dir ? (2 * s2 + 1 >= wid) : (2 * s2 <= wid);
        if (needed) {
          float pw[8];
#pragma unroll
          for (int hf = 0; hf < 2; ++hf) { const int mb = 2 * s2 + hf; f32x4 a = (f32x4){0.f, 0.f, 0.f, 0.f};
#pragma unroll
            for (int ks = 0; ks < 4; ++ks) { const bf16x8 kf = *(const LAS bf16x8*)(Ks + (16 * mb + c16) * RT_STR + ks * 32 + quad * 8); a = mfma16(kf, qf[ks], a); }
#pragma unroll
            for (int r = 0; r < 4; ++r) { const int m = 16 * mb + 4 * quad + r; const bool keep = dir ? (m > n) : (n >= m); pw[4 * hf + r] = keep ? a[r] * cn : 0.f; } }
          u32x4 w; w.x = cvtpk(pw[0], pw[1]); w.y = cvtpk(pw[2], pw[3]); w.z = cvtpk(pw[4], pw[5]); w.w = cvtpk(pw[6], pw[7]);
          const bf16x8 pf = __builtin_bit_cast(bf16x8, w);
#pragma unroll
          for (int eb = 0; eb < 4; ++eb) o[eb] = mfma16(vf[eb], pf, o[eb]);
        }
        const LAS bf16_t* kb = Ks + (32 * s2 + 4 * quad + tq) * RT_STR + 16 * wid + 4 * tp;
        const u32x2 klo = tr_rd(kb), khi = tr_rd(kb + 16 * RT_STR);
        const u32x4 kk = (u32x4){klo.x, klo.y, khi.x, khi.y}; const bf16x8 bk = __builtin_bit_cast(bf16x8, kk);
#pragma unroll
        for (int eb = 0; eb < 4; ++eb) st[eb] = mfma16(vf[eb], bk, st[eb]);
      }
#pragma unroll
      for (int eb = 0; eb < 4; ++eb) st[eb] = st[eb] * post;
      if (dir == 0) { bf16_t* op = OF + grow * 2048 + h * 256 + sl * 64 + quad * 4;
#pragma unroll
        for (int eb = 0; eb < 4; ++eb) { u32x2 w; w.x = cvtpk(o[eb][0], o[eb][1]); w.y = cvtpk(o[eb][2], o[eb][3]); *(u32x2*)(op + eb * 16) = w; } }
      else { bf16_t* op = U + grow * 4096 + 2048 + h * 256 + sl * 64 + quad * 4;
#pragma unroll
        for (int eb = 0; eb < 4; ++eb) { u32x2 w; w.x = cvtpk(o[eb][0] + bflo(fo[eb].x), o[eb][1] + bfhi(fo[eb].x)); w.y = cvtpk(o[eb][2] + bflo(fo[eb].y), o[eb][3] + bfhi(fo[eb].y)); *(u32x2*)(op + eb * 16) = w; } }
    }
  }
}
__device__ __forceinline__ void ret_phase(const Params& p, LAS unsigned char* lds, const int tid, const int bid, const bool dry) {
  bf16_t* U = (bf16_t*)(p.ws + WS_B0); bf16_t* OF = (bf16_t*)(p.ws + WS_Y);
  for (int u = bid; u < 256; u += gridDim.x) { const int b = u & 7, rest = u >> 3, sl = rest & 3, h = rest >> 2; ret_unit(lds, U, OF, b, h, sl, tid, dry); }
}

#ifndef PHASE_MAP
#define PHASE_MAP(it) (it)
#define N_ITERS 38
#endif
#define RUN_GEMM(MODE, APTR, LDA_, BTPTR, N_, K_, OPTR, LDC_, COFF_, CS_, TAB_, SCALE_) do { const int skipc_ = ((L == 3 && s >= 4) || s == 8) ? 1 : 0; \
    pg8::Gemm g; g.A = (APTR); g.Bt = (BTPTR); g.M = T; g.N = (N_); g.K = (K_); g.lda = (LDA_); \
    Epi<MODE, LDC_, COFF_> E; E.O = (OPTR); E.cs = (CS_); E.tab = (TAB_); E.scale = (SCALE_); \
    pg8::StaticOrder S; S.init(T, (N_), G, (bid + G - rot_) % G, skipc_); \
    int tg_ = tid; asm volatile("" : "+v"(tg_)); \
    pg8::gemm_phase<Epi<MODE, LDC_, COFF_>, pg8::StaticOrder, true, true, K_, LDA_>(lds, g, S, E, tg_); \
    __syncthreads(); } while (0)
#define RUN_SPLIT(APTR, LDA_, BTPTR, LDB_, N_, KP_, NP_, OPTR) do { \
    pg8::Gemm g; g.A = (APTR); g.Bt = (BTPTR); g.M = T; g.N = (N_); g.K = (KP_); g.lda = (LDA_); \
    Epi<5, 1024, 0> E; E.O = (bf16_t*)(OPTR); E.cs = nullptr; E.tab = nullptr; E.scale = 1.f; \
    pg8::CtxSplitOrder S; S.init((N_), (NP_), G, bid); \
    int tg_ = tid; asm volatile("" : "+v"(tg_)); \
    pg8::gemm_phase<Epi<5, 1024, 0>, pg8::CtxSplitOrder, true, true, KP_, LDA_, LDB_>(lds, g, S, E, tg_); \
    __syncthreads(); } while (0)
__global__ void __launch_bounds__(NTHR, 2) mega(Params p_unused) {
  extern __shared__ __attribute__((aligned(16))) unsigned char lds_raw[];
  LAS unsigned char* lds = (LAS unsigned char*)lds_raw;
  const Params& p = *(const Params*)__builtin_amdgcn_kernarg_segment_ptr();
  const int G = gridDim.x;
  volatile LAS unsigned* bst = (volatile LAS unsigned*)(lds + LDS_BAR_OFF);
  if (threadIdx.x < 2) bst[threadIdx.x] = 0u;
  __syncthreads();
  const XcdBarrier bar = xcd_barrier_post((unsigned*)(p.ws + WS_BAR), bst);
  for (int it = p.lo; it < p.hi; ++it) {
    const int phc = PHASE_MAP(it); const int ph = phc & 63; const bool dry = (phc >> 6) != 0;
    if (it > p.lo + 1) { xcd_barrier(bar); }
    else if (it > p.lo) {
      asm volatile("s_waitcnt vmcnt(0) lgkmcnt(0)" ::: "memory");
      __syncthreads();
      if (threadIdx.x < 64) { __builtin_amdgcn_fence(__ATOMIC_RELEASE, "agent"); asm volatile("s_waitcnt vmcnt(0)" ::: "memory"); }
      cg::this_grid().sync();
      if (threadIdx.x < 64) { __builtin_amdgcn_fence(__ATOMIC_ACQUIRE, "agent"); asm volatile("s_waitcnt vmcnt(0)" ::: "memory"); }
      __syncthreads();
    }
    int tid = threadIdx.x; asm volatile("" : "+v"(tid));
    int bid = blockIdx.x; asm volatile("" : "+s"(bid));
    const int lane = tid & 63, wid = __builtin_amdgcn_readfirstlane(tid >> 6);
    const int gw = bid * NWAVE + wid, ngw = G * NWAVE;
    unsigned char* ws = p.ws;
    const float* mod = (const float*)(ws + WS_MOD);
    const float* tab = (const float*)(ws + WS_TAB);
    bf16_t* H = (bf16_t*)(ws + WS_H); bf16_t* B0 = (bf16_t*)(ws + WS_B0); bf16_t* Y = (bf16_t*)(ws + WS_Y);
    if (ph == 0) { p0_phase(p, lds, tid, bid); continue; }
    if (ph == 37) { norm_phase(p, false, true, true, p.g_ffn_post + 3 * DM, mod + (size_t)3 * 9 * 6144 + 5 * 1024, nullptr, nullptr, gw, ngw, lane); continue; }
    const int L = (ph - 1) / 9, s = (ph - 1) % 9, odd = L & 1, li = L >> 1;
    const float* modL = mod + (size_t)L * 9 * 6144;
    int rot_ = 0;
    if (s == 0) {
      conv_layer(p, L, lds, gw, ngw, wid, lane);
      norm_phase(p, L == 0, L > 0, false, p.g_ffn_post + (L > 0 ? (L - 1) : 0) * DM, mod + (size_t)(L > 0 ? (L - 1) : 0) * 9 * 6144 + 5 * 1024, p.g_mix_pre + L * DM, modL, gw, ngw, lane, false, (L > 0) ? (const float*)(ws + WS_YP) : nullptr);
      __syncthreads();
    }
    else if (s == 6) { norm_phase(p, false, true, false, p.g_mix_post + L * DM, modL + 2 * 1024, p.g_ffn_pre + L * DM, modL + 3 * 1024, gw, ngw, lane, dry); }
    else if (s == 7) { RUN_GEMM(1, H, 1024, (const bf16_t*)(ws + WS_WFF1), 4096, 1024, B0, 4096, 0, nullptr, tab, 1.f); }
    else if (s == 8) {
      RUN_GEMM(0, B0, 4096, (const bf16_t*)(ws + WS_WFF2), 1024, 4096, Y, 1024, 0, nullptr, tab, 1.f);
      if (L < 3) RUN_SPLIT(B0, 4096, (const bf16_t*)(ws + WS_WFF2), 4096, 1024, 512, 8, ws + WS_YP);
    }
    else if (!odd) {
      if (s == 1) { RUN_GEMM(0, H, 1024, (const bf16_t*)(ws + WS_WA), 1024, 1024, B0, 1024, 0, nullptr, tab, 1.f); }
      else if (s == 2) { mid_phase(p, li, gw, ngw, lane); }
      else if (s == 3) {
        RUN_GEMM(2, (const bf16_t*)(ws + WS_UQN), 256, (const bf16_t*)(ws + WS_WUQ), 768, 256, (bf16_t*)(ws + WS_Q), 768, 0, nullptr, tab, 0.10206207261596577f * 1.4426950408889634f);
        rot_ = 24;
        RUN_GEMM(0, (const bf16_t*)(ws + WS_UKVN), 128, (const bf16_t*)(ws + WS_WUKV), 1024, 256, (bf16_t*)(ws + WS_KV), 1024, 0, nullptr, tab, 1.f);
        rot_ = 56;
        RUN_GEMM(0, (const bf16_t*)(ws + WS_PD), 512, (const bf16_t*)(ws + WS_WPOOL), 512, 512, B0, 1024, 512, p.pool_scale + li * 512, tab, 1.f);
      }
      else if (s == 4) { attn_phase(p, lds, tid, bid); }
      else { RUN_GEMM(0, B0, 1024, (const bf16_t*)(ws + WS_WB), 1024, 1024, Y, 1024, 0, nullptr, tab, 1.f); }
    } else {
      if (s == 1) { RUN_GEMM(3, H, 1024, (const bf16_t*)(ws + WS_WA), 4096, 1024, B0, 4096, 0, nullptr, tab + 2048, 0.08838834764831845f); }
      else if (s == 2) { ret_phase(p, lds, tid, bid, dry); }
      else if (s == 3) { gn_phase(p, gw, ngw, lane); }
      else if (s == 4) { RUN_GEMM(4, H, 1024, (const bf16_t*)(ws + WS_WA) + (size_t)4096 * 1024, 2048, 1024, B0, 4096, 2048, nullptr, tab, 1.f); }
      else { RUN_GEMM(0, B0 + 2048, 4096, (const bf16_t*)(ws + WS_WB), 1024, 2048, Y, 1024, 0, nullptr, tab, 1.f); }
    }
  }
}

extern "C" void kernel_launch(void* const* d_in, const int* in_sizes, int n_in, void* d_out, int out_size, void* d_ws, size_t ws_size, hipStream_t stream) {
  static int grid = 0;
  if (grid == 0) {
    if (n_in != 22 || ws_size < WS_END) { fprintf(stderr, "kernel_launch: unexpected n_in %d or workspace %zu < %zu\n", n_in, ws_size, (size_t)WS_END); grid = -1; return; }
    int dev = 0, cus = 0, per_cu = 0;
    hipGetDevice(&dev); hipDeviceGetAttribute(&cus, hipDeviceAttributeMultiprocessorCount, dev);
    if (hipFuncSetAttribute((const void*)mega, hipFuncAttributeMaxDynamicSharedMemorySize, LDS_BYTES) != hipSuccess) { fprintf(stderr, "kernel_launch: hipFuncSetAttribute failed\n"); }
    if (hipOccupancyMaxActiveBlocksPerMultiprocessor(&per_cu, (const void*)mega, NTHR, LDS_BYTES) != hipSuccess || per_cu < 1) { fprintf(stderr, "kernel_launch: occupancy query gave %d\n", per_cu); per_cu = 1; }
    (void)hipGetLastError();
    grid = cus * 1;
  }
  if (grid < 0) return;
  if (hipMemsetAsync((char*)d_ws + WS_BAR, 0, XCD_BAR_WORDS * 4, stream) != hipSuccess) fprintf(stderr, "kernel_launch: memset of the barrier words failed\n");
  Params p{};
  const float** pp = (const float**)&p;
  for (int i = 0; i < 22; ++i) pp[i] = (const float*)d_in[i];
  p.out = (float*)d_out; p.ws = (unsigned char*)d_ws;
#ifndef N_SPLIT
  p.lo = 0; p.hi = N_ITERS;
  void* args[] = {&p};
  hipError_t e = hipLaunchCooperativeKernel((const void*)mega, dim3(grid), dim3(NTHR), args, LDS_BYTES, stream);
  if (e != hipSuccess) fprintf(stderr, "cooperative launch failed: %s (grid %d)\n", hipGetErrorString(e), grid);
#else
  for (int ph = 0; ph < 38; ++ph) { p.lo = ph; p.hi = ph + 1; hipLaunchKernelGGL(mega, dim3(grid), dim3(NTHR), LDS_BYTES, stream, p); }
#endif
}
```

```cpp
#include <hip/hip_runtime.h>
#include <hip/hip_cooperative_groups.h>
#include <cstdio>
#include <cstdint>
namespace cg = cooperative_groups;
namespace pg8 {
#define PG8_LAS __attribute__((address_space(3)))
typedef unsigned short bf16_t;
typedef short bf16x8 __attribute__((ext_vector_type(8)));
typedef float f32x4 __attribute__((ext_vector_type(4)));
typedef unsigned u32x4 __attribute__((ext_vector_type(4)));
constexpr int BM = 256, BK = 64, HALF = 128, HTB = HALF * BK * 2  , STAGE_BYTES = 8 * HTB, NXCD = 8, WGM = 8;

__host__ __device__ __forceinline__ int lds_byte(int r, int c) { const int st = (r >> 4) * 2 + (c >> 5), rr = r & 15, cc = c & 31, ob = rr * 64 + cc * 2; return st * 1024 + (ob ^ (((ob >> 9) & 1) << 5)); }
__host__ __device__ __forceinline__ void stage_rc(int b, int& R, int& C) { const int st = b / 1024, sb = b % 1024, swz = sb ^ (((sb >> 9) & 1) << 5); R = (st >> 1) * 16 + swz / 64; C = (st & 1) * 32 + (swz % 64) / 2; }
__host__ __device__ __forceinline__ int perm32(int rho) { const int n = rho >> 4, i = rho & 15; return 8 * (i >> 2) + 4 * n + (i & 3); }

struct Unit { int pm, pn, kp; };
struct Gemm { const bf16_t* A; const bf16_t* Bt; int M, N, K, lda; };

struct StaticOrder {
    int nM, nN, nwg, G, c, skip;
    __host__ __device__ void init(int M, int N, int G_, int c_, int skip_ = 0) { skip = skip_; nM = skip_ ? (M / BM / 33) * 32 : M / BM; nN = N / BM; nwg = nM * nN; G = G_; c = c_; }
    __host__ __device__ bool next(int i, Unit& u) const {
        const long L = (long)i * G + c; if (L >= nwg) return false;
        int wgid = (int)L; { const int q = nwg / NXCD, r = nwg % NXCD, xcd = wgid % NXCD, off = wgid / NXCD; wgid = (xcd < r ? xcd * (q + 1) : r * (q + 1) + (xcd - r) * q) + off; }
        const int nig = WGM * nN, gid = wgid / nig, fm = gid * WGM, gsz = (nM - fm) < WGM ? (nM - fm) : WGM;
        u.kp = 0; u.pm = fm + ((wgid % nig) % gsz); u.pn = (wgid % nig) / gsz; if (skip) u.pm = (u.pm >> 5) * 33 + 1 + (u.pm & 31); return true;
    }
    __device__ __forceinline__ void a_ready(const Unit&) const {}
    __device__ __forceinline__ void done(const Unit&) const {}
};

struct CtxSplitOrder {
    int nN, NP, G, c;
    __host__ __device__ void init(int N, int NP_, int G_, int c_) { nN = N / BM; NP = NP_; G = G_; c = c_; }
    __host__ __device__ bool next(int i, Unit& u) const {
        const int L = i * G + c; if (L >= 8 * nN * NP) return false;
        u.kp = L % NP; const int rest = L / NP; u.pn = rest % nN; u.pm = (rest / nN) * 33; return true;
    }
    __device__ __forceinline__ void a_ready(const Unit&) const {}
    __device__ __forceinline__ void done(const Unit&) const {}
};

template <class Epi, class Sched, bool ALIGN_EPI, bool SP2, int KC, int LDAC, int LDBC = KC>
__device__ __forceinline__ void gemm_phase(PG8_LAS unsigned char* lds, const Gemm g, const Sched& S, const Epi& E, const int tid) {
    const int wid = __builtin_amdgcn_readfirstlane(tid >> 6), lane = tid & 63, wr = wid >> 2, wc = wid & 3, fr = lane & 15, fq = lane >> 4;
    constexpr int K = KC, nt = K / BK;
    unsigned voffA[2], voffB[2];
#pragma unroll
    for (int i = 0; i < 2; ++i) { int R, C; stage_rc(tid * 16 + i * 8192, R, C); const int Rb = Epi::PERM ? ((R & ~31) + perm32(R & 31)) : R;
        voffA[i] = (unsigned)(R * LDAC + C) * 2u; voffB[i] = (unsigned)(Rb * LDBC + C) * 2u; }
    const size_t kstep = (size_t)(BK * 2);
    const size_t hstepA = (size_t)HALF * LDAC * 2, hstepB = (size_t)HALF * LDBC * 2;
    const size_t tstepA = 2 * hstepA, tstepB = 2 * hstepB;
    const unsigned ldsw = (unsigned)wid * 1024u;
    const int aoff = lds_byte(wr * 64 + fr, fq * 8), boff = lds_byte(wc * 32 + fr, fq * 8);
#define PG8_SA(b, h) (((b) * 2 + (h)) * HTB)
#define PG8_SB(b, h) ((4 + (b) * 2 + (h)) * HTB)
#define PG8_STAGE(bufoff, gbase, voff) do { _Pragma("unroll") for (int _i = 0; _i < 2; ++_i) \
        __builtin_amdgcn_global_load_lds((const unsigned*)((const char*)(gbase) + (voff)[_i]), (PG8_LAS unsigned*)(lds + (bufoff) + ldsw + _i * 8192), 16, 0, 0); } while (0)
#define PG8_LDA(dst, b, h) do { _Pragma("unroll") for (int m = 0; m < 4; ++m) _Pragma("unroll") for (int k = 0; k < 2; ++k) dst[m][k] = *(const PG8_LAS bf16x8*)(lds + PG8_SA(b, h) + aoff + m * 2048 + k * 1024); } while (0)
#define PG8_LDB(dst, b, h) do { _Pragma("unroll") for (int n = 0; n < 2; ++n) _Pragma("unroll") for (int k = 0; k < 2; ++k) dst[n][k] = *(const PG8_LAS bf16x8*)(lds + PG8_SB(b, h) + boff + n * 2048 + k * 1024); } while (0)
#define PG8_MMA(ai, bj, At, Bt) do { __builtin_amdgcn_s_setprio(1); _Pragma("unroll") for (int m = 0; m < 4; ++m) _Pragma("unroll") for (int n = 0; n < 2; ++n) _Pragma("unroll") for (int k = 0; k < 2; ++k) \
        acc[ai][bj][m][n] = __builtin_amdgcn_mfma_f32_16x16x32_bf16(Bt[n][k], At[m][k], acc[ai][bj][m][n], 0, 0, 0); __builtin_amdgcn_s_setprio(0); } while (0)
#define PG8_WAIT_V(n) asm volatile("s_waitcnt vmcnt(" #n ")" ::: "memory")
#define PG8_WAIT_L(n) asm volatile("s_waitcnt lgkmcnt(" #n ")" ::: "memory")
#define PG8_BAR __builtin_amdgcn_s_barrier()
#define PG8_SCHED __builtin_amdgcn_sched_barrier(0)
    Unit cur, nxt; int ui = 0;
    if (!S.next(0, cur)) return;
    f32x4 acc[2][2][4][2];
#pragma unroll
    for (int a = 0; a < 2; ++a)
#pragma unroll
        for (int b = 0; b < 2; ++b)
#pragma unroll
            for (int m = 0; m < 4; ++m)
#pragma unroll
                for (int n = 0; n < 2; ++n) acc[a][b][m][n] = (f32x4){0.f, 0.f, 0.f, 0.f};
    bf16x8 At[4][2], B0[2][2], B1[2][2];
    const char* cA = (const char*)g.A + (size_t)cur.pm * tstepA + (size_t)cur.kp * (K * 2); const char* cB = (const char*)g.Bt + (size_t)cur.pn * tstepB + (size_t)cur.kp * (K * 2);
    S.a_ready(cur);
    if constexpr (SP2) {
        PG8_STAGE(PG8_SB(0, 0), cB, voffB); PG8_STAGE(PG8_SB(0, 1), cB + hstepB, voffB); PG8_STAGE(PG8_SA(0, 0), cA, voffA); PG8_STAGE(PG8_SA(0, 1), cA + hstepA, voffA);
        if (wr == 1) PG8_BAR;
        PG8_WAIT_V(2); PG8_BAR;
        PG8_STAGE(PG8_SB(1, 0), cB + kstep, voffB); PG8_STAGE(PG8_SA(1, 0), cA + kstep, voffA); PG8_STAGE(PG8_SB(1, 1), cB + hstepB + kstep, voffB);
        PG8_WAIT_V(6); PG8_BAR;
    } else {
        PG8_STAGE(PG8_SB(0, 0), cB, voffB); PG8_STAGE(PG8_SA(0, 0), cA, voffA); PG8_STAGE(PG8_SB(0, 1), cB + hstepB, voffB); PG8_STAGE(PG8_SA(0, 1), cA + hstepA, voffA);
        if (wr == 1) PG8_BAR;
        PG8_WAIT_V(4); PG8_BAR;
        PG8_STAGE(PG8_SB(1, 0), cB + kstep, voffB); PG8_STAGE(PG8_SA(1, 0), cA + kstep, voffA); PG8_STAGE(PG8_SB(1, 1), cB + hstepB + kstep, voffB);
        PG8_WAIT_V(6); PG8_BAR;
    }
    for (;;) {
        const bool has_next = S.next(ui + 1, nxt);
        const char* nA = has_next ? (const char*)g.A + (size_t)nxt.pm * tstepA + (size_t)nxt.kp * (K * 2) : cA; const char* nB = has_next ? (const char*)g.Bt + (size_t)nxt.pn * tstepB + (size_t)nxt.kp * (K * 2) : cB;
#pragma nounroll
        for (int t = 0; t < nt; t += 2) {
            const bool last = (t == nt - 2);
            const char* a1 = cA + (size_t)(t + 1) * kstep;
            const char* a2 = last ? nA : cA + (size_t)(t + 2) * kstep; const char* b2 = last ? nB : cB + (size_t)(t + 2) * kstep;
            const char* a3 = a2 + kstep; const char* b3 = b2 + kstep;
            if (last && has_next) S.a_ready(nxt);
            if constexpr (SP2) {
            PG8_LDB(B0, 0, 0); PG8_LDB(B1, 0, 1); PG8_SCHED; PG8_LDA(At, 0, 0); PG8_STAGE(PG8_SA(1, 1), a1 + hstepA, voffA);
            PG8_WAIT_V(8); PG8_WAIT_L(0); PG8_BAR; PG8_MMA(0, 0, At, B0); PG8_MMA(0, 1, At, B1); PG8_BAR; PG8_SCHED;
            PG8_LDA(At, 0, 1); PG8_STAGE(PG8_SB(0, 0), b2, voffB); PG8_STAGE(PG8_SB(0, 1), b2 + hstepB, voffB); PG8_STAGE(PG8_SA(0, 0), a2, voffA);
            PG8_WAIT_V(8); PG8_WAIT_L(0); PG8_BAR; PG8_MMA(1, 0, At, B0); PG8_MMA(1, 1, At, B1); PG8_BAR; PG8_SCHED;
            PG8_LDB(B0, 1, 0); PG8_LDB(B1, 1, 1); PG8_SCHED; PG8_LDA(At, 1, 0); PG8_STAGE(PG8_SA(0, 1), a2 + hstepA, voffA);
            PG8_WAIT_V(8); PG8_WAIT_L(0); PG8_BAR; PG8_MMA(0, 0, At, B0); PG8_MMA(0, 1, At, B1); PG8_BAR; PG8_SCHED;
            PG8_LDA(At, 1, 1); PG8_STAGE(PG8_SB(1, 0), b3, voffB); PG8_STAGE(PG8_SB(1, 1), b3 + hstepB, voffB); PG8_STAGE(PG8_SA(1, 0), a3, voffA);
            PG8_WAIT_V(8); PG8_WAIT_L(0); PG8_BAR; PG8_MMA(1, 0, At, B0); PG8_MMA(1, 1, At, B1); PG8_BAR; PG8_SCHED;
            } else {
            PG8_LDB(B0, 0, 0); PG8_SCHED; PG8_LDA(At, 0, 0); PG8_STAGE(PG8_SA(1, 1), a1 + hstepA, voffA);
            PG8_WAIT_L(8); PG8_BAR; PG8_WAIT_L(0); PG8_MMA(0, 0, At, B0); PG8_BAR; PG8_SCHED;
            PG8_LDB(B1, 0, 1); PG8_STAGE(PG8_SB(0, 0), b2, voffB);
            PG8_BAR; PG8_WAIT_L(0); PG8_MMA(0, 1, At, B1); PG8_BAR;
            PG8_LDA(At, 0, 1); PG8_STAGE(PG8_SA(0, 0), a2, voffA);
            PG8_BAR; PG8_WAIT_L(0); PG8_MMA(1, 0, At, B0); PG8_BAR; PG8_SCHED;
            PG8_STAGE(PG8_SB(0, 1), b2 + hstepB, voffB);
            PG8_WAIT_V(6); PG8_BAR; PG8_MMA(1, 1, At, B1); PG8_BAR;
            PG8_LDB(B0, 1, 0); PG8_SCHED; PG8_LDA(At, 1, 0); PG8_STAGE(PG8_SA(0, 1), a2 + hstepA, voffA);
            PG8_WAIT_L(8); PG8_BAR; PG8_WAIT_L(0); PG8_MMA(0, 0, At, B0); PG8_BAR; PG8_SCHED;
            PG8_LDB(B1, 1, 1); PG8_STAGE(PG8_SB(1, 0), b3, voffB);
            PG8_BAR; PG8_WAIT_L(0); PG8_MMA(0, 1, At, B1); PG8_BAR;
            PG8_LDA(At, 1, 1); PG8_STAGE(PG8_SA(1, 0), a3, voffA);
            PG8_BAR; PG8_WAIT_L(0); PG8_MMA(1, 0, At, B0); PG8_BAR; PG8_SCHED;
            PG8_STAGE(PG8_SB(1, 1), b3 + hstepB, voffB);
            PG8_WAIT_V(6); PG8_BAR; PG8_MMA(1, 1, At, B1); PG8_BAR;
            }
        }
        if constexpr (ALIGN_EPI) { if (wr == 0) PG8_BAR; }
        if constexpr (!Epi::AFTER_DRAIN) { int te = tid; asm volatile("" : "+v"(te)); E(acc, cur, wr, wc, te & 15, (te & 63) >> 4); S.done(cur); }
        if (!has_next) break;
#pragma unroll
        for (int a = 0; a < 2; ++a)
#pragma unroll
            for (int b = 0; b < 2; ++b)
#pragma unroll
                for (int m = 0; m < 4; ++m)
#pragma unroll
                    for (int n = 0; n < 2; ++n) acc[a][b][m][n] = (f32x4){0.f, 0.f, 0.f, 0.f};
        cur = nxt; cA = nA; cB = nB; ++ui;
        if constexpr (ALIGN_EPI) { if (wr == 1) PG8_BAR; }
    }
    PG8_WAIT_V(0);
    if constexpr (!ALIGN_EPI) { if (wr == 0) PG8_BAR; }
    PG8_BAR;
    if constexpr (Epi::AFTER_DRAIN) { E.fused(acc, cur, wr, wc, fr, fq, lds, wid, lane); S.done(cur); }
#undef PG8_SA
#undef PG8_SB
#undef PG8_STAGE
#undef PG8_LDA
#undef PG8_LDB
#undef PG8_MMA
#undef PG8_WAIT_V
#undef PG8_WAIT_L
#undef PG8_BAR
#undef PG8_SCHED
}
}


#define LAS __attribute__((address_space(3)))
typedef unsigned short bf16_t;
typedef short bf16x8 __attribute__((ext_vector_type(8)));
typedef float f32x4 __attribute__((ext_vector_type(4)));
typedef unsigned u32x4 __attribute__((ext_vector_type(4)));
typedef unsigned u32x2 __attribute__((ext_vector_type(2)));
typedef float f32x2_t __attribute__((ext_vector_type(2)));
typedef __bf16 bf16x2_t __attribute__((ext_vector_type(2)));

constexpr int DM = 1024, NB = 8, SEQL = 8192, CTXL = 256, SEGL = SEQL + CTXL  , T = NB * SEGL  ;
constexpr int DFF = 4096, NTHR = 512, NWAVE = 8;
constexpr float EPS = 1e-6f;
constexpr size_t MiB = 1u << 20;
constexpr size_t WS_MOD = 0;
constexpr size_t WS_TAB = 1 * MiB;
constexpr size_t WS_XC = 2 * MiB;
constexpr size_t WS_WFF1 = 10 * MiB, WS_WFF2 = 18 * MiB, WS_WA = 26 * MiB, WS_WB = 38 * MiB;
constexpr size_t WS_WUQ = 28 * MiB, WS_WUKV = WS_WUQ + 512 * 1024, WS_WPOOL = 29 * MiB;
constexpr size_t WS_H = 46 * MiB;
constexpr size_t WS_B0 = 178 * MiB;
constexpr size_t WS_UQN = 310 * MiB, WS_UKVN = 343 * MiB, WS_KR = 360 * MiB, WS_PD = 365 * MiB, WS_Q = 431 * MiB, WS_KV = 530 * MiB;
constexpr size_t WS_Y = 706 * MiB;
constexpr size_t WS_YP = 838 * MiB;
constexpr size_t WS_END = 970 * MiB;
constexpr size_t WS_BAR = 900 * 1024;
constexpr int LDS_BAR_OFF = 141312;
constexpr int LDS_BYTES = 143360;

struct Params {
  const float *x, *c, *ctx, *c_ctx, *w_ada, *b_ada, *g_mix_pre, *g_mix_post, *g_ffn_pre, *g_ffn_post, *w_ffn_in, *w_ffn_out, *w_in_even, *g_q_lora, *g_kv_lora,
      *w_uq, *w_ukv, *w_pool, *pool_scale, *w_out_even, *w_in_odd, *w_out_odd;
  float* out; unsigned char* ws; int lo, hi;
};

__device__ __forceinline__ unsigned cvtpk(float lo, float hi) { f32x2_t v = {lo, hi}; bf16x2_t b = __builtin_convertvector(v, bf16x2_t); return __builtin_bit_cast(unsigned, b); }
__device__ __forceinline__ float bflo(unsigned u) { return __uint_as_float(u << 16); }
__device__ __forceinline__ float bfhi(unsigned u) { return __uint_as_float(u & 0xffff0000u); }
__device__ __forceinline__ bf16_t f2bf(float f) { return (bf16_t)(cvtpk(f, 0.f) & 0xffffu); }
__device__ __forceinline__ float wave_sum(float v) {
#pragma unroll
  for (int o = 1; o < 64; o <<= 1) v += __shfl_xor(v, o);
  return v;
}
__device__ __forceinline__ f32x4 mfma16(bf16x8 a, bf16x8 b, f32x4 c) { return __builtin_amdgcn_mfma_f32_16x16x32_bf16(a, b, c, 0, 0, 0); }

template <int mode, int ldc, int col_off> struct Epi {
  static constexpr bool PERM = true, AFTER_DRAIN = false;
  bf16_t* O; const float* cs; const float* tab; float scale;
  __device__ __forceinline__ void operator()(const f32x4 (&acc)[2][2][4][2], const pg8::Unit& u, int wr, int wc, int fr, int fq) const {
    const int seg = u.pm % 33; const bool islat = seg != 0;
    const int colt = u.pn * 256 + wc * 32 + 8 * fq;
    f32x4 tcm[4], tsm[4], tca[2], tsa[2]; u32x4 oldv[2][4][2]; bool rpart = false;
    if (mode == 3) {
      const int hc = colt & 127, g = (hc & 63) >> 3; rpart = (hc >> 6) != 0;
      if (u.pn < 8 && islat) {
#pragma unroll
        for (int m = 0; m < 4; ++m) { const int pos = m * 16 + fr; tcm[m] = *(const f32x4*)(tab + pos * 32 + 4 * g); tsm[m] = *(const f32x4*)(tab + 4096 + pos * 32 + 4 * g); }
#pragma unroll
        for (int ai = 0; ai < 2; ++ai) { const int pos = (seg - 1) * 4 + ai * 2 + wr; tca[ai] = *(const f32x4*)(tab + pos * 32 + 4 * g); tsa[ai] = *(const f32x4*)(tab + 4096 + pos * 32 + 4 * g); }
      }
    }
#pragma unroll
    for (int ai = 0; ai < 2; ++ai) {
      if (mode == 4) {
#pragma unroll
        for (int m = 0; m < 4; ++m)
#pragma unroll
          for (int bj = 0; bj < 2; ++bj) oldv[ai][m][bj] = *(const u32x4*)(O + (size_t)(u.pm * 256 + ai * 128 + wr * 64 + m * 16 + fr) * ldc + col_off + colt + bj * 128);
      }
#pragma unroll
      for (int m = 0; m < 4; ++m) {
        const int lrow = ai * 128 + wr * 64 + m * 16 + fr;
        const int row = u.pm * 256 + lrow;
        const int tok = (seg - 1) * 256 + lrow;
        bf16_t* rowp = O + (size_t)row * ldc + col_off;
#pragma unroll
        for (int bj = 0; bj < 2; ++bj) {
          const int c = colt + bj * 128;
          f32x4 v0 = acc[ai][bj][m][0], v1 = acc[ai][bj][m][1];
          if (mode == 5) {
            float* pp = (float*)O + ((size_t)(u.kp * 2048 + (u.pm / 33) * 256 + lrow) * 1024 + c);
            *(f32x4*)pp = v0; *(f32x4*)(pp + 4) = v1;
            continue;
          }
          if (mode == 1) {
#pragma unroll
            for (int i = 0; i < 4; ++i) { float a = fmaxf(v0[i], 0.f), b = fmaxf(v1[i], 0.f); v0[i] = a * a; v1[i] = b * b; }
          } else if (mode == 2) {
            const int hc = c % 96;
            if (islat && hc >= 64) {
              const int j = hc - 64, part = j >> 4, g = (j & 15) >> 3, pos = part ? (tok & 63) : (tok >> 6);
              const f32x4 cs4 = *(const f32x4*)(tab + pos * 8 + 4 * g), sn4 = *(const f32x4*)(tab + 1024 + pos * 8 + 4 * g);
              const f32x4 o0 = v0 * cs4 - v1 * sn4, o1 = v0 * sn4 + v1 * cs4; v0 = o0; v1 = o1;
            }
            v0 = v0 * scale; v1 = v1 * scale;
          } else if (mode == 3) {
            if (u.pn < 8) {
              if (islat) {
                const f32x4 cs4 = rpart ? tcm[m] : tca[ai], sn4 = rpart ? tsm[m] : tsa[ai];
                const f32x4 o0 = v0 * cs4 - v1 * sn4, o1 = v0 * sn4 + v1 * cs4; v0 = o0; v1 = o1;
              }
              if (u.pn >= 4) { v0 = v0 * scale; v1 = v1 * scale; }
            }
          } else if (mode == 4) {
            const u32x4 old = oldv[ai][m][bj];
            const float ov[8] = {bflo(old.x), bfhi(old.x), bflo(old.y), bfhi(old.y), bflo(old.z), bfhi(old.z), bflo(old.w), bfhi(old.w)};
#pragma unroll
            for (int i = 0; i < 4; ++i) { const float a = v0[i], b = v1[i]; v0[i] = a / (1.f + __expf(-a)) * ov[i]; v1[i] = b / (1.f + __expf(-b)) * ov[4 + i]; }
          } else if (cs) {
            const f32x4 s0 = *(const f32x4*)(cs + c), s1 = *(const f32x4*)(cs + c + 4); v0 = v0 * s0; v1 = v1 * s1;
          }
          u32x4 w; w.x = cvtpk(v0[0], v0[1]); w.y = cvtpk(v0[2], v0[3]); w.z = cvtpk(v1[0], v1[1]); w.w = cvtpk(v1[2], v1[3]);
          *(u32x4*)(rowp + c) = w;
        }
      }
    }
  }
};

__device__ __forceinline__ int src_col(int n, int mode) {
  if (mode == 1) { const int hc = n % 96; if (hc >= 64) { const int j = (hc - 64) & 15, g = j >> 3, i = j & 7; return n - j + ((i < 4) ? 4 * g + i : 8 + 4 * g + (i - 4)); } return n; }
  if (mode == 2) { if (n < 2048) { const int j = n & 63, g = j >> 3, i = j & 7; return n - j + ((i < 4) ? 4 * g + i : 32 + 4 * g + (i - 4)); } return n; }
  return n;
}
__device__ __forceinline__ void tr_item(const float* W, int K, int N, bf16_t* WT, int ldk, int mode, LAS float* scr, int item, int lane) {
  const int nblk = N / 32, kb = item / nblk, nb = item % nblk, k0 = 64 * kb, n0 = 32 * nb;
  const int sc = src_col(n0 + (lane & 31), mode);
#pragma unroll 8
  for (int i = 0; i < 32; ++i) { const int kk = 2 * i + (lane >> 5); scr[kk * 33 + (lane & 31)] = W[(size_t)(k0 + kk) * N + sc]; }
  asm volatile("s_waitcnt lgkmcnt(0)" ::: "memory");
  const int c = lane & 7;
#pragma unroll
  for (int j = 0; j < 4; ++j) { const int n = (lane >> 3) + 8 * j; const LAS float* s = scr + (8 * c) * 33 + n;
    u32x4 o; o.x = cvtpk(s[0 * 33], s[1 * 33]); o.y = cvtpk(s[2 * 33], s[3 * 33]); o.z = cvtpk(s[4 * 33], s[5 * 33]); o.w = cvtpk(s[6 * 33], s[7 * 33]);
    *(u32x4*)(WT + (size_t)(n0 + n) * ldk + k0 + 8 * c) = o; }
  asm volatile("s_waitcnt lgkmcnt(0)" ::: "memory");
}
__device__ __forceinline__ void conv_mat(const float* W, int K, int N, bf16_t* WT, int mode, LAS float* scr, int gw, int ngw, int lane, int ldk = 0) {
  const int items = (K / 64) * (N / 32);
  for (int it = gw; it < items; it += ngw) tr_item(W, K, N, WT, ldk ? ldk : K, mode, scr, it, lane);
}
__device__ __forceinline__ void conv_pool(const float* Wp, bf16_t* WT, LAS float* scr, int gw, int ngw, int lane) {
  for (int it = gw; it < 8 * 16; it += ngw) {
    const int kb = it / 16, nb = it % 16, k0 = 64 * kb, n0 = 32 * nb, gk = k0 >> 7, gn = n0 >> 7;
    if (gk == gn) {
      const float* W = Wp + (size_t)gk * 128 * 128;
#pragma unroll 8
      for (int i = 0; i < 32; ++i) { const int kk = 2 * i + (lane >> 5); scr[kk * 33 + (lane & 31)] = W[(size_t)(k0 - gk * 128 + kk) * 128 + (n0 - gn * 128) + (lane & 31)]; }
    } else {
#pragma unroll 8
      for (int i = 0; i < 32; ++i) { const int kk = 2 * i + (lane >> 5); scr[kk * 33 + (lane & 31)] = 0.f; }
    }
    asm volatile("s_waitcnt lgkmcnt(0)" ::: "memory");
    const int c = lane & 7;
#pragma unroll
    for (int j = 0; j < 4; ++j) { const int n = (lane >> 3) + 8 * j; const LAS float* s = scr + (8 * c) * 33 + n;
      u32x4 o; o.x = cvtpk(s[0 * 33], s[1 * 33]); o.y = cvtpk(s[2 * 33], s[3 * 33]); o.z = cvtpk(s[4 * 33], s[5 * 33]); o.w = cvtpk(s[6 * 33], s[7 * 33]);
      *(u32x4*)(WT + (size_t)(n0 + n) * 512 + k0 + 8 * c) = o; }
    asm volatile("s_waitcnt lgkmcnt(0)" ::: "memory");
  }
}
__device__ __forceinline__ void conv_layer(const Params& p, int L, LAS unsigned char* lds, int gw, int ngw, int wid, int lane) {
  LAS float* scr = (LAS float*)(lds + wid * 16384);
  unsigned char* ws = p.ws; const int i = L >> 1;
  conv_mat(p.w_ffn_in + (size_t)L * DM * DFF, DM, DFF, (bf16_t*)(ws + WS_WFF1), 0, scr, gw, ngw, lane);
  conv_mat(p.w_ffn_out + (size_t)L * DFF * DM, DFF, DM, (bf16_t*)(ws + WS_WFF2), 0, scr, gw, ngw, lane);
  if ((L & 1) == 0) {
    conv_mat(p.w_in_even + (size_t)i * DM * 928, DM, 928, (bf16_t*)(ws + WS_WA), 0, scr, gw, ngw, lane);
    conv_mat(p.w_uq + (size_t)i * 256 * 768, 256, 768, (bf16_t*)(ws + WS_WUQ), 1, scr, gw, ngw, lane);
    conv_mat(p.w_ukv + (size_t)i * 128 * 1024, 128, 1024, (bf16_t*)(ws + WS_WUKV), 0, scr, gw, ngw, lane, 256);
    for (int e = gw * 64 + lane; e < 1024 * 16; e += ngw * 64) { const int n = e >> 4, c = e & 15; *(u32x4*)((bf16_t*)(ws + WS_WUKV) + (size_t)n * 256 + 128 + c * 8) = (u32x4){0u, 0u, 0u, 0u}; }
    conv_pool(p.w_pool + (size_t)i * 4 * 128 * 128, (bf16_t*)(ws + WS_WPOOL), scr, gw, ngw, lane);
    conv_mat(p.w_out_even + (size_t)i * 1024 * 1024, 1024, 1024, (bf16_t*)(ws + WS_WB), 0, scr, gw, ngw, lane);
  } else {
    conv_mat(p.w_in_odd + (size_t)i * DM * 6144, DM, 6144, (bf16_t*)(ws + WS_WA), 2, scr, gw, ngw, lane);
    conv_mat(p.w_out_odd + (size_t)i * 2048 * 1024, 2048, 1024, (bf16_t*)(ws + WS_WB), 0, scr, gw, ngw, lane);
  }
}

__device__ __forceinline__ void p0_phase(const Params& p, LAS unsigned char* lds, const int tid, const int bid) {
  const int G = gridDim.x, lane = tid & 63, wid = tid >> 6;
  float* mod = (float*)(p.ws + WS_MOD);
  LAS float* sc = (LAS float*)lds;
  LAS float* part = (LAS float*)(lds + 9 * 1024 * 4);
  for (int e = tid; e < 9 * 1024; e += NTHR) { const int r = e >> 10, k = e & 1023; const float v = (r < 8) ? p.c[r * DM + k] : p.c_ctx[k]; sc[e] = v / (1.f + expf(-v)); }
  __syncthreads();
  for (int it = bid; it < 4 * 96; it += G) {
    const int L = it / 96, col0 = (it % 96) * 64;
    float a0 = 0, a1 = 0, a2 = 0, a3 = 0, a4 = 0, a5 = 0, a6 = 0, a7 = 0, a8 = 0;
    const float* wp = p.w_ada + ((size_t)L * DM + wid * 128) * 6144 + col0 + lane;
    const LAS float* s0 = sc + wid * 128;
#pragma unroll 16
    for (int k = 0; k < 128; ++k) { const float w = wp[(size_t)k * 6144];
      a0 += s0[k] * w; a1 += s0[1024 + k] * w; a2 += s0[2048 + k] * w; a3 += s0[3072 + k] * w; a4 += s0[4096 + k] * w; a5 += s0[5120 + k] * w; a6 += s0[6144 + k] * w; a7 += s0[7168 + k] * w; a8 += s0[8192 + k] * w; }
    LAS float* pp = part + wid * 9 * 64 + lane;
    pp[0] = a0; pp[64] = a1; pp[128] = a2; pp[192] = a3; pp[256] = a4; pp[320] = a5; pp[384] = a6; pp[448] = a7; pp[512] = a8;
    __syncthreads();
    for (int e = tid; e < 9 * 64; e += NTHR) { const int r = e >> 6, cl = e & 63; float v = p.b_ada[L * 6144 + col0 + cl];
#pragma unroll
      for (int w = 0; w < 8; ++w) v += part[w * 9 * 64 + e];
      mod[((size_t)L * 9 + r) * 6144 + col0 + cl] = v; }
    __syncthreads();
  }
  float* tab = (float*)(p.ws + WS_TAB);
  for (int e = bid * NTHR + tid; e < 1024 + 4096; e += G * NTHR) {
    if (e < 1024) { const int pos = e >> 3, i = e & 7; const float fr = powf(10000.f, -(float)(2 * i) / 16.f), a = (float)pos * fr; tab[e] = cosf(a); tab[1024 + e] = sinf(a); }
    else { const int q = e - 1024, pos = q >> 5, i = q & 31; const float fr = powf(10000.f, -(float)(2 * i) / 64.f), a = (float)pos * fr; tab[2048 + q] = cosf(a); tab[2048 + 4096 + q] = sinf(a); }
  }
}

__device__ __forceinline__ const float* xrow_ptr(const float* xl, const float* xc, int r) {
  const int b = r / SEGL, w = r % SEGL;
  return (w < CTXL) ? xc + (size_t)(b * CTXL + w) * DM : xl + (size_t)(b * SEQL + (w - CTXL)) * DM;
}
__device__ __forceinline__ void norm_phase(const Params& p, bool first, bool has_res, bool final_, const float* gpost, const float* gate_mod  ,
                                            const float* gpre, const float* shsc_mod  , int gw, int ngw, int lane, bool dry = false, const float* ysplit = nullptr) {
  const bf16_t* Y = (const bf16_t*)(p.ws + WS_Y); bf16_t* H = (bf16_t*)(p.ws + WS_H); float* XC = (float*)(p.ws + WS_XC);
  const float* xl = first ? p.x : p.out; const float* xc = first ? p.ctx : XC;
  const int rbeg = gw, rend = T, rstep = ngw;
  if (rbeg >= rend) return;
  int cur_m = -1;
  f32x4 cres[4], ca[4], csh[4];
#pragma unroll
  for (int j = 0; j < 4; ++j) { cres[j] = (f32x4){0.f, 0.f, 0.f, 0.f}; ca[j] = cres[j]; csh[j] = cres[j]; }
  f32x4 nx[4]; u32x2 ny[4];
  { const float* xs = xrow_ptr(xl, xc, rbeg);
#pragma unroll
    for (int j = 0; j < 4; ++j) { nx[j] = __builtin_nontemporal_load(((const f32x4*)xs) + lane + 64 * j); ny[j] = has_res ? __builtin_nontemporal_load(((const u32x2*)(Y + (size_t)rbeg * DM)) + lane + 64 * j) : (u32x2){0u, 0u}; } }
  for (int r = rbeg; r < rend; r += rstep) {
    const int b = r / SEGL, w = r % SEGL; const bool isctx = w < CTXL;
    float* xd = (isctx ? XC + (size_t)(b * CTXL + w) * DM : p.out + (size_t)(b * SEQL + (w - CTXL)) * DM);
    const int mrow = isctx ? 8 : b;
    f32x4 v[4]; u32x2 yq[4];
#pragma unroll
    for (int j = 0; j < 4; ++j) { v[j] = nx[j]; yq[j] = ny[j]; }
    if (r + rstep < rend) { const float* xs = xrow_ptr(xl, xc, r + rstep);
#pragma unroll
      for (int j = 0; j < 4; ++j) { nx[j] = __builtin_nontemporal_load(((const f32x4*)xs) + lane + 64 * j); if (has_res) ny[j] = __builtin_nontemporal_load(((const u32x2*)(Y + (size_t)(r + rstep) * DM)) + lane + 64 * j); } }
    if (final_ && isctx) continue;
    if (mrow != cur_m) { cur_m = mrow;
#pragma unroll
      for (int j = 0; j < 4; ++j) {
        if (has_res) cres[j] = ((const f32x4*)gpost)[lane + 64 * j] * ((const f32x4*)(gate_mod + (size_t)mrow * 6144))[lane + 64 * j];
        if (!final_) { ca[j] = ((const f32x4*)gpre)[lane + 64 * j] * (((const f32x4*)(shsc_mod + (size_t)mrow * 6144 + 1024))[lane + 64 * j] + 1.f); csh[j] = ((const f32x4*)(shsc_mod + (size_t)mrow * 6144))[lane + 64 * j]; } } }
    if (has_res) {
      f32x4 y[4]; float ss = 0.f;
#pragma unroll
      for (int j = 0; j < 4; ++j) y[j] = (f32x4){bflo(yq[j].x), bfhi(yq[j].x), bflo(yq[j].y), bfhi(yq[j].y)};
      if (ysplit && isctx) {
        const float* yp = ysplit + (size_t)(b * CTXL + w) * DM;
#pragma unroll
        for (int j = 0; j < 4; ++j) y[j] = ((const f32x4*)yp)[lane + 64 * j];
#pragma unroll 1
        for (int k = 1; k < 8; ++k) {
#pragma unroll
          for (int j = 0; j < 4; ++j) y[j] = y[j] + ((const f32x4*)(yp + (size_t)k * 2048 * DM))[lane + 64 * j]; }
      }
#pragma unroll
      for (int j = 0; j < 4; ++j) ss += (y[j].x * y[j].x + y[j].y * y[j].y) + (y[j].z * y[j].z + y[j].w * y[j].w);
      const float rs = rsqrtf(wave_sum(ss) * (1.f / DM) + EPS);
#pragma unroll
      for (int j = 0; j < 4; ++j) v[j] = v[j] + cres[j] * (y[j] * rs);
    }
    if ((has_res || first) && !dry) {
#pragma unroll
      for (int j = 0; j < 4; ++j) __builtin_nontemporal_store(v[j], ((f32x4*)xd) + lane + 64 * j);
    }
    if (!final_) {
      float ss = 0.f;
#pragma unroll
      for (int j = 0; j < 4; ++j) ss += (v[j].x * v[j].x + v[j].y * v[j].y) + (v[j].z * v[j].z + v[j].w * v[j].w);
      const float rs = rsqrtf(wave_sum(ss) * (1.f / DM) + EPS);
#pragma unroll
      for (int j = 0; j < 4; ++j) { const f32x4 h = (v[j] * rs) * ca[j] + csh[j];
        u32x2 o; o.x = cvtpk(h.x, h.y); o.y = cvtpk(h.z, h.w); __builtin_nontemporal_store(o, ((u32x2*)(H + (size_t)r * DM)) + lane + 64 * j); }
    }
  }
}

__device__ __forceinline__ void mid_phase(const Params& p, int i, int gw, int ngw, int lane) {
  const bf16_t* U = (const bf16_t*)(p.ws + WS_B0); bf16_t* UQN = (bf16_t*)(p.ws + WS_UQN); bf16_t* UKVN = (bf16_t*)(p.ws + WS_UKVN); bf16_t* KR = (bf16_t*)(p.ws + WS_KR); bf16_t* PD = (bf16_t*)(p.ws + WS_PD);
  const float* tab = (const float*)(p.ws + WS_TAB);
  const float* gq = p.g_q_lora + i * 256; const float* gkv = p.g_kv_lora + i * 128;
  const f32x4 g4 = ((const f32x4*)gq)[lane]; const float gk0 = gkv[2 * lane], gk1 = gkv[2 * lane + 1];
  int prow = -1, pdst = 0; u32x2 pq = (u32x2){0u, 0u}; unsigned pkv = 0u; bf16_t pkr = 0; u32x4 ppd = (u32x4){0u, 0u, 0u, 0u};
  for (int r = gw; r < T; r += ngw) {
    const int w = r % SEGL; const bool isctx = w < CTXL; const int t = isctx ? w : w - CTXL, Lseg = isctx ? CTXL : SEQL;
    const bf16_t* ur = U + (size_t)r * 1024;
    const u32x2 qw = ((const u32x2*)ur)[lane];
    const unsigned kvw = ((const unsigned*)(ur + 256))[lane];
    const int j = lane & 31; const unsigned krw = (unsigned)ur[384 + j];
    const int part = j >> 4, jj = j & 15, isx2 = jj >> 3, fi = jj & 7;
    float cs = 1.f, sn = 0.f;
    if (!isctx) { const int pos = part ? (t & 63) : (t >> 6); cs = tab[pos * 8 + fi]; sn = tab[1024 + pos * 8 + fi]; }
    const int g = lane >> 4, wn = 2 << g; const int lo = max(t - (wn >> 1), 0), hi = min(t + wn - (wn >> 1), Lseg);
    const bf16_t* base = ur + 416 + lane * 8;
    u32x4 d[16];
#pragma unroll
    for (int k = 0; k < 16; ++k) { const int q = t - 8 + k; d[k] = (u32x4){0u, 0u, 0u, 0u}; if (q >= lo && q < hi) d[k] = *(const u32x4*)(base + (ptrdiff_t)(q - t) * 1024); }
    const u32x4 own = *(const u32x4*)base;
    if (prow >= 0) {
      ((u32x2*)(UQN + (size_t)prow * 256))[lane] = pq;
      ((unsigned*)(UKVN + (size_t)prow * 128))[lane] = pkv;
      if (lane < 32) KR[(size_t)prow * 32 + pdst] = pkr;
      *(u32x4*)(PD + (size_t)prow * 512 + lane * 8) = ppd;
    }
    float s[8] = {0, 0, 0, 0, 0, 0, 0, 0};
#pragma unroll
    for (int k = 0; k < 16; ++k) { s[0] += bflo(d[k].x); s[1] += bfhi(d[k].x); s[2] += bflo(d[k].y); s[3] += bfhi(d[k].y); s[4] += bflo(d[k].z); s[5] += bfhi(d[k].z); s[6] += bflo(d[k].w); s[7] += bfhi(d[k].w); }
    const float a0 = bflo(qw.x), a1 = bfhi(qw.x), a2 = bflo(qw.y), a3 = bfhi(qw.y);
    const float rsq = rsqrtf(wave_sum(a0 * a0 + a1 * a1 + a2 * a2 + a3 * a3) * (1.f / 256.f) + EPS);
    const float b0 = bflo(kvw), b1 = bfhi(kvw);
    const float rsk = rsqrtf(wave_sum(b0 * b0 + b1 * b1) * (1.f / 128.f) + EPS);
    const float val = bflo(krw); const float pv = __shfl_xor(val, 8);
    const float ko = isx2 ? (pv * sn + val * cs) : (val * cs - pv * sn);
    const float inv = 1.f / (float)(hi - lo);
    pq.x = cvtpk(a0 * rsq * g4.x, a1 * rsq * g4.y); pq.y = cvtpk(a2 * rsq * g4.z, a3 * rsq * g4.w);
    pkv = cvtpk(b0 * rsk * gk0, b1 * rsk * gk1);
    pkr = f2bf(ko); pdst = part * 16 + 8 * (fi >> 2) + (fi & 3) + 4 * isx2;
    ppd.x = cvtpk(s[0] * inv - bflo(own.x), s[1] * inv - bfhi(own.x)); ppd.y = cvtpk(s[2] * inv - bflo(own.y), s[3] * inv - bfhi(own.y));
    ppd.z = cvtpk(s[4] * inv - bflo(own.z), s[5] * inv - bfhi(own.z)); ppd.w = cvtpk(s[6] * inv - bflo(own.w), s[7] * inv - bfhi(own.w));
    prow = r;
  }
  if (prow >= 0) {
    ((u32x2*)(UQN + (size_t)prow * 256))[lane] = pq;
    ((unsigned*)(UKVN + (size_t)prow * 128))[lane] = pkv;
    if (lane < 32) KR[(size_t)prow * 32 + pdst] = pkr;
    *(u32x4*)(PD + (size_t)prow * 512 + lane * 8) = ppd;
  }
}

__device__ __forceinline__ void gn_phase(const Params& p, int gw, int ngw, int lane) {
  bf16_t* U = (bf16_t*)(p.ws + WS_B0);
  if (gw >= T) return;
  u32x4 nd[4];
#pragma unroll
  for (int i = 0; i < 4; ++i) nd[i] = *(const u32x4*)(U + (size_t)gw * 4096 + 2048 + lane * 8 + i * 512);
  for (int r = gw; r < T; r += ngw) {
    bf16_t* rowp = U + (size_t)r * 4096 + 2048 + lane * 8;
    u32x4 d[4];
#pragma unroll
    for (int i = 0; i < 4; ++i) d[i] = nd[i];
    if (r + ngw < T) {
#pragma unroll
      for (int i = 0; i < 4; ++i) nd[i] = *(const u32x4*)(U + (size_t)(r + ngw) * 4096 + 2048 + lane * 8 + i * 512); }
#pragma unroll
    for (int i = 0; i < 4; ++i) {
      float v[8] = {bflo(d[i].x), bfhi(d[i].x), bflo(d[i].y), bfhi(d[i].y), bflo(d[i].z), bfhi(d[i].z), bflo(d[i].w), bfhi(d[i].w)};
      float s = ((v[0] + v[1]) + (v[2] + v[3])) + ((v[4] + v[5]) + (v[6] + v[7]));
#pragma unroll
      for (int o = 1; o < 32; o <<= 1) s += __shfl_xor(s, o);
      const float mu = s * (1.f / 256.f); float q = 0.f;
#pragma unroll
      for (int e2 = 0; e2 < 8; ++e2) { v[e2] -= mu; q += v[e2] * v[e2]; }
#pragma unroll
      for (int o = 1; o < 32; o <<= 1) q += __shfl_xor(q, o);
      const float rs = rsqrtf(q * (1.f / 256.f) + EPS);
      u32x4 w; w.x = cvtpk(v[0] * rs, v[1] * rs); w.y = cvtpk(v[2] * rs, v[3] * rs); w.z = cvtpk(v[4] * rs, v[5] * rs); w.w = cvtpk(v[6] * rs, v[7] * rs);
      *(u32x4*)(rowp + i * 512) = w;
    }
  }
}

#define XB_TMO      128
#define XB_XCNT(j)  (256  + 64 * (j))
#define XB_XSUB(j)  (1280 + 64 * (j))
#define XB_XGEN(j)  (2304 + 64 * (j))
#define XB_TOP      3328
#define XB_TOPGEN   3392
#define XCD_BAR_WORDS 3456
#define XB_SPIN_CAP (1u << 18)

__device__ __forceinline__ unsigned xb_ld(unsigned* p)              { return __hip_atomic_load(p, __ATOMIC_RELAXED, __HIP_MEMORY_SCOPE_AGENT); }
__device__ __forceinline__ unsigned xb_add(unsigned* p, unsigned v) { return __hip_atomic_fetch_add(p, v, __ATOMIC_RELAXED, __HIP_MEMORY_SCOPE_AGENT); }
__device__ __forceinline__ unsigned xb_xcc_id() { return (unsigned)__builtin_amdgcn_s_getreg((3 << 11) | 20) & 0xFu; }
#define XB_SPIN(cond, bar) do { unsigned _sp = 0; while (cond) { __builtin_amdgcn_s_sleep(1); \
    if ((++_sp & 255u) == 0u) { if (xb_ld(&(bar)[XB_TMO])) break; if (_sp > XB_SPIN_CAP) { atomicAdd(&(bar)[XB_TMO], 1u); break; } } } } while (0)

struct XcdBarrier {
    unsigned* bar; unsigned x;
    volatile LAS unsigned* st;
};

__device__ __forceinline__ XcdBarrier xcd_barrier_post(unsigned* bar, volatile LAS unsigned* st) {
    XcdBarrier b; b.bar = bar; b.x = xb_xcc_id(); b.st = st;
    if (threadIdx.x == 0) (void)xb_add(&bar[XB_XCNT(b.x)], 1u);
    return b;
}
__device__ __forceinline__ void xcd_barrier_complete(unsigned* bar, unsigned x, unsigned& nloc, unsigned& nx) {
    const unsigned G = gridDim.x * gridDim.y * gridDim.z;
    unsigned sum, cnt, mine, sp = 0u;
    for (;;) {
        sum = 0u; cnt = 0u; mine = 0u;
#pragma unroll
        for (unsigned j = 0; j < 16; ++j) { const unsigned c = xb_ld(&bar[XB_XCNT(j)]); sum += c; cnt += (c > 0u) ? 1u : 0u; mine = (j == x) ? c : mine; }
        if (sum == G) break;
        __builtin_amdgcn_s_sleep(1);
        if ((++sp & 255u) == 0u) { if (xb_ld(&bar[XB_TMO])) break; if (sp > XB_SPIN_CAP) { atomicAdd(&bar[XB_TMO], 1u); break; } }
    }
    nloc = mine > 0u ? mine : 1u; nx = cnt > 0u ? cnt : 1u;
}

__device__ __forceinline__ void xcd_barrier(const XcdBarrier& b) {
    asm volatile("s_waitcnt vmcnt(0)" ::: "memory");
    __syncthreads();
    if (threadIdx.x == 0) {
        unsigned* bar = b.bar;
        __builtin_amdgcn_s_waitcnt(0);
        unsigned nloc = b.st[0], nx = b.st[1];
        if (nloc == 0u) { xcd_barrier_complete(bar, b.x, nloc, nx); b.st[0] = nloc; b.st[1] = nx; }
        const unsigned old = xb_add(&bar[XB_XSUB(b.x)], 1u);
        const unsigned gen = old / nloc;
        if (old + 1u == (gen + 1u) * nloc) {
            __builtin_amdgcn_fence(__ATOMIC_RELEASE, "agent");
            asm volatile("s_waitcnt vmcnt(0)" ::: "memory");
            const unsigned og = xb_add(&bar[XB_TOP], 1u);
            const unsigned tg = og / nx;
            if (og + 1u == (tg + 1u) * nx) xb_add(&bar[XB_TOPGEN], 1u);
            else XB_SPIN(xb_ld(&bar[XB_TOPGEN]) == tg, bar);
            __builtin_amdgcn_fence(__ATOMIC_ACQUIRE, "agent");
            xb_add(&bar[XB_XGEN(b.x)], 1u);
            asm volatile("s_waitcnt vmcnt(0)" ::: "memory");
        } else {
            XB_SPIN(xb_ld(&bar[XB_XGEN(b.x)]) == gen, bar);
            __builtin_amdgcn_fence(__ATOMIC_ACQUIRE, "agent");
            asm volatile("s_waitcnt vmcnt(0)" ::: "memory");
        }
    }
    __syncthreads();
}

typedef short v4i16_t __attribute__((ext_vector_type(4)));
__device__ __forceinline__ u32x2 tr_rd(const LAS bf16_t* p) { return __builtin_bit_cast(u32x2, __builtin_amdgcn_ds_read_tr16_b64_v4i16((LAS v4i16_t*)p)); }
constexpr int AT_KSTR = 104, AT_VSTR = 72, AT_BUF = 64 * AT_KSTR * 2 + 64 * AT_VSTR * 2;
__device__ __forceinline__ void attn_stage(LAS unsigned char* buf, int tid, u32x4 rk, u32x4 rv, u32x4 rr) {
  LAS bf16_t* Ks = (LAS bf16_t*)buf; LAS bf16_t* Vs = (LAS bf16_t*)(buf + 64 * AT_KSTR * 2);
  const int skey = tid >> 3, sch = tid & 7;
  *(LAS u32x4*)(Ks + skey * AT_KSTR + sch * 8) = rk;
  if (tid < 256) { const int rkey = tid >> 2, rch = tid & 3; *(LAS u32x4*)(Ks + rkey * AT_KSTR + 64 + rch * 8) = rr; }
  *(LAS u32x4*)(Vs + skey * AT_VSTR + sch * 8) = rv;
}
__device__ __forceinline__ void attn_unit(LAS unsigned char* lds, const bf16_t* Q, const bf16_t* KV, const bf16_t* KR, bf16_t* MIX, size_t qrow0, size_t krow0, int ntiles, int h, const int tid) {
  const int lane = tid & 63, wid = tid >> 6, c16 = lane & 15, quad = lane >> 4, tq = (lane & 15) >> 2, tp = lane & 3;
  const bf16_t* gk = KV + (krow0 + (tid >> 3)) * 1024 + h * 128 + (tid & 7) * 8;
  const bf16_t* gr = KR + (krow0 + ((tid & 255) >> 2)) * 32 + (tid & 3) * 8;
  bf16x8 qf[2][3];
#pragma unroll
  for (int qb = 0; qb < 2; ++qb)
#pragma unroll
    for (int ks = 0; ks < 3; ++ks) qf[qb][ks] = *(const bf16x8*)(Q + (qrow0 + wid * 32 + qb * 16 + c16) * 768 + h * 96 + ks * 32 + quad * 8);
  f32x4 o[2][4];
#pragma unroll
  for (int qb = 0; qb < 2; ++qb)
#pragma unroll
    for (int eb = 0; eb < 4; ++eb) o[qb][eb] = (f32x4){0.f, 0.f, 0.f, 0.f};
  float mref[2] = {0.f, 0.f}; f32x4 lacc[2] = {(f32x4){0.f, 0.f, 0.f, 0.f}, (f32x4){0.f, 0.f, 0.f, 0.f}};
  const bf16x8 ones = (bf16x8){0x3F80, 0x3F80, 0x3F80, 0x3F80, 0x3F80, 0x3F80, 0x3F80, 0x3F80};
  u32x4 rk = *(const u32x4*)gk, rv = *(const u32x4*)(gk + 64), rr = (u32x4){0, 0, 0, 0};
  if (tid < 256) rr = *(const u32x4*)gr;
  __syncthreads();
  attn_stage(lds, tid, rk, rv, rr);
  __syncthreads();
  for (int t = 0; t < ntiles; ++t) {
    LAS unsigned char* buf = lds + (t & 1) * AT_BUF;
    const bool more = (t + 1 < ntiles);
    if (more) { const bf16_t* g2 = gk + (size_t)(t + 1) * 64 * 1024; rk = *(const u32x4*)g2; rv = *(const u32x4*)(g2 + 64); if (tid < 256) rr = *(const u32x4*)(gr + (size_t)(t + 1) * 64 * 32); }
    const LAS bf16_t* Ks = (const LAS bf16_t*)buf; const LAS bf16_t* Vs = (const LAS bf16_t*)(buf + 64 * AT_KSTR * 2);
    f32x4 s[4][2];
#pragma unroll
    for (int kb = 0; kb < 4; ++kb) {
      bf16x8 kf[3];
#pragma unroll
      for (int ks = 0; ks < 3; ++ks) kf[ks] = *(const LAS bf16x8*)(Ks + (kb * 16 + c16) * AT_KSTR + ks * 32 + quad * 8);
#pragma unroll
      for (int qb = 0; qb < 2; ++qb) { const float nm = -mref[qb]; f32x4 a = (f32x4){nm, nm, nm, nm};
#pragma unroll
        for (int ks = 0; ks < 3; ++ks) a = mfma16(kf[ks], qf[qb][ks], a);
        s[kb][qb] = a; }
    }
#pragma unroll
    for (int qb = 0; qb < 2; ++qb) {
      float mx = -1e30f;
#pragma unroll
      for (int kb = 0; kb < 4; ++kb) mx = fmaxf(fmaxf(fmaxf(s[kb][qb][0], s[kb][qb][1]), fmaxf(s[kb][qb][2], s[kb][qb][3])), mx);
      mx = fmaxf(mx, __shfl_xor(mx, 16)); mx = fmaxf(mx, __shfl_xor(mx, 32));
      if (t == 0 || __any(mx > 8.f)) {
        const float delta = (t == 0) ? mx : fmaxf(mx, 0.f), alpha = (t == 0) ? 1.f : __builtin_amdgcn_exp2f(-delta);
        mref[qb] += delta; lacc[qb] = lacc[qb] * alpha;
#pragma unroll
        for (int kb = 0; kb < 4; ++kb) s[kb][qb] = s[kb][qb] - delta;
#pragma unroll
        for (int eb = 0; eb < 4; ++eb) o[qb][eb] = o[qb][eb] * alpha;
      }
#pragma unroll
      for (int kb = 0; kb < 4; ++kb)
#pragma unroll
        for (int r = 0; r < 4; ++r) s[kb][qb][r] = __builtin_amdgcn_exp2f(s[kb][qb][r]);
    }
#pragma unroll
    for (int s2 = 0; s2 < 2; ++s2) {
      bf16x8 pf[2];
#pragma unroll
      for (int qb = 0; qb < 2; ++qb) { u32x4 w; w.x = cvtpk(s[2 * s2][qb][0], s[2 * s2][qb][1]); w.y = cvtpk(s[2 * s2][qb][2], s[2 * s2][qb][3]);
        w.z = cvtpk(s[2 * s2 + 1][qb][0], s[2 * s2 + 1][qb][1]); w.w = cvtpk(s[2 * s2 + 1][qb][2], s[2 * s2 + 1][qb][3]); pf[qb] = __builtin_bit_cast(bf16x8, w);
        lacc[qb] = mfma16(ones, pf[qb], lacc[qb]); }
      const LAS bf16_t* vb = Vs + (32 * s2 + 4 * quad + tq) * AT_VSTR + 4 * tp;
#pragma unroll
      for (int eb = 0; eb < 4; ++eb) {
        const u32x2 lo = tr_rd(vb + 16 * eb), hi = tr_rd(vb + 16 * AT_VSTR + 16 * eb);
        const u32x4 vv = (u32x4){lo.x, lo.y, hi.x, hi.y}; const bf16x8 vf = __builtin_bit_cast(bf16x8, vv);
#pragma unroll
        for (int qb = 0; qb < 2; ++qb) o[qb][eb] = mfma16(vf, pf[qb], o[qb][eb]);
      }
    }
    if (more) attn_stage(lds + ((t + 1) & 1) * AT_BUF, tid, rk, rv, rr);
    __syncthreads();
  }
#pragma unroll
  for (int qb = 0; qb < 2; ++qb) {
    const float inv = 1.f / lacc[qb][0];
    bf16_t* op = MIX + (qrow0 + wid * 32 + qb * 16 + c16) * 1024 + h * 64 + quad * 4;
#pragma unroll
    for (int eb = 0; eb < 4; ++eb) { u32x2 w; w.x = cvtpk(o[qb][eb][0] * inv, o[qb][eb][1] * inv); w.y = cvtpk(o[qb][eb][2] * inv, o[qb][eb][3] * inv); *(u32x2*)(op + eb * 16) = w; }
  }
}
__device__ __forceinline__ void attn_phase(const Params& p, LAS unsigned char* lds, const int tid, const int bid) {
  const bf16_t* Q = (const bf16_t*)(p.ws + WS_Q); const bf16_t* KV = (const bf16_t*)(p.ws + WS_KV); const bf16_t* KR = (const bf16_t*)(p.ws + WS_KR); bf16_t* MIX = (bf16_t*)(p.ws + WS_B0);
  const int G = gridDim.x;
  for (int u = bid; u < 2048; u += G) {
    const int b = u & 7, rest = u >> 3, qb = rest & 31, h = rest >> 5;
    attn_unit(lds, Q, KV, KR, MIX, (size_t)b * SEGL + CTXL + (size_t)qb * 256, (size_t)b * SEGL, SEGL / 64, h, tid);
  }
  for (int u = bid; u < 64; u += G) {
    const int b = u & 7, h = u >> 3;
    attn_unit(lds, Q, KV, KR, MIX, (size_t)b * SEGL, (size_t)b * SEGL, CTXL / 64, h, tid);
  }
}

constexpr int RT_STR = 136, RT_VSTR = 72;
constexpr int RT_QS = 0, RT_KS = 128 * RT_STR * 2, RT_VS = 2 * RT_KS, RT_ST = RT_VS + 128 * RT_VSTR * 2;
__device__ __forceinline__ u32x4 scale8(u32x4 v, float f) {
  u32x4 o; o.x = cvtpk(bflo(v.x) * f, bfhi(v.x) * f); o.y = cvtpk(bflo(v.y) * f, bfhi(v.y) * f); o.z = cvtpk(bflo(v.z) * f, bfhi(v.z) * f); o.w = cvtpk(bflo(v.w) * f, bfhi(v.w) * f); return o;
}
__device__ __forceinline__ void ret_unit(LAS unsigned char* lds, bf16_t* U, bf16_t* OF, int b, int h, int sl, const int tid, const bool dry) {
  const int lane = tid & 63, wid = tid >> 6, c16 = lane & 15, quad = lane >> 4, tq = (lane & 15) >> 2, tp = lane & 3;
  LAS bf16_t* Qs = (LAS bf16_t*)(lds + RT_QS); LAS bf16_t* Ks = (LAS bf16_t*)(lds + RT_KS); LAS bf16_t* Vs = (LAS bf16_t*)(lds + RT_VS); LAS bf16_t* St = (LAS bf16_t*)(lds + RT_ST);
  const size_t rowb = (size_t)b * SEGL;
  const int n = 16 * wid + c16;
  for (int dir = 0; dir < 2; ++dir) {
    const int hh = dir ? (7 - h) : h;
    const float lg = log2f(1.0f - exp2f(-5.0f - (float)hh));
    const float gC = exp2f(lg * 128.f), g1 = exp2f(lg), g127 = exp2f(lg * 127.f);
    const float dq = dir ? exp2f(lg * (float)(128 - n)) : exp2f(lg * (float)(n + 1));
    const float cn = dir ? exp2f(-lg * (float)n) : exp2f(lg * (float)n);
    float kf4[4];
#pragma unroll
    for (int i = 0; i < 4; ++i) { const int row = (tid + 512 * i) >> 4; kf4[i] = dir ? exp2f(lg * (float)row) : exp2f(-lg * (float)row); }
    f32x4 st[4];
#pragma unroll
    for (int eb = 0; eb < 4; ++eb) st[eb] = (f32x4){0.f, 0.f, 0.f, 0.f};
    u32x4 rq[4], rk[4], rv[2];
    { const int c0 = dir ? 1 : 0; const size_t row0 = rowb + (size_t)c0 * 128;
#pragma unroll
      for (int i = 0; i < 4; ++i) { const int idx = tid + 512 * i, row = idx >> 4, ch = idx & 15; const bf16_t* src = U + (row0 + row) * 4096 + h * 128 + ch * 8; rq[i] = *(const u32x4*)src; rk[i] = *(const u32x4*)(src + 1024); }
#pragma unroll
      for (int i = 0; i < 2; ++i) { const int idx = tid + 512 * i, row = idx >> 3, ch = idx & 7; rv[i] = *(const u32x4*)(U + (row0 + row) * 4096 + 2048 + h * 256 + sl * 64 + ch * 8); } }
    for (int step = 0; step < 66; ++step) {
      const int c = dir ? ((step < 2) ? (1 - step) : (67 - step)) : step;
      const size_t grow = rowb + (size_t)c * 128 + n;
      __syncthreads();
#pragma unroll
      for (int i = 0; i < 4; ++i) { const int idx = tid + 512 * i, row = idx >> 4, ch = idx & 15;
        *(LAS u32x4*)(Qs + row * RT_STR + ch * 8) = rq[i]; *(LAS u32x4*)(Ks + row * RT_STR + ch * 8) = scale8(rk[i], kf4[i]); }
#pragma unroll
      for (int i = 0; i < 2; ++i) { const int idx = tid + 512 * i, row = idx >> 3, ch = idx & 7; *(LAS u32x4*)(Vs + row * RT_VSTR + ch * 8) = rv[i]; }
#pragma unroll
      for (int eb = 0; eb < 4; ++eb)
#pragma unroll
        for (int r = 0; r < 4; ++r) St[(16 * eb + 4 * quad + r) * RT_STR + 16 * wid + c16] = f2bf(st[eb][r]);
      __syncthreads();
      if (step + 1 < 66) { const int s1 = step + 1; const int c1 = dir ? ((s1 < 2) ? (1 - s1) : (67 - s1)) : s1; const size_t r1 = rowb + (size_t)c1 * 128;
#pragma unroll
        for (int i = 0; i < 4; ++i) { const int idx = tid + 512 * i, row = idx >> 4, ch = idx & 15; const bf16_t* src = U + (r1 + row) * 4096 + h * 128 + ch * 8; rq[i] = *(const u32x4*)src; rk[i] = *(const u32x4*)(src + 1024); }
#pragma unroll
        for (int i = 0; i < 2; ++i) { const int idx = tid + 512 * i, row = idx >> 3, ch = idx & 7; rv[i] = *(const u32x4*)(U + (r1 + row) * 4096 + 2048 + h * 256 + sl * 64 + ch * 8); } }
      u32x2 fo[4];
      if (dir) { const bf16_t* ip = OF + grow * 2048 + h * 256 + sl * 64 + quad * 4;
#pragma unroll
        for (int eb = 0; eb < 4; ++eb) fo[eb] = *(const u32x2*)(ip + eb * 16); }
      bf16x8 qf[4];
#pragma unroll
      for (int ks = 0; ks < 4; ++ks) qf[ks] = *(const LAS bf16x8*)(Qs + n * RT_STR + ks * 32 + quad * 8);
      f32x4 o[4];
#pragma unroll
      for (int eb = 0; eb < 4; ++eb) { f32x4 a = (f32x4){0.f, 0.f, 0.f, 0.f};
#pragma unroll
        for (int ks = 0; ks < 4; ++ks) { const bf16x8 af = *(const LAS bf16x8*)(St + (16 * eb + c16) * RT_STR + ks * 32 + quad * 8); a = mfma16(af, qf[ks], a); }
        o[eb] = a * dq; }
      const float pre = dir ? gC : g1, post = dir ? 1.f : g127;
#pragma unroll
      for (int eb = 0; eb < 4; ++eb) st[eb] = st[eb] * pre;
#pragma unroll 4
      for (int s2 = 0; s2 < 4; ++s2) {
        const LAS bf16_t* vb = Vs + (32 * s2 + 4 * quad + tq) * RT_VSTR + 4 * tp;
        bf16x8 vf[4];
#pragma unroll
        for (int eb = 0; eb < 4; ++eb) { const u32x2 lo = tr_rd(vb + 16 * eb), hi = tr_rd(vb + 16 * RT_VSTR + 16 * eb); const u32x4 vv = (u32x4){lo.x, lo.y, hi.x, hi.y}; vf[eb] = __builtin_bit_cast(bf16x8, vv); }
        const bool needed = dir ? (2 * s2 + 1 >= wid) : (2 * s2 <= wid);
        if (needed) {
          float pw[8];
#pragma unroll
          for (int hf = 0; hf < 2; ++hf) { const int mb = 2 * s2 + hf; f32x4 a = (f32x4){0.f, 0.f, 0.f, 0.f};
#pragma unroll
            for (int ks = 0; ks < 4; ++ks) { const bf16x8 kf = *(const LAS bf16x8*)(Ks + (16 * mb + c16) * RT_STR + ks * 32 + quad * 8); a = mfma16(kf, qf[ks], a); }
#pragma unroll
            for (int r = 0; r < 4; ++r) { const int m = 16 * mb + 4 * quad + r; const bool keep = dir ? (m > n) : (n >= m); pw[4 * hf + r] = keep ? a[r] * cn : 0.f; } }
          u32x4 w; w.x = cvtpk(pw[0], pw[1]); w.y = cvtpk(pw[2], pw[3]); w.z = cvtpk(pw[4], pw[5]); w.w = cvtpk(pw[6], pw[7]);
          const bf16x8 pf = __builtin_bit_cast(bf16x8, w);
#pragma unroll
          for (int eb = 0; eb < 4; ++eb) o[eb] = mfma16(vf[eb], pf, o[eb]);
        }
        const LAS bf16_t* kb = Ks + (32 * s2 + 4 * quad + tq) * RT_STR + 16 * wid + 4 * tp;
        const u32x2 klo = tr_rd(kb), khi = tr_rd(kb + 16 * RT_STR);
        const u32x4 kk = (u32x4){klo.x, klo.y, khi.x, khi.y}; const bf16x8 bk = __builtin_bit_cast(bf16x8, kk);
#pragma unroll
        for (int eb = 0; eb < 4; ++eb) st[eb] = mfma16(vf[eb], bk, st[eb]);
      }
#pragma unroll
      for (int eb = 0; eb < 4; ++eb) st[eb] = st[eb] * post;
      if (dir == 0) { bf16_t* op = OF + grow * 2048 + h * 256 + sl * 64 + quad * 4;
#pragma unroll
        for (int eb = 0; eb < 4; ++eb) { u32x2 w; w.x = cvtpk(o[eb][0], o[eb][1]); w.y = cvtpk(o[eb][2], o[eb][3]); *(u32x2*)(op + eb * 16) = w; } }
      else { bf16_t* op = U + grow * 4096 + 2048 + h * 256 + sl * 64 + quad * 4;
#pragma unroll
        for (int eb = 0; eb < 4; ++eb) { u32x2 w; w.x = cvtpk(o[eb][0] + bflo(fo[eb].x), o[eb][1] + bfhi(fo[eb].x)); w.y = cvtpk(o[eb][2] + bflo(fo[eb].y), o[eb][3] + bfhi(fo[eb].y)); *(u32x2*)(op + eb * 16) = w; } }
    }
  }
}
__device__ __forceinline__ void ret_phase(const Params& p, LAS unsigned char* lds, const int tid, const int bid, const bool dry) {
  bf16_t* U = (bf16_t*)(p.ws + WS_B0); bf16_t* OF = (bf16_t*)(p.ws + WS_Y);
  for (int u = bid; u < 256; u += gridDim.x) { const int b = u & 7, rest = u >> 3, sl = rest & 3, h = rest >> 2; ret_unit(lds, U, OF, b, h, sl, tid, dry); }
}

#ifndef PHASE_MAP
#define PHASE_MAP(it) (it)
#define N_ITERS 38
#endif
#define RUN_GEMM(MODE, APTR, LDA_, BTPTR, N_, K_, OPTR, LDC_, COFF_, CS_, TAB_, SCALE_) do { const int skipc_ = ((L == 3 && s >= 4) || s == 8) ? 1 : 0; \
    pg8::Gemm g; g.A = (APTR); g.Bt = (BTPTR); g.M = T; g.N = (N_); g.K = (K_); g.lda = (LDA_); \
    Epi<MODE, LDC_, COFF_> E; E.O = (OPTR); E.cs = (CS_); E.tab = (TAB_); E.scale = (SCALE_); \
    pg8::StaticOrder S; S.init(T, (N_), G, (bid + G - rot_) % G, skipc_); \
    int tg_ = tid; asm volatile("" : "+v"(tg_)); \
    pg8::gemm_phase<Epi<MODE, LDC_, COFF_>, pg8::StaticOrder, true, true, K_, LDA_>(lds, g, S, E, tg_); \
    __syncthreads(); } while (0)
#define RUN_SPLIT(APTR, LDA_, BTPTR, LDB_, N_, KP_, NP_, OPTR) do { \
    pg8::Gemm g; g.A = (APTR); g.Bt = (BTPTR); g.M = T; g.N = (N_); g.K = (KP_); g.lda = (LDA_); \
    Epi<5, 1024, 0> E; E.O = (bf16_t*)(OPTR); E.cs = nullptr; E.tab = nullptr; E.scale = 1.f; \
    pg8::CtxSplitOrder S; S.init((N_), (NP_), G, bid); \
    int tg_ = tid; asm volatile("" : "+v"(tg_)); \
    pg8::gemm_phase<Epi<5, 1024, 0>, pg8::CtxSplitOrder, true, true, KP_, LDA_, LDB_>(lds, g, S, E, tg_); \
    __syncthreads(); } while (0)
__global__ void __launch_bounds__(NTHR, 2) mega(Params p_unused) {
  extern __shared__ __attribute__((aligned(16))) unsigned char lds_raw[];
  LAS unsigned char* lds = (LAS unsigned char*)lds_raw;
  const Params& p = *(const Params*)__builtin_amdgcn_kernarg_segment_ptr();
  const int G = gridDim.x;
  volatile LAS unsigned* bst = (volatile LAS unsigned*)(lds + LDS_BAR_OFF);
  if (threadIdx.x < 2) bst[threadIdx.x] = 0u;
  __syncthreads();
  const XcdBarrier bar = xcd_barrier_post((unsigned*)(p.ws + WS_BAR), bst);
  for (int it = p.lo; it < p.hi; ++it) {
    const int phc = PHASE_MAP(it); const int ph = phc & 63; const bool dry = (phc >> 6) != 0;
    if (it > p.lo + 1) { xcd_barrier(bar); }
    else if (it > p.lo) {
      asm volatile("s_waitcnt vmcnt(0) lgkmcnt(0)" ::: "memory");
      __syncthreads();
      if (threadIdx.x < 64) { __builtin_amdgcn_fence(__ATOMIC_RELEASE, "agent"); asm volatile("s_waitcnt vmcnt(0)" ::: "memory"); }
      cg::this_grid().sync();
      if (threadIdx.x < 64) { __builtin_amdgcn_fence(__ATOMIC_ACQUIRE, "agent"); asm volatile("s_waitcnt vmcnt(0)" ::: "memory"); }
      __syncthreads();
    }
    int tid = threadIdx.x; asm volatile("" : "+v"(tid));
    int bid = blockIdx.x; asm volatile("" : "+s"(bid));
    const int lane = tid & 63, wid = __builtin_amdgcn_readfirstlane(tid >> 6);
    const int gw = bid * NWAVE + wid, ngw = G * NWAVE;
    unsigned char* ws = p.ws;
    const float* mod = (const float*)(ws + WS_MOD);
    const float* tab = (const float*)(ws + WS_TAB);
    bf16_t* H = (bf16_t*)(ws + WS_H); bf16_t* B0 = (bf16_t*)(ws + WS_B0); bf16_t* Y = (bf16_t*)(ws + WS_Y);
    if (ph == 0) { p0_phase(p, lds, tid, bid); continue; }
    if (ph == 37) { norm_phase(p, false, true, true, p.g_ffn_post + 3 * DM, mod + (size_t)3 * 9 * 6144 + 5 * 1024, nullptr, nullptr, gw, ngw, lane); continue; }
    const int L = (ph - 1) / 9, s = (ph - 1) % 9, odd = L & 1, li = L >> 1;
    const float* modL = mod + (size_t)L * 9 * 6144;
    int rot_ = 0;
    if (s == 0) {
      conv_layer(p, L, lds, gw, ngw, wid, lane);
      norm_phase(p, L == 0, L > 0, false, p.g_ffn_post + (L > 0 ? (L - 1) : 0) * DM, mod + (size_t)(L > 0 ? (L - 1) : 0) * 9 * 6144 + 5 * 1024, p.g_mix_pre + L * DM, modL, gw, ngw, lane, false, (L > 0) ? (const float*)(ws + WS_YP) : nullptr);
      __syncthreads();
    }
    else if (s == 6) { norm_phase(p, false, true, false, p.g_mix_post + L * DM, modL + 2 * 1024, p.g_ffn_pre + L * DM, modL + 3 * 1024, gw, ngw, lane, dry); }
    else if (s == 7) { RUN_GEMM(1, H, 1024, (const bf16_t*)(ws + WS_WFF1), 4096, 1024, B0, 4096, 0, nullptr, tab, 1.f); }
    else if (s == 8) {
      RUN_GEMM(0, B0, 4096, (const bf16_t*)(ws + WS_WFF2), 1024, 4096, Y, 1024, 0, nullptr, tab, 1.f);
      if (L < 3) RUN_SPLIT(B0, 4096, (const bf16_t*)(ws + WS_WFF2), 4096, 1024, 512, 8, ws + WS_YP);
    }
    else if (!odd) {
      if (s == 1) { RUN_GEMM(0, H, 1024, (const bf16_t*)(ws + WS_WA), 1024, 1024, B0, 1024, 0, nullptr, tab, 1.f); }
      else if (s == 2) { mid_phase(p, li, gw, ngw, lane); }
      else if (s == 3) {
        RUN_GEMM(2, (const bf16_t*)(ws + WS_UQN), 256, (const bf16_t*)(ws + WS_WUQ), 768, 256, (bf16_t*)(ws + WS_Q), 768, 0, nullptr, tab, 0.10206207261596577f * 1.4426950408889634f);
        rot_ = 24;
        RUN_GEMM(0, (const bf16_t*)(ws + WS_UKVN), 128, (const bf16_t*)(ws + WS_WUKV), 1024, 256, (bf16_t*)(ws + WS_KV), 1024, 0, nullptr, tab, 1.f);
        rot_ = 56;
        RUN_GEMM(0, (const bf16_t*)(ws + WS_PD), 512, (const bf16_t*)(ws + WS_WPOOL), 512, 512, B0, 1024, 512, p.pool_scale + li * 512, tab, 1.f);
      }
      else if (s == 4) { attn_phase(p, lds, tid, bid); }
      else { RUN_GEMM(0, B0, 1024, (const bf16_t*)(ws + WS_WB), 1024, 1024, Y, 1024, 0, nullptr, tab, 1.f); }
    } else {
      if (s == 1) { RUN_GEMM(3, H, 1024, (const bf16_t*)(ws + WS_WA), 4096, 1024, B0, 4096, 0, nullptr, tab + 2048, 0.08838834764831845f); }
      else if (s == 2) { ret_phase(p, lds, tid, bid, dry); }
      else if (s == 3) { gn_phase(p, gw, ngw, lane); }
      else if (s == 4) { RUN_GEMM(4, H, 1024, (const bf16_t*)(ws + WS_WA) + (size_t)4096 * 1024, 2048, 1024, B0, 4096, 2048, nullptr, tab, 1.f); }
      else { RUN_GEMM(0, B0 + 2048, 4096, (const bf16_t*)(ws + WS_WB), 1024, 2048, Y, 1024, 0, nullptr, tab, 1.f); }
    }
  }
}

extern "C" void kernel_launch(void* const* d_in, const int* in_sizes, int n_in, void* d_out, int out_size, void* d_ws, size_t ws_size, hipStream_t stream) {
  static int grid = 0;
  if (grid == 0) {
    if (n_in != 22 || ws_size < WS_END) { fprintf(stderr, "kernel_launch: unexpected n_in %d or workspace %zu < %zu\n", n_in, ws_size, (size_t)WS_END); grid = -1; return; }
    int dev = 0, cus = 0, per_cu = 0;
    hipGetDevice(&dev); hipDeviceGetAttribute(&cus, hipDeviceAttributeMultiprocessorCount, dev);
    if (hipFuncSetAttribute((const void*)mega, hipFuncAttributeMaxDynamicSharedMemorySize, LDS_BYTES) != hipSuccess) { fprintf(stderr, "kernel_launch: hipFuncSetAttribute failed\n"); }
    if (hipOccupancyMaxActiveBlocksPerMultiprocessor(&per_cu, (const void*)mega, NTHR, LDS_BYTES) != hipSuccess || per_cu < 1) { fprintf(stderr, "kernel_launch: occupancy query gave %d\n", per_cu); per_cu = 1; }
    (void)hipGetLastError();
    grid = cus * 1;
  }
  if (grid < 0) return;
  if (hipMemsetAsync((char*)d_ws + WS_BAR, 0, XCD_BAR_WORDS * 4, stream) != hipSuccess) fprintf(stderr, "kernel_launch: memset of the barrier words failed\n");
  Params p{};
  const float** pp = (const float**)&p;
  for (int i = 0; i < 22; ++i) pp[i] = (const float*)d_in[i];
  p.out = (float*)d_out; p.ws = (unsigned char*)d_ws;
#ifndef N_SPLIT
  p.lo = 0; p.hi = N_ITERS;
  void* args[] = {&p};
  hipError_t e = hipLaunchCooperativeKernel((const void*)mega, dim3(grid), dim3(NTHR), args, LDS_BYTES, stream);
  if (e != hipSuccess) fprintf(stderr, "cooperative launch failed: %s (grid %d)\n", hipGetErrorString(e), grid);
#else
  for (int ph = 0; ph < 38; ++ph) { p.lo = ph; p.hi = ph + 1; hipLaunchKernelGGL(mega, dim3(grid), dim3(NTHR), LDS_BYTES, stream, p); }
#endif
}
```
